# Optimizing an MI355X kernel written in HIP

```python
import jax, jax.numpy as jnp
from jax import lax
import numpy as np

D_MODEL = 2048
BATCH = 4
SEQ = 8192
DEPTH = 4

HEAD_DIM = 128
N_HEADS_A = 12
N_HEADS_B = 12
WIDTH_A = N_HEADS_A * HEAD_DIM
WIDTH_B = N_HEADS_B * HEAD_DIM
DILATED_PATTERNS = ((128, 1), (512, 4), (2048, 16))
Q_BLOCK = 128
ROPE_THETA = 10000.0
LN_EPS = 1e-5
DEEPNORM_ALPHA = float((2 * DEPTH) ** 0.25)
DEEPNORM_BETA = float((8 * DEPTH) ** -0.25)
FORGET_BIAS_INIT = 2.0

SPLIT_SIZES = (WIDTH_A, WIDTH_A, WIDTH_A, WIDTH_A,
               WIDTH_B, WIDTH_B, WIDTH_B, WIDTH_B,
               N_HEADS_B,
               2 * D_MODEL)
SPLIT_POINTS = tuple(int(v) for v in np.cumsum(SPLIT_SIZES)[:-1])
N_IN_COLS = int(sum(SPLIT_SIZES))

kernel_name = "hybrid_dilated_forgetting_attention_deepnorm"


def rope(t, pos):
    half = HEAD_DIM // 2
    inv_freq = ROPE_THETA ** (-jnp.arange(half, dtype=jnp.float32) / half)
    ang = pos.astype(jnp.float32)[:, None] * inv_freq[None, :]
    cos = jnp.cos(ang)[None, :, None, :]
    sin = jnp.sin(ang)[None, :, None, :]
    t32 = t.astype(jnp.float32)
    t1, t2 = t32[..., :half], t32[..., half:]
    return jnp.concatenate([t1 * cos - t2 * sin, t1 * sin + t2 * cos], axis=-1).astype(t.dtype)


def dilated_pattern(q, k, v, window, dilation):
    B, S, H, hd = q.shape
    span = window // dilation
    L = S // dilation
    nblk = -(-L // Q_BLOCK)
    Lp = nblk * Q_BLOCK

    def to_residue(t):
        t = t.reshape(B, L, dilation, H, hd).transpose(0, 2, 1, 3, 4)
        return jnp.pad(t, ((0, 0), (0, 0), (0, Lp - L), (0, 0), (0, 0)))

    def band_keys(t):
        tp = jnp.pad(t, ((0, 0), (0, 0), (Q_BLOCK, 0), (0, 0), (0, 0)))
        tp = tp.reshape(B, dilation, nblk + 1, Q_BLOCK, H, hd)
        return jnp.concatenate([tp[:, :, :-1], tp[:, :, 1:]], axis=3)

    qb = to_residue(q).reshape(B, dilation, nblk, Q_BLOCK, H, hd)
    kb = band_keys(to_residue(k))
    vb = band_keys(to_residue(v))

    n_idx = jnp.arange(nblk)[:, None, None]
    i_idx = jnp.arange(Q_BLOCK)[None, :, None]
    j_idx = jnp.arange(2 * Q_BLOCK)[None, None, :]
    dist = Q_BLOCK + i_idx - j_idx
    valid = (dist >= 0) & (dist <= span) & (n_idx * Q_BLOCK + j_idx - Q_BLOCK >= 0)
    valid = valid[None, None, :, None]

    scale = HEAD_DIM ** -0.5
    s = jnp.einsum('bdnihe,bdnjhe->bdnhij', qb, kb, preferred_element_type=jnp.float32) * scale
    s = jnp.where(valid, s, -jnp.inf)
    m = jnp.max(s, axis=-1, keepdims=True)
    p = jnp.exp(s - m)
    den = jnp.sum(p, axis=-1, keepdims=True)
    out = jnp.einsum('bdnhij,bdnjhe->bdnihe', p, vb.astype(jnp.float32))
    out = out / jnp.moveaxis(den, 3, 4)
    lse = jnp.moveaxis((m + jnp.log(den))[..., 0], 3, 4)

    out = out.reshape(B, dilation, Lp, H, hd)[:, :, :L].transpose(0, 2, 1, 3, 4).reshape(B, S, H, hd)
    lse = lse.reshape(B, dilation, Lp, H)[:, :, :L].transpose(0, 2, 1, 3).reshape(B, S, H)
    return out, lse


def dilated_mixture(q, k, v):
    outs, lses = [], []
    for window, dilation in DILATED_PATTERNS:
        o, l = dilated_pattern(q, k, v, window, dilation)
        outs.append(o)
        lses.append(l)
    w = jax.nn.softmax(jnp.stack(lses, axis=0), axis=0)
    return jnp.sum(w[..., None] * jnp.stack(outs, axis=0), axis=0).astype(q.dtype)


def forgetting_attention(q, k, v, log_f):
    B, S, H, hd = q.shape
    nblk = S // Q_BLOCK
    cum = jnp.cumsum(log_f, axis=1).transpose(0, 2, 1)
    q_blocks = q.reshape(B, nblk, Q_BLOCK, H, hd).transpose(1, 0, 2, 3, 4)
    c_blocks = cum.reshape(B, H, nblk, Q_BLOCK).transpose(2, 0, 1, 3)
    kpos = jnp.arange(S)
    scale = HEAD_DIM ** -0.5

    def block(args):
        n, qn, cn = args
        s = jnp.einsum('bihe,bjhe->bhij', qn, k, preferred_element_type=jnp.float32) * scale
        s = s + cn[..., :, None] - cum[..., None, :]
        qpos = n * Q_BLOCK + jnp.arange(Q_BLOCK)
        causal = kpos[None, :] <= qpos[:, None]
        s = jnp.where(causal[None, None], s, -jnp.inf)
        p = jax.nn.softmax(s, axis=-1)
        return jnp.einsum('bhij,bjhe->bihe', p, v.astype(jnp.float32)).astype(q.dtype)

    out = lax.map(block, (jnp.arange(nblk), q_blocks, c_blocks))
    return out.transpose(1, 0, 2, 3, 4).reshape(B, S, H, hd)


def layer_norm(x, g, b):
    x32 = x.astype(jnp.float32)
    mu = jnp.mean(x32, axis=-1, keepdims=True)
    var = jnp.mean(jnp.square(x32 - mu), axis=-1, keepdims=True)
    y = (x32 - mu) * lax.rsqrt(var + LN_EPS)
    return (y * g.astype(jnp.float32) + b.astype(jnp.float32)).astype(x.dtype)


def hybrid_layer(x, pos, w_in, b_forget, b_gate, w_up_a, w_up_b, w_out, ln_g, ln_b):
    B, S, _ = x.shape
    h = jnp.einsum('bsd,dc->bsc', x, w_in)
    qa, ka, va, za, qb, kb, vb, zb, f_logit, g_logit = jnp.split(h, SPLIT_POINTS, axis=-1)
    heads = lambda t, n: t.reshape(B, S, n, HEAD_DIM)

    qa = rope(heads(qa, N_HEADS_A), pos)
    ka = rope(heads(ka, N_HEADS_A), pos)
    out_a = dilated_mixture(qa, ka, heads(va, N_HEADS_A)).reshape(B, S, WIDTH_A)
    up_a = jnp.einsum('bsw,wd->bsd', out_a * jax.nn.silu(za), w_up_a)

    log_f = jax.nn.log_sigmoid((f_logit + b_forget).astype(jnp.float32))
    out_b = forgetting_attention(heads(qb, N_HEADS_B), heads(kb, N_HEADS_B),
                                 heads(vb, N_HEADS_B), log_f).reshape(B, S, WIDTH_B)
    up_b = jnp.einsum('bsw,wd->bsd', out_b * jax.nn.silu(zb), w_up_b)

    gates = jax.nn.sigmoid(g_logit + b_gate)
    g_a, g_b = gates[..., :D_MODEL], gates[..., D_MODEL:]
    y = jnp.einsum('bsd,de->bse', g_a * up_a + g_b * up_b, w_out)

    return layer_norm(DEEPNORM_ALPHA * x + y, ln_g, ln_b)


def setup_inputs(seed: int = 0) -> dict:
    key = jax.random.key(seed)
    ks = jax.random.split(key, 10)
    x = jax.random.normal(ks[0], (BATCH, SEQ, D_MODEL), jnp.float32)

    offs = (0,) + SPLIT_POINTS
    col_scale = jnp.ones((N_IN_COLS,), jnp.float32)
    col_scale = col_scale.at[offs[2]:offs[3]].set(DEEPNORM_BETA)
    col_scale = col_scale.at[offs[6]:offs[7]].set(DEEPNORM_BETA)
    w_in = jax.random.normal(ks[1], (DEPTH, D_MODEL, N_IN_COLS), jnp.float32) * (D_MODEL ** -0.5) * col_scale
    b_forget = FORGET_BIAS_INIT + 0.1 * jax.random.normal(ks[2], (DEPTH, N_HEADS_B), jnp.float32)
    b_gate = 0.02 * jax.random.normal(ks[3], (DEPTH, 2 * D_MODEL), jnp.float32)
    w_up_a = jax.random.normal(ks[4], (DEPTH, WIDTH_A, D_MODEL), jnp.float32) * (WIDTH_A ** -0.5) * DEEPNORM_BETA
    w_up_b = jax.random.normal(ks[5], (DEPTH, WIDTH_B, D_MODEL), jnp.float32) * (WIDTH_B ** -0.5) * DEEPNORM_BETA
    w_out = jax.random.normal(ks[6], (DEPTH, D_MODEL, D_MODEL), jnp.float32) * (D_MODEL ** -0.5) * DEEPNORM_BETA
    ln_g = 1.0 + 0.02 * jax.random.normal(ks[7], (DEPTH, D_MODEL), jnp.float32)
    ln_b = 0.02 * jax.random.normal(ks[8], (DEPTH, D_MODEL), jnp.float32)
    return {"x": x, "w_in": w_in, "b_forget": b_forget, "b_gate": b_gate,
            "w_up_a": w_up_a, "w_up_b": w_up_b, "w_out": w_out,
            "ln_g": ln_g, "ln_b": ln_b}


def reference(x, w_in, b_forget, b_gate, w_up_a, w_up_b, w_out, ln_g, ln_b):
    pos = jnp.arange(x.shape[1], dtype=jnp.int32)
    for l in range(DEPTH):
        x = hybrid_layer(x, pos, w_in[l], b_forget[l], b_gate[l],
                         w_up_a[l], w_up_b[l], w_out[l], ln_g[l], ln_b[l])
    return x
```

```cpp
#include <hip/hip_runtime.h>
#include <hip/hip_cooperative_groups.h>
#include <cstdio>
#include <cstdint>
namespace cg = cooperative_groups;
namespace pg8 {
#define PG8_LAS __attribute__((address_space(3)))
typedef unsigned short bf16_t;
typedef short bf16x8 __attribute__((ext_vector_type(8)));
typedef float f32x4 __attribute__((ext_vector_type(4)));
typedef unsigned u32x4 __attribute__((ext_vector_type(4)));
constexpr int BM = 256, BK = 64, HALF = 128, HTB = HALF * BK * 2  , STAGE_BYTES = 8 * HTB, NXCD = 8, WGM = 8;

__host__ __device__ __forceinline__ int lds_byte(int r, int c) { const int st = (r >> 4) * 2 + (c >> 5), rr = r & 15, cc = c & 31, ob = rr * 64 + cc * 2; return st * 1024 + (ob ^ (((ob >> 9) & 1) << 5)); }
__host__ __device__ __forceinline__ void stage_rc(int b, int& R, int& C) { const int st = b / 1024, sb = b % 1024, swz = sb ^ (((sb >> 9) & 1) << 5); R = (st >> 1) * 16 + swz / 64; C = (st & 1) * 32 + (swz % 64) / 2; }
__host__ __device__ __forceinline__ int perm32(int rho) { const int n = rho >> 4, i = rho & 15; return 8 * (i >> 2) + 4 * n + (i & 3); }

struct Unit { int pm, pn; };
struct Gemm { const bf16_t* A; const bf16_t* Bt; int M, N, K, lda; };

struct StaticOrder {
    int nM, nN, nwg, G, c;
    __host__ __device__ void init(int M, int N, int G_, int c_) { nM = M / BM; nN = N / BM; nwg = nM * nN; G = G_; c = c_; }
    __host__ __device__ bool next(int i, Unit& u) const {
        const long L = (long)i * G + c; if (L >= nwg) return false;
        int wgid = (int)L; { const int q = nwg / NXCD, r = nwg % NXCD, xcd = wgid % NXCD, off = wgid / NXCD; wgid = (xcd < r ? xcd * (q + 1) : r * (q + 1) + (xcd - r) * q) + off; }
        const int nig = WGM * nN, gid = wgid / nig, fm = gid * WGM, gsz = (nM - fm) < WGM ? (nM - fm) : WGM;
        u.pm = fm + ((wgid % nig) % gsz); u.pn = (wgid % nig) / gsz; return true;
    }
    __device__ __forceinline__ void a_ready(const Unit&) const {}
    __device__ __forceinline__ void done(const Unit&) const {}
};

__device__ __forceinline__ unsigned cvt_pk_bf16(float lo, float hi) { unsigned r; asm volatile("v_cvt_pk_bf16_f32 %0, %1, %2" : "=v"(r) : "v"(lo), "v"(hi)); return r; }
typedef float f32x2 __attribute__((ext_vector_type(2)));
typedef unsigned u32x2 __attribute__((ext_vector_type(2)));
typedef int i32x4 __attribute__((ext_vector_type(4)));
template <bool I8> struct AccSel { typedef f32x4 type; };
template <> struct AccSel<true> { typedef i32x4 type; };
__device__ __forceinline__ f32x4 cvt4(i32x4 a, float s) { return (f32x4){(float)a[0] * s, (float)a[1] * s, (float)a[2] * s, (float)a[3] * s}; }
__device__ __forceinline__ float bf_lo(unsigned w) { return __uint_as_float(w << 16); }
__device__ __forceinline__ float bf_hi(unsigned w) { return __uint_as_float(w & 0xffff0000u); }
__device__ __forceinline__ float sigm(float z) { return __builtin_amdgcn_rcpf(1.f + __builtin_amdgcn_exp2f(-1.4426950408889634f * z)); }
__device__ __forceinline__ float logsig(float z) { return fminf(z, 0.f) - log1pf(expf(-fabsf(z))); }

struct EpiIn {
    static constexpr bool PERM = true, AFTER_DRAIN = false;
    bf16_t* H; int ldh; const float* cosT; const float* sinT; float* logf; const float* bfg; const float* sx; const float* sw;
    __device__ __forceinline__ void operator()(const i32x4 (&acc)[2][2][4][2], const Unit& u, int wr, int wc, int fr, int fq) const {
        asm volatile("" : "+v"(fr), "+v"(fq));
        const int row0 = u.pm * BM + wr * 64 + fr;
        if (u.pn == 64) {
            if (wc == 0 && fq < 2) {
                const f32x4 b0 = *(const f32x4*)(bfg + 8 * fq); const f32x4 b1 = fq == 0 ? *(const f32x4*)(bfg + 4) : (f32x4){0.f, 0.f, 0.f, 0.f};
                const f32x4 w0 = *(const f32x4*)(sw + u.pn * BM + 8 * fq), w1 = *(const f32x4*)(sw + u.pn * BM + 8 * fq + 4);
#pragma unroll
                for (int ai = 0; ai < 2; ++ai)
#pragma unroll
                    for (int m = 0; m < 4; ++m) { const int row = row0 + ai * HALF + m * 16; const float sr = sx[row];
                        float* o = logf + ((size_t)(row >> 13) * 12 + 8 * fq) * 8192 + (row & 8191);
                        const f32x4 v0 = cvt4(acc[ai][0][m][0], sr) * w0 + b0; o[0] = logsig(v0[0]); o[8192] = logsig(v0[1]); o[2 * 8192] = logsig(v0[2]); o[3 * 8192] = logsig(v0[3]);
                        if (fq == 0) { const f32x4 v1 = cvt4(acc[ai][0][m][1], sr) * w1 + b1; o[4 * 8192] = logsig(v1[0]); o[5 * 8192] = logsig(v1[1]); o[6 * 8192] = logsig(v1[2]); o[7 * 8192] = logsig(v1[3]); } }
            }
            return;
        }
        const bool rope = u.pn < 12;
        const int i0 = 16 * wc + 4 * fq;
#pragma unroll
        for (int bj = 0; bj < 2; ++bj) { const int col0 = u.pn * BM + bj * HALF + wc * 32 + 8 * fq;
            const f32x4 w0 = *(const f32x4*)(sw + col0), w1 = *(const f32x4*)(sw + col0 + 4);
#pragma unroll
            for (int ai = 0; ai < 2; ++ai)
#pragma unroll
                for (int m = 0; m < 4; ++m) { const int row = row0 + ai * HALF + m * 16; const float sr = sx[row];
                    f32x4 v0 = cvt4(acc[ai][bj][m][0], sr) * w0, v1 = cvt4(acc[ai][bj][m][1], sr) * w1;
                    if (rope) { const int pos = row & 8191; const f32x4 c = *(const f32x4*)(cosT + pos * 64 + i0), s = *(const f32x4*)(sinT + pos * 64 + i0);
                        const f32x4 o0 = v0 * c - v1 * s, o1 = v0 * s + v1 * c; v0 = o0; v1 = o1; }
                    u32x4 w; w.x = cvt_pk_bf16(v0[0], v0[1]); w.y = cvt_pk_bf16(v0[2], v0[3]); w.z = cvt_pk_bf16(v1[0], v1[1]); w.w = cvt_pk_bf16(v1[2], v1[3]);
                    *(u32x4*)(H + (size_t)row * ldh + col0) = w; } }
    }
};
template <bool ADD> struct EpiGate {
    static constexpr bool PERM = true, AFTER_DRAIN = false; static constexpr int NB = 2;
    const bf16_t* Hg; int ldh; const float* bg; const bf16_t* Mf; bf16_t* O; int ldo; const float* sa; const float* sb;
    __device__ __forceinline__ void operator()(const i32x4 (&acc)[2][2][4][2], const Unit& u, int wr, int wc, int fr, int fq) const {
        asm volatile("" : "+v"(fr), "+v"(fq));
        const int row0 = u.pm * BM + wr * 64 + fr;
#pragma unroll
        for (int bj = 0; bj < 2; ++bj) { const int col0 = u.pn * BM + bj * HALF + wc * 32 + 8 * fq;
            const f32x4 g0 = *(const f32x4*)(bg + col0), g1 = *(const f32x4*)(bg + col0 + 4), w0 = *(const f32x4*)(sb + col0), w1 = *(const f32x4*)(sb + col0 + 4);
#pragma unroll
            for (int ai = 0; ai < 2; ++ai)
#pragma unroll
              for (int mb = 0; mb < 4; mb += NB) {
                u32x4 gl[NB], pm[NB]; float sr[NB];
#pragma unroll
                for (int q = 0; q < NB; ++q) { const int row = row0 + ai * HALF + (mb + q) * 16;
                    gl[q] = *(const u32x4*)(Hg + (size_t)row * ldh + col0); if (ADD) pm[q] = *(const u32x4*)(Mf + (size_t)row * ldo + col0); sr[q] = sa[row]; }
                asm volatile("" ::: "memory");
#pragma unroll
                for (int q = 0; q < NB; ++q) { const int m = mb + q; const int row = row0 + ai * HALF + m * 16;
                    f32x4 v0 = cvt4(acc[ai][bj][m][0], sr[q]) * w0, v1 = cvt4(acc[ai][bj][m][1], sr[q]) * w1;
                    v0[0] *= sigm(bf_lo(gl[q].x) + g0[0]); v0[1] *= sigm(bf_hi(gl[q].x) + g0[1]); v0[2] *= sigm(bf_lo(gl[q].y) + g0[2]); v0[3] *= sigm(bf_hi(gl[q].y) + g0[3]);
                    v1[0] *= sigm(bf_lo(gl[q].z) + g1[0]); v1[1] *= sigm(bf_hi(gl[q].z) + g1[1]); v1[2] *= sigm(bf_lo(gl[q].w) + g1[2]); v1[3] *= sigm(bf_hi(gl[q].w) + g1[3]);
                    if (ADD) { v0[0] += bf_lo(pm[q].x); v0[1] += bf_hi(pm[q].x); v0[2] += bf_lo(pm[q].y); v0[3] += bf_hi(pm[q].y); v1[0] += bf_lo(pm[q].z); v1[1] += bf_hi(pm[q].z); v1[2] += bf_lo(pm[q].w); v1[3] += bf_hi(pm[q].w); }
                    u32x4 w; w.x = cvt_pk_bf16(v0[0], v0[1]); w.y = cvt_pk_bf16(v0[2], v0[3]); w.z = cvt_pk_bf16(v1[0], v1[1]); w.w = cvt_pk_bf16(v1[2], v1[3]);
                    *(u32x4*)(O + (size_t)row * ldo + col0) = w; }
                asm volatile("" ::: "memory"); } }
    }
};
struct EpiOut {
    static constexpr bool PERM = false, AFTER_DRAIN = false;
    const float* X; float* T; int ldc; float alpha; const float* stats; const float* lg; const float* lb; const float* sa; const float* sb;
    __device__ __forceinline__ void operator()(const i32x4 (&acc)[2][2][4][2], const Unit& u, int wr, int wc, int fr, int fq) const {
        asm volatile("" : "+v"(fr), "+v"(fq));
        const int row0 = u.pm * BM + wr * 64 + fr, col0 = u.pn * BM + wc * 32 + 4 * fq;
#pragma unroll
        for (int ai = 0; ai < 2; ++ai)
#pragma unroll
            for (int mp = 0; mp < 4; mp += 2) { f32x4 xv0[2][2], xv1[2][2]; float mu0 = 0.f, mu1 = 0.f, rs0 = 1.f, rs1 = 1.f;
                const int rowa = row0 + ai * HALF + mp * 16, rowb = rowa + 16; const size_t offa = (size_t)rowa * ldc + col0, offb = (size_t)rowb * ldc + col0;
                if (stats) { mu0 = stats[2 * rowa]; rs0 = stats[2 * rowa + 1]; mu1 = stats[2 * rowb]; rs1 = stats[2 * rowb + 1]; }
                const float sra = sa[rowa], srb = sa[rowb];
#pragma unroll
                for (int bj = 0; bj < 2; ++bj)
#pragma unroll
                    for (int n = 0; n < 2; ++n) { xv0[bj][n] = *(const f32x4*)(X + offa + bj * HALF + n * 16); xv1[bj][n] = *(const f32x4*)(X + offb + bj * HALF + n * 16); }
                asm volatile("" ::: "memory");
#pragma unroll
                for (int bj = 0; bj < 2; ++bj)
#pragma unroll
                    for (int n = 0; n < 2; ++n) { f32x4 xa = xv0[bj][n], xb = xv1[bj][n];
                        if (stats) { const f32x4 gv = *(const f32x4*)(lg + col0 + bj * HALF + n * 16), bv = *(const f32x4*)(lb + col0 + bj * HALF + n * 16);
                            xa = (xa - mu0) * rs0 * gv + bv; xb = (xb - mu1) * rs1 * gv + bv; }
                        const f32x4 wv = *(const f32x4*)(sb + col0 + bj * HALF + n * 16);
                        *(f32x4*)(T + offa + bj * HALF + n * 16) = xa * alpha + cvt4(acc[ai][bj][mp][n], sra) * wv;
                        *(f32x4*)(T + offb + bj * HALF + n * 16) = xb * alpha + cvt4(acc[ai][bj][mp + 1][n], srb) * wv; }
                asm volatile("" ::: "memory"); }
    }
};
template <class Epi, class Sched, bool ALIGN_EPI = false, bool SP2 = false, bool I8 = false>
__device__ __forceinline__ void gemm_phase(PG8_LAS unsigned char* lds, const Gemm g, const Sched& S, const Epi& E) {
    int tid = threadIdx.x; asm volatile("" : "+v"(tid));
    const int wid = __builtin_amdgcn_readfirstlane(tid >> 6), lane = tid & 63, wr = wid >> 2, wc = wid & 3, fr = lane & 15, fq = lane >> 4;
    const int K = g.K, nt = K / BK;
    unsigned voffA[2], voffB[2];
#pragma unroll
    for (int i = 0; i < 2; ++i) { int R, C; stage_rc(tid * 16 + i * 8192, R, C); const int Rb = Epi::PERM ? ((R & ~31) + perm32(R & 31)) : R;
        voffA[i] = (unsigned)(R * g.lda + C) * 2u; voffB[i] = (unsigned)(Rb * K + C) * 2u; }
    const size_t kstep = (size_t)(BK * 2);
    const size_t hstepA = (size_t)HALF * g.lda * 2, hstepB = (size_t)HALF * K * 2;
    const size_t tstepA = 2 * hstepA, tstepB = 2 * hstepB;
    const unsigned ldsw = (unsigned)wid * 1024u;
    const int aoff = lds_byte(wr * 64 + fr, fq * 8), boff = lds_byte(wc * 32 + fr, fq * 8);
#define PG8_SA(b, h) (((b) * 2 + (h)) * HTB)
#define PG8_SB(b, h) ((4 + (b) * 2 + (h)) * HTB)
#define PG8_STAGE(bufoff, gbase, voff) do { _Pragma("unroll") for (int _i = 0; _i < 2; ++_i) \
        __builtin_amdgcn_global_load_lds((const unsigned*)((const char*)(gbase) + (voff)[_i]), (PG8_LAS unsigned*)(lds + (bufoff) + ldsw + _i * 8192), 16, 0, 0); } while (0)
#define PG8_LDA(dst, b, h) do { _Pragma("unroll") for (int m = 0; m < 4; ++m) _Pragma("unroll") for (int k = 0; k < 2; ++k) dst[m][k] = *(const PG8_LAS bf16x8*)(lds + PG8_SA(b, h) + aoff + m * 2048 + k * 1024); } while (0)
#define PG8_LDB(dst, b, h) do { _Pragma("unroll") for (int n = 0; n < 2; ++n) _Pragma("unroll") for (int k = 0; k < 2; ++k) dst[n][k] = *(const PG8_LAS bf16x8*)(lds + PG8_SB(b, h) + boff + n * 2048 + k * 1024); } while (0)
#define PG8_MMA(ai, bj, At, Bt) do { __builtin_amdgcn_s_setprio(1); _Pragma("unroll") for (int m = 0; m < 4; ++m) _Pragma("unroll") for (int n = 0; n < 2; ++n) _Pragma("unroll") for (int k = 0; k < 2; ++k) \
        { if constexpr (I8) acc[ai][bj][m][n] = __builtin_amdgcn_mfma_i32_16x16x64_i8(__builtin_bit_cast(i32x4, Bt[n][k]), __builtin_bit_cast(i32x4, At[m][k]), acc[ai][bj][m][n], 0, 0, 0); \
          else acc[ai][bj][m][n] = __builtin_amdgcn_mfma_f32_16x16x32_bf16(Bt[n][k], At[m][k], acc[ai][bj][m][n], 0, 0, 0); } __builtin_amdgcn_s_setprio(0); } while (0)
#define PG8_WAIT_V(n) asm volatile("s_waitcnt vmcnt(" #n ")" ::: "memory")
#define PG8_WAIT_L(n) asm volatile("s_waitcnt lgkmcnt(" #n ")" ::: "memory")
#define PG8_BAR __builtin_amdgcn_s_barrier()
#define PG8_SCHED __builtin_amdgcn_sched_barrier(0)
    Unit cur, nxt; int ui = 0;
    if (!S.next(0, cur)) return;
    typedef typename AccSel<I8>::type AccT; AccT acc[2][2][4][2];
#pragma unroll
    for (int a = 0; a < 2; ++a)
#pragma unroll
        for (int b = 0; b < 2; ++b)
#pragma unroll
            for (int m = 0; m < 4; ++m)
#pragma unroll
                for (int n = 0; n < 2; ++n) acc[a][b][m][n] = AccT{};
    bf16x8 At[4][2], B0[2][2], B1[2][2];
    const char* cA = (const char*)g.A + (size_t)cur.pm * tstepA; const char* cB = (const char*)g.Bt + (size_t)cur.pn * tstepB;
    S.a_ready(cur);
    if constexpr (SP2) {
        PG8_STAGE(PG8_SB(0, 0), cB, voffB); PG8_STAGE(PG8_SB(0, 1), cB + hstepB, voffB); PG8_STAGE(PG8_SA(0, 0), cA, voffA); PG8_STAGE(PG8_SA(0, 1), cA + hstepA, voffA);
        if (wr == 1) PG8_BAR;
        PG8_WAIT_V(2); PG8_BAR;
        PG8_STAGE(PG8_SB(1, 0), cB + kstep, voffB); PG8_STAGE(PG8_SA(1, 0), cA + kstep, voffA); PG8_STAGE(PG8_SB(1, 1), cB + hstepB + kstep, voffB);
        PG8_WAIT_V(6); PG8_BAR;
    } else {
        PG8_STAGE(PG8_SB(0, 0), cB, voffB); PG8_STAGE(PG8_SA(0, 0), cA, voffA); PG8_STAGE(PG8_SB(0, 1), cB + hstepB, voffB); PG8_STAGE(PG8_SA(0, 1), cA + hstepA, voffA);
        if (wr == 1) PG8_BAR;
        PG8_WAIT_V(4); PG8_BAR;
        PG8_STAGE(PG8_SB(1, 0), cB + kstep, voffB); PG8_STAGE(PG8_SA(1, 0), cA + kstep, voffA); PG8_STAGE(PG8_SB(1, 1), cB + hstepB + kstep, voffB);
        PG8_WAIT_V(6); PG8_BAR;
    }
    for (;;) {
        const bool has_next = S.next(ui + 1, nxt);
        const char* nA = has_next ? (const char*)g.A + (size_t)nxt.pm * tstepA : cA; const char* nB = has_next ? (const char*)g.Bt + (size_t)nxt.pn * tstepB : cB;
        for (int t = 0; t < nt; t += 2) {
            const bool last = (t == nt - 2);
            const char* a1 = cA + (size_t)(t + 1) * kstep;
            const char* a2 = last ? nA : cA + (size_t)(t + 2) * kstep; const char* b2 = last ? nB : cB + (size_t)(t + 2) * kstep;
            const char* a3 = a2 + kstep; const char* b3 = b2 + kstep;
            if (last && has_next) S.a_ready(nxt);
            if constexpr (SP2) {
            PG8_LDB(B0, 0, 0); PG8_LDB(B1, 0, 1); PG8_SCHED; PG8_LDA(At, 0, 0); PG8_STAGE(PG8_SA(1, 1), a1 + hstepA, voffA);
            PG8_WAIT_V(8); PG8_WAIT_L(0); PG8_BAR; PG8_MMA(0, 0, At, B0); PG8_MMA(0, 1, At, B1); PG8_BAR; PG8_SCHED;
            PG8_LDA(At, 0, 1); PG8_STAGE(PG8_SB(0, 0), b2, voffB); PG8_STAGE(PG8_SB(0, 1), b2 + hstepB, voffB); PG8_STAGE(PG8_SA(0, 0), a2, voffA);
            PG8_WAIT_V(8); PG8_WAIT_L(0); PG8_BAR; PG8_MMA(1, 0, At, B0); PG8_MMA(1, 1, At, B1); PG8_BAR; PG8_SCHED;
            PG8_LDB(B0, 1, 0); PG8_LDB(B1, 1, 1); PG8_SCHED; PG8_LDA(At, 1, 0); PG8_STAGE(PG8_SA(0, 1), a2 + hstepA, voffA);
            PG8_WAIT_V(8); PG8_WAIT_L(0); PG8_BAR; PG8_MMA(0, 0, At, B0); PG8_MMA(0, 1, At, B1); PG8_BAR; PG8_SCHED;
            PG8_LDA(At, 1, 1); PG8_STAGE(PG8_SB(1, 0), b3, voffB); PG8_STAGE(PG8_SB(1, 1), b3 + hstepB, voffB); PG8_STAGE(PG8_SA(1, 0), a3, voffA);
            PG8_WAIT_V(8); PG8_WAIT_L(0); PG8_BAR; PG8_MMA(1, 0, At, B0); PG8_MMA(1, 1, At, B1); PG8_BAR; PG8_SCHED;
            } else {
            PG8_LDB(B0, 0, 0); PG8_SCHED; PG8_LDA(At, 0, 0); PG8_STAGE(PG8_SA(1, 1), a1 + hstepA, voffA);
            PG8_WAIT_L(8); PG8_BAR; PG8_WAIT_L(0); PG8_MMA(0, 0, At, B0); PG8_BAR; PG8_SCHED;
            PG8_LDB(B1, 0, 1); PG8_STAGE(PG8_SB(0, 0), b2, voffB);
            PG8_BAR; PG8_WAIT_L(0); PG8_MMA(0, 1, At, B1); PG8_BAR;
            PG8_LDA(At, 0, 1); PG8_STAGE(PG8_SA(0, 0), a2, voffA);
            PG8_BAR; PG8_WAIT_L(0); PG8_MMA(1, 0, At, B0); PG8_BAR; PG8_SCHED;
            PG8_STAGE(PG8_SB(0, 1), b2 + hstepB, voffB);
            PG8_WAIT_V(6); PG8_BAR; PG8_MMA(1, 1, At, B1); PG8_BAR;
            PG8_LDB(B0, 1, 0); PG8_SCHED; PG8_LDA(At, 1, 0); PG8_STAGE(PG8_SA(0, 1), a2 + hstepA, voffA);
            PG8_WAIT_L(8); PG8_BAR; PG8_WAIT_L(0); PG8_MMA(0, 0, At, B0); PG8_BAR; PG8_SCHED;
            PG8_LDB(B1, 1, 1); PG8_STAGE(PG8_SB(1, 0), b3, voffB);
            PG8_BAR; PG8_WAIT_L(0); PG8_MMA(0, 1, At, B1); PG8_BAR;
            PG8_LDA(At, 1, 1); PG8_STAGE(PG8_SA(1, 0), a3, voffA);
            PG8_BAR; PG8_WAIT_L(0); PG8_MMA(1, 0, At, B0); PG8_BAR; PG8_SCHED;
            PG8_STAGE(PG8_SB(1, 1), b3 + hstepB, voffB);
            PG8_WAIT_V(6); PG8_BAR; PG8_MMA(1, 1, At, B1); PG8_BAR;
            }
        }
        if constexpr (ALIGN_EPI) { if (wr == 0) PG8_BAR; }
        if constexpr (!Epi::AFTER_DRAIN) { E(acc, cur, wr, wc, fr, fq); S.done(cur); }
        if (!has_next) break;
#pragma unroll
        for (int a = 0; a < 2; ++a)
#pragma unroll
            for (int b = 0; b < 2; ++b)
#pragma unroll
                for (int m = 0; m < 4; ++m)
#pragma unroll
                    for (int n = 0; n < 2; ++n) acc[a][b][m][n] = AccT{};
        cur = nxt; cA = nA; cB = nB; ++ui;
        if constexpr (ALIGN_EPI) { if (wr == 1) PG8_BAR; }
    }
    PG8_WAIT_V(0);
    if constexpr (!ALIGN_EPI) { if (wr == 0) PG8_BAR; }
    PG8_BAR;
    if constexpr (Epi::AFTER_DRAIN) { E.fused(acc, cur, wr, wc, fr, fq, lds, wid, lane); S.done(cur); }
#undef PG8_SA
#undef PG8_SB
#undef PG8_STAGE
#undef PG8_LDA
#undef PG8_LDB
#undef PG8_MMA
#undef PG8_WAIT_V
#undef PG8_WAIT_L
#undef PG8_BAR
#undef PG8_SCHED
}
}
namespace at {
typedef unsigned short bf16;
typedef short bf16x8 __attribute__((ext_vector_type(8)));
typedef short s16x4 __attribute__((ext_vector_type(4)));
typedef float f32x16 __attribute__((ext_vector_type(16)));
typedef float f32x4 __attribute__((ext_vector_type(4)));
typedef unsigned u32x4 __attribute__((ext_vector_type(4)));
constexpr int D = 128;
constexpr float SCALE = 0.08838834764831845f, INV_SCALE = 11.313708498984761f, THR = 8.f;
constexpr int NW = 8, QBLK = 32, KVBLK = 64, QB = NW * QBLK;
constexpr int SHM_V = KVBLK * D * 2, SHM_K = KVBLK * D * 2;
constexpr int LDS_ATT = 2 * SHM_V + 2 * SHM_K + NW * 64 * 4;
constexpr int BIAS_OFF = LDS_ATT, JLW_OFF = BIAS_OFF + 8192 * 4, LDS_TOTAL = JLW_OFF + 16;

#define KSWZ(row, colB) ((row) * 256 + ((colB) ^ (((row) & 7) << 4)))
#define SBAR() __builtin_amdgcn_sched_barrier(0)
#define LBAR() do { asm volatile("s_waitcnt lgkmcnt(0)" ::: "memory"); __builtin_amdgcn_s_barrier(); asm volatile("" ::: "memory"); } while (0)
__device__ __forceinline__ int v_st(int k, int c) { const int kk = (k & ~0xC) | ((k & 4) << 1) | ((k & 8) >> 1); return ((kk >> 3) * 4 + (c >> 5)) * 512 + ((kk & 7) * 32 + (c & 31)) * 2; }
__device__ __forceinline__ int v_rd_base(int lane) { return ((lane & 3) << 3) | (((lane >> 2) & 3) << 6) | (((lane >> 4) & 1) << 5) | (((lane >> 5) & 1) << 8); }
constexpr int v_rd_off(int d0, int ks, int half) { return d0 * 512 + ks * 4096 + half * 2048; }
__device__ __forceinline__ int crow(int r, int hi) { return (r & 3) + 8 * (r >> 2) + 4 * hi; }
__device__ __forceinline__ unsigned cvtpk(float lo, float hi) { unsigned r; asm volatile("v_cvt_pk_bf16_f32 %0, %1, %2" : "=v"(r) : "v"(lo), "v"(hi)); return r; }
__device__ __forceinline__ bf16x8 load8(const bf16* p) { return *reinterpret_cast<const bf16x8*>(p); }
__device__ __forceinline__ void mask_tile(f32x16& p0, f32x16& p1, int dq, unsigned W) {
    const float NEG = -__builtin_inff();
#pragma unroll
    for (int r = 0; r < 16; ++r) {
        const int c = (r & 3) + 8 * (r >> 2);
        if ((unsigned)(dq - c) >= W) p0[r] = NEG;
        if ((unsigned)(dq - c - 32) >= W) p1[r] = NEG;
    }
}
__device__ __forceinline__ void partialSM(f32x16& p0, f32x16& p1, float& m_reg, float& mn, float& alpha) {
    float pmax = p0[0]; for (int r = 1; r < 16; ++r) pmax = fmaxf(pmax, p0[r]); for (int r = 0; r < 16; ++r) pmax = fmaxf(pmax, p1[r]);
    { auto rr = __builtin_amdgcn_permlane32_swap(__float_as_uint(pmax), __float_as_uint(pmax), false, false);
      pmax = fmaxf(__uint_as_float(rr[0]), __uint_as_float(rr[1])); }
    constexpr float C2 = 1.4426950408889634f * SCALE;
    if (__builtin_expect(__all((pmax - m_reg) * SCALE <= THR), 1)) { mn = m_reg; alpha = 1.f; }
    else { mn = fmaxf(m_reg, pmax); alpha = __builtin_amdgcn_exp2f((m_reg - mn) * C2); m_reg = mn; }
    const float mnL = -mn * C2;
    for (int r = 0; r < 16; ++r) p0[r] = fmaf(p0[r], C2, mnL); for (int r = 0; r < 16; ++r) p1[r] = fmaf(p1[r], C2, mnL);
    for (int r = 0; r < 16; ++r) p0[r] = __builtin_amdgcn_exp2f(p0[r]);
}
__device__ __forceinline__ void finishSM(f32x16& p0, f32x16& p1, float alpha, float& l_reg, bf16x8& pa0, bf16x8& pa1, bf16x8& pa2, bf16x8& pa3) {
    for (int r = 0; r < 16; ++r) p1[r] = __builtin_amdgcn_exp2f(p1[r]);
    float ps = 0; for (int r = 0; r < 16; ++r) ps += p0[r]; for (int r = 0; r < 16; ++r) ps += p1[r];
    { auto rr = __builtin_amdgcn_permlane32_swap(__float_as_uint(ps), __float_as_uint(ps), false, false);
      ps = __uint_as_float(rr[0]) + __uint_as_float(rr[1]); }
    l_reg = l_reg * alpha + ps;
#define PK4(P, B_, OUT) do { unsigned a0 = cvtpk(P[B_+0], P[B_+1]), a1 = cvtpk(P[B_+2], P[B_+3]);                          \
        unsigned b0 = cvtpk(P[B_+4], P[B_+5]), b1 = cvtpk(P[B_+6], P[B_+7]);                                             \
        auto r0 = __builtin_amdgcn_permlane32_swap(a0, b0, false, false); auto r1 = __builtin_amdgcn_permlane32_swap(a1, b1, false, false); \
        u32x4 w = {r0[0], r1[0], r0[1], r1[1]}; OUT = *reinterpret_cast<bf16x8*>(&w); } while (0)
    PK4(p0, 0, pa0); PK4(p0, 8, pa1); PK4(p1, 0, pa2); PK4(p1, 8, pa3);
#undef PK4
}
template <int KB, bool SK>
__device__ __forceinline__ void qkt(f32x16& p0, f32x16& p1, const char* K_lds, int r32, int hi, const bf16x8* qr, bool act) {
    if (SK && !act) { const float NEG = -__builtin_inff();
#pragma unroll
        for (int r = 0; r < 16; ++r) { p0[r] = NEG; p1[r] = NEG; } return; }
    p0 = f32x16{}; p1 = f32x16{};
    const char* kb[4];
#pragma unroll
    for (int dd = 0; dd < 4; ++dd) kb[dd] = K_lds + KB * SHM_K + KSWZ(r32, (dd * 16 + hi * 8) * 2);
#pragma unroll
    for (int d0 = 0; d0 < 8; ++d0) { const char* a = kb[d0 & 3] + (d0 >> 2) * 128;
        bf16x8 b0 = *reinterpret_cast<const bf16x8*>(a);
        bf16x8 b1 = *reinterpret_cast<const bf16x8*>(a + 32 * 256);
        p0 = __builtin_amdgcn_mfma_f32_32x32x16_bf16(b0, qr[d0], p0, 0, 0, 0);
        p1 = __builtin_amdgcn_mfma_f32_32x32x16_bf16(b1, qr[d0], p1, 0, 0, 0); }
}
template <int VB, bool SK>
__device__ __forceinline__ void pv_tile(f32x16* o, int vb0, bf16x8 pa0, bf16x8 pa1, bf16x8 pa2, bf16x8 pa3, bool act) {
    if (SK && !act) return;
#define TRRD(dst, off) asm volatile("ds_read_b64_tr_b16 %0, %1 offset:%2" : "=&v"(dst) : "v"(vb0), "i"(off) : "memory")
#define PV_D0(d0) do { s16x4 l0, l1, l2, l3, h0, h1, h2, h3; constexpr int b_ = VB * SHM_V + v_rd_off(d0, 0, 0); \
        TRRD(l0, b_); TRRD(h0, b_ + 2048); TRRD(l1, b_ + 4096); TRRD(h1, b_ + 6144); TRRD(l2, b_ + 8192); TRRD(h2, b_ + 10240); TRRD(l3, b_ + 12288); TRRD(h3, b_ + 14336); \
        asm volatile("s_waitcnt lgkmcnt(0)" ::: "memory"); SBAR();   \
        o[d0] = __builtin_amdgcn_mfma_f32_32x32x16_bf16(pa0, (bf16x8){l0[0], l0[1], l0[2], l0[3], h0[0], h0[1], h0[2], h0[3]}, o[d0], 0, 0, 0);   \
        o[d0] = __builtin_amdgcn_mfma_f32_32x32x16_bf16(pa1, (bf16x8){l1[0], l1[1], l1[2], l1[3], h1[0], h1[1], h1[2], h1[3]}, o[d0], 0, 0, 0);   \
        o[d0] = __builtin_amdgcn_mfma_f32_32x32x16_bf16(pa2, (bf16x8){l2[0], l2[1], l2[2], l2[3], h2[0], h2[1], h2[2], h2[3]}, o[d0], 0, 0, 0);   \
        o[d0] = __builtin_amdgcn_mfma_f32_32x32x16_bf16(pa3, (bf16x8){l3[0], l3[1], l3[2], l3[3], h3[0], h3[1], h3[2], h3[3]}, o[d0], 0, 0, 0); } while (0)
    PV_D0(0); PV_D0(1); PV_D0(2); PV_D0(3);
#undef PV_D0
#undef TRRD
}
struct BlkRef { const bf16* Q; const bf16* K; const bf16* V; bf16* O; float* LSE; const float* CUM; int P0, pq, po, pl, skv; float thr; };
struct Seam { bf16x8 qr[8]; bf16x8 st_v0[1], st_v1[1], st_k0[1], st_k1[1]; int jlo; };
__device__ __forceinline__ int swa_jlo(int P0, int W) { const int lowk = P0 - W + 1; return lowk > 0 ? lowk / KVBLK : 0; }
#define ROW(p, k0, rr, pit) ((p) + (size_t)((k0) + (rr)) * (pit) + sc)
#define VMW() asm volatile("s_waitcnt vmcnt(0)" ::: "memory")
#define VMWN(n) asm volatile("s_waitcnt vmcnt(%0)" :: "i"(n) : "memory")
#define SLOAD_H(Z, Kp, Vp, k0, pit) do { S.st_v0[Z] = load8(ROW(Vp, k0, sr, pit)); S.st_v1[Z] = load8(ROW(Vp, k0, 32 + sr, pit));              \
                         S.st_k0[Z] = load8(ROW(Kp, k0, sr, pit)); S.st_k1[Z] = load8(ROW(Kp, k0, 32 + sr, pit)); } while (0)
#define SWRITE_HK(Z, bf) do { *(bf16x8*)(K_lds + (bf) * SHM_K + kws) = S.st_k0[Z]; *(bf16x8*)(K_lds + (bf) * SHM_K + kws + 32 * 256) = S.st_k1[Z]; } while (0)
#define SWRITE_HV(Z, bf) do { *(bf16x8*)(V_lds + (bf) * SHM_V + vst0) = S.st_v0[Z]; *(bf16x8*)(V_lds + (bf) * SHM_V + vst1) = S.st_v1[Z]; } while (0)
#define SWRITE_H(Z, bf) do { SWRITE_HV(Z, bf); SWRITE_HK(Z, bf); } while (0)
__device__ __forceinline__ int fox_jlo(const BlkRef& R, char* lds) {
    int tid = threadIdx.x; asm volatile("" : "+v"(tid));
    int* jlw = (int*)(lds + JLW_OFF); int nt0 = R.P0 / KVBLK; asm volatile("" : "+s"(nt0));
    if (tid == 0) *jlw = nt0;
    __syncthreads();
    if (tid < nt0) { if (R.CUM[R.P0] - R.CUM[KVBLK * tid + KVBLK - 1] >= -R.thr) atomicMin(jlw, tid); }
    __syncthreads();
    return *jlw;
}
template <bool FOX>
__device__ __forceinline__ void attn_prime(const BlkRef& cur, int W, char* lds, Seam& S) {
    int tid = threadIdx.x; asm volatile("" : "+v"(tid));
    const int wid = __builtin_amdgcn_readfirstlane(tid >> 6), lane = tid & 63, r32 = lane & 31, hi = lane >> 5;
    const int sr = tid >> 4, sc = (tid & 15) * 8, kws = KSWZ(sr, sc * 2); char* K_lds = lds + 2 * SHM_V;
    S.jlo = FOX ? fox_jlo(cur, lds) : swa_jlo(cur.P0, W);
    const int kb0 = S.jlo * KVBLK;
    for (int d0 = 0; d0 < 8; ++d0) S.qr[d0] = load8(cur.Q + (size_t)(wid * QBLK + r32) * cur.pq + d0 * 16 + hi * 8);
    SLOAD_H(0, cur.K, cur.V, kb0, cur.pq); VMW(); SWRITE_HK(0, 0);
    __syncthreads();
}
template <bool FOX, bool SK, int W>
__device__ __forceinline__ void attn_block(const BlkRef& cur, const BlkRef& nxt, char* lds, Seam& S) {
    int tid = threadIdx.x; asm volatile("" : "+v"(tid));
    const int wid = __builtin_amdgcn_readfirstlane(tid >> 6), lane = tid & 63, r32 = lane & 31, hi = lane >> 5;
    const int j_lo = S.jlo;
    int j_hi = (cur.P0 + QB - 1) / KVBLK + 1; if (j_hi > cur.skv / KVBLK) j_hi = cur.skv / KVBLK;
    const int NT = j_hi - j_lo;
    const int qlo = cur.P0 + wid * QBLK, qm = qlo + r32 - 4 * hi;
    char* V_lds = lds; char* K_lds = lds + 2 * SHM_V;
    float* ws = (float*)(lds + 2 * SHM_V + 2 * SHM_K) + wid * 64; float* li_l = ws, * al_l = ws + 32;
    float* bias = (float*)(lds + BIAS_OFF);
    const int sr = tid >> 4, sc = (tid & 15) * 8, vst0 = v_st(sr, sc), vst1 = v_st(32 + sr, sc), kws = KSWZ(sr, sc * 2);
    const int vb0 = (int)(uintptr_t)V_lds + v_rd_base(lane);
    const bf16* Kh = cur.K; const bf16* Vh = cur.V; const int pq = cur.pq;
    if (FOX) {
        const float cref = cur.CUM[cur.P0]; const int nb_ = cur.P0 + QB;
        for (int j = j_lo * KVBLK + tid; j < nb_; j += NW * 64) bias[j] = (cref - cur.CUM[j]) * INV_SCALE;
    }
    if (FOX) __syncthreads();
    float m_reg = -1e30f, l_reg = 0; f32x16 o[4] = {};
#define RESC(a) do { if (__any((a) < 1.f)) { if (hi == 0) al_l[r32] = (a); asm volatile("s_waitcnt lgkmcnt(0)" ::: "memory");              \
                     for (int d_ = 0; d_ < 4; ++d_) for (int r = 0; r < 16; ++r) o[d_][r] *= al_l[crow(r, hi)]; } } while (0)
#define KBASE(t) ((j_lo + (t)) * KVBLK)
#define ACT(t) (KBASE(t) <= qlo + QBLK - 1 && KBASE(t) + KVBLK - 1 >= qlo - W + 1)
#define MASKT(P0_, P1_, t) do { const int kb_ = KBASE(t); \
        if (FOX) { const float* bp_ = bias + kb_ + 4 * hi; _Pragma("unroll") for (int g_ = 0; g_ < 4; ++g_) { const f32x4 b0_ = *(const f32x4*)(bp_ + 8 * g_), b1_ = *(const f32x4*)(bp_ + 32 + 8 * g_); \
            _Pragma("unroll") for (int e_ = 0; e_ < 4; ++e_) { P0_[4 * g_ + e_] += b0_[e_]; P1_[4 * g_ + e_] += b1_[e_]; } } } \
        if ((!SK || ACT(t)) && (kb_ + KVBLK - 1 > qlo || kb_ <= qlo + QBLK - 1 - W)) mask_tile(P0_, P1_, qm - kb_, (unsigned)W); } while (0)
    f32x16 pA0, pA1, pB0, pB1; float mnA, mnB, alA, alB; bf16x8 pa0, pa1, pa2, pa3;
    SWRITE_HV(0, 0); SBAR();
    if (NT > 1) { SLOAD_H(0, Kh, Vh, KBASE(1), pq); }
    SBAR(); qkt<0, SK>(pA0, pA1, K_lds, r32, hi, S.qr, ACT(0));
    MASKT(pA0, pA1, 0); partialSM(pA0, pA1, m_reg, mnA, alA);
    if (NT > 1) { VMW(); SWRITE_H(0, 1); }
    __syncthreads();
#define HALF_STEP(PX0, PX1, mnX, alX, PY0, PY1, alY, t, KB, VB, SB) do {                                                      \
        SBAR(); qkt<KB, SK>(PX0, PX1, K_lds, r32, hi, S.qr, ACT(t));                                             \
        finishSM(PY0, PY1, alY, l_reg, pa0, pa1, pa2, pa3); SBAR();                                                           \
        if ((t) + 1 < NT) { SLOAD_H(0, Kh, Vh, KBASE((t) + 1), pq); SBAR(); }                                               \
        pv_tile<VB, SK>(o, vb0, pa0, pa1, pa2, pa3, ACT((t) - 1)); MASKT(PX0, PX1, (t)); partialSM(PX0, PX1, m_reg, mnX, alX);                                        \
        __syncthreads();                                                                                                      \
        if ((t) + 1 < NT) { VMW(); SWRITE_H(0, SB); }                                                                          \
        RESC(alX); __syncthreads(); } while (0)
    for (int t = 1; t + 1 < NT; t += 2) {
        HALF_STEP(pB0, pB1, mnB, alB, pA0, pA1, alA, t, 1, 0, 0);
        HALF_STEP(pA0, pA1, mnA, alA, pB0, pB1, alB, t + 1, 0, 1, 1);
    }
    const bool even = (NT & 1) == 0;
    if (even) { SBAR(); qkt<1, SK>(pB0, pB1, K_lds, r32, hi, S.qr, ACT(NT - 1)); SBAR(); }
    const int jln = FOX ? fox_jlo(nxt, lds) : swa_jlo(nxt.P0, W); const int kbn = jln * KVBLK; S.jlo = jln;
    SLOAD_H(0, nxt.K, nxt.V, kbn, nxt.pq); SBAR();
#pragma unroll
    for (int d0 = 0; d0 < 8; ++d0) S.qr[d0] = load8(nxt.Q + (size_t)(wid * QBLK + r32) * nxt.pq + d0 * 16 + hi * 8);
    SBAR();
    finishSM(pA0, pA1, alA, l_reg, pa0, pa1, pa2, pa3); SBAR();
    pv_tile<0, SK>(o, vb0, pa0, pa1, pa2, pa3, ACT(even ? NT - 2 : NT - 1));
    if (even) { MASKT(pB0, pB1, NT - 1); partialSM(pB0, pB1, m_reg, mnB, alB); __syncthreads(); RESC(alB);
        finishSM(pB0, pB1, alB, l_reg, pa0, pa1, pa2, pa3); SBAR(); pv_tile<1, SK>(o, vb0, pa0, pa1, pa2, pa3, ACT(NT - 1)); }
    SBAR(); VMWN(8); SWRITE_HK(0, 0); SBAR();
    if (hi == 0) li_l[r32] = l_reg; asm volatile("s_waitcnt lgkmcnt(0)" ::: "memory");
    if (!FOX) { if (hi == 0) cur.LSE[(size_t)(wid * QBLK + r32) * cur.pl] = m_reg * SCALE + __logf(l_reg); }
    float rli[16];
#pragma unroll
    for (int r = 0; r < 16; ++r) rli[r] = __builtin_amdgcn_rcpf(li_l[crow(r, hi)]);
    bf16* Ow = cur.O + (size_t)(wid * QBLK) * cur.po;
#pragma unroll
    for (int r = 0; r < 16; ++r) { const int orow = crow(r, hi);
#pragma unroll
        for (int d0 = 0; d0 < 4; ++d0) { const float v = o[d0][r] * rli[r];
            const float vn = __shfl_xor(v, 1);
            if ((r32 & 1) == 0) *(unsigned*)(Ow + (size_t)orow * cur.po + d0 * 32 + r32) = cvtpk(v, vn); } }
    __syncthreads();
#undef RESC
#undef KBASE
#undef ACT
#undef MASKT
#undef HALF_STEP
}
#undef ROW
#undef VMW
#undef VMWN
#undef SLOAD_H
#undef SWRITE_HK
#undef SWRITE_HV
#undef SWRITE_H
}
#define LAS __attribute__((address_space(3)))
#define XB_TMO      128
#define XB_XCNT(j)  (256  + 64 * (j))
#define XB_XSUB(j)  (1280 + 64 * (j))
#define XB_XGEN(j)  (2304 + 64 * (j))
#define XB_TOP      3328
#define XB_TOPGEN   3392
#define XCD_BAR_WORDS 3456
#define XB_SPIN_CAP (1u << 18)

__device__ __forceinline__ unsigned xb_ld(unsigned* p)              { return __hip_atomic_load(p, __ATOMIC_RELAXED, __HIP_MEMORY_SCOPE_AGENT); }
__device__ __forceinline__ unsigned xb_add(unsigned* p, unsigned v) { return __hip_atomic_fetch_add(p, v, __ATOMIC_RELAXED, __HIP_MEMORY_SCOPE_AGENT); }
__device__ __forceinline__ unsigned xb_xcc_id() { return (unsigned)__builtin_amdgcn_s_getreg((3 << 11) | 20) & 0xFu; }
#define XB_SPIN(cond, bar) do { unsigned _sp = 0; while (cond) { __builtin_amdgcn_s_sleep(1); \
    if ((++_sp & 255u) == 0u) { if (xb_ld(&(bar)[XB_TMO])) break; if (_sp > XB_SPIN_CAP) { atomicAdd(&(bar)[XB_TMO], 1u); break; } } } } while (0)

struct XcdBarrier {
    unsigned* bar; unsigned x;
    volatile LAS unsigned* st;
};

__device__ __forceinline__ XcdBarrier xcd_barrier_post(unsigned* bar, volatile LAS unsigned* st) {
    XcdBarrier b; b.bar = bar; b.x = xb_xcc_id(); b.st = st;
    if (threadIdx.x == 0) (void)xb_add(&bar[XB_XCNT(b.x)], 1u);
    return b;
}
__device__ __forceinline__ void xcd_barrier_complete(unsigned* bar, unsigned x, unsigned& nloc, unsigned& nx) {
    const unsigned G = gridDim.x * gridDim.y * gridDim.z;
    unsigned sum, cnt, mine, sp = 0u;
    for (;;) {
        sum = 0u; cnt = 0u; mine = 0u;
#pragma unroll
        for (unsigned j = 0; j < 16; ++j) { const unsigned c = xb_ld(&bar[XB_XCNT(j)]); sum += c; cnt += (c > 0u) ? 1u : 0u; mine = (j == x) ? c : mine; }
        if (sum == G) break;
        __builtin_amdgcn_s_sleep(1);
        if ((++sp & 255u) == 0u) { if (xb_ld(&bar[XB_TMO])) break; if (sp > XB_SPIN_CAP) { atomicAdd(&bar[XB_TMO], 1u); break; } }
    }
    nloc = mine > 0u ? mine : 1u; nx = cnt > 0u ? cnt : 1u;
}

__device__ __forceinline__ void xcd_barrier(const XcdBarrier& b) {
    asm volatile("s_waitcnt vmcnt(0)" ::: "memory");
    __syncthreads();
    if (threadIdx.x == 0) {
        unsigned* bar = b.bar;
        __builtin_amdgcn_s_waitcnt(0);
        unsigned nloc = b.st[0], nx = b.st[1];
        if (nloc == 0u) { xcd_barrier_complete(bar, b.x, nloc, nx); b.st[0] = nloc; b.st[1] = nx; }
        const unsigned old = xb_add(&bar[XB_XSUB(b.x)], 1u);
        const unsigned gen = old / nloc;
        if (old + 1u == (gen + 1u) * nloc) {
            __builtin_amdgcn_fence(__ATOMIC_RELEASE, "agent");
            asm volatile("s_waitcnt vmcnt(0)" ::: "memory");
            const unsigned og = xb_add(&bar[XB_TOP], 1u);
            const unsigned tg = og / nx;
            if (og + 1u == (tg + 1u) * nx) xb_add(&bar[XB_TOPGEN], 1u);
            else XB_SPIN(xb_ld(&bar[XB_TOPGEN]) == tg, bar);
            __builtin_amdgcn_fence(__ATOMIC_ACQUIRE, "agent");
            xb_add(&bar[XB_XGEN(b.x)], 1u);
            asm volatile("s_waitcnt vmcnt(0)" ::: "memory");
        } else {
            XB_SPIN(xb_ld(&bar[XB_XGEN(b.x)]) == gen, bar);
            __builtin_amdgcn_fence(__ATOMIC_ACQUIRE, "agent");
            asm volatile("s_waitcnt vmcnt(0)" ::: "memory");
        }
    }
    __syncthreads();
}
constexpr int BATCH = 4, SEQ = 8192, DM = 2048, M = BATCH * SEQ, NH = 12, HD = 128, WA = 1536, DEPTH = 4;
constexpr int NIN = 16396, NPAD = 16640;
constexpr int C_QA = 0, C_KA = 1536, C_VA = 3072, C_ZA = 4608, C_QB = 6144, C_KB = 7680, C_VB = 9216, C_ZB = 10752, C_G = 12288, C_F = 16384;
constexpr float LN_EPS = 1e-5f, ALPHA = 1.6817928305074290f;
constexpr size_t MiB = 1u << 20;
constexpr size_t WS_XB = 0, WS_WIN = 128 * MiB, WS_WUA = 388 * MiB, WS_WUB = 412 * MiB, WS_WOUT = 436 * MiB, WS_H = 468 * MiB, WS_OA = 1508 * MiB,
                 WS_LSE = 1796 * MiB, WS_LOGF = 1802 * MiB, WS_CUM = 1804 * MiB, WS_COS = 1806 * MiB, WS_SIN = 1808 * MiB, WS_NRM = 1810 * MiB, WS_SC = 1811 * MiB, WS_BAR = 1812 * MiB, WS_END = 1813 * MiB;
constexpr size_t SC_SX = 0, SC_SAA = 32768, SC_SAB = 65536, SC_SWIN = 98304, SC_SWUA = SC_SWIN + 4 * 16640, SC_SWUB = SC_SWUA + 4 * 2048, SC_CSIN = SC_SWUB + 4 * 2048, SC_SWOUT = SC_CSIN + 4 * 16640;
constexpr size_t WS_STATS = WS_BAR + 65536;
constexpr size_t WS_SM = WS_BAR + 393216;
constexpr size_t WS_MF = WS_OA + 96 * MiB;
constexpr size_t OA_STRIDE = (size_t)M * WA, LSE_STRIDE = (size_t)M * NH;
constexpr int LDS_BYTES = 147456, LDS_BARST_OFF = 139264;
constexpr int NPH = 2 + 7 * DEPTH;
typedef unsigned short bf16;
typedef float f32x4 __attribute__((ext_vector_type(4)));
typedef unsigned u32x4 __attribute__((ext_vector_type(4)));

__device__ __forceinline__ unsigned f2bf(float f) { unsigned u = __builtin_bit_cast(unsigned, f); return (u + 0x7fffu + ((u >> 16) & 1u)) >> 16; }
__device__ __forceinline__ unsigned pk2(float lo, float hi) { return f2bf(lo) | (f2bf(hi) << 16); }
__device__ __forceinline__ float bflo(unsigned w) { return __uint_as_float(w << 16); }
__device__ __forceinline__ float bfhi(unsigned w) { return __uint_as_float(w & 0xffff0000u); }
__device__ __forceinline__ float wave_sum(float v) {
#pragma unroll
    for (int o = 1; o < 64; o <<= 1) v += __shfl_xor(v, o);
    return v;
}
__device__ __forceinline__ int in_src_col(int n) {
    if (n < C_VA) { const int hb = n >> 7, p = n & 127; return hb * 128 + 4 * (p >> 3) + (p & 3) + 64 * ((p >> 2) & 1); }
    if (n < C_G) return n;
    if (n < C_F) return n + 12;
    if (n < C_F + 12) return n - C_F + 12288;
    return -1;
}
__device__ __forceinline__ unsigned q8(float v) { return (unsigned)__float2int_rn(v) & 0xffu; }
__device__ __forceinline__ unsigned pack4q(float a, float b, float c, float d) { return q8(a) | (q8(b) << 8) | (q8(c) << 16) | (q8(d) << 24); }
__device__ __forceinline__ float wave_max(float v) {
#pragma unroll
    for (int o = 1; o < 64; o <<= 1) v = fmaxf(v, __shfl_xor(v, o));
    return v;
}
__device__ __forceinline__ void quant_row(const f32x4 (&v)[8], unsigned char* qrow, float* scale, int lane) {
    float amax = 0.f;
#pragma unroll
    for (int j = 0; j < 8; ++j) amax = fmaxf(amax, fmaxf(fmaxf(fabsf(v[j][0]), fabsf(v[j][1])), fmaxf(fabsf(v[j][2]), fabsf(v[j][3]))));
    amax = wave_max(amax); const float inv = amax > 0.f ? 127.f / amax : 0.f;
#pragma unroll
    for (int j = 0; j < 8; ++j) *(unsigned*)(qrow + 4 * lane + 256 * j) = pack4q(v[j][0] * inv, v[j][1] * inv, v[j][2] * inv, v[j][3] * inv);
    if (lane == 0) *scale = amax > 0.f ? amax * (1.f / 127.f) : 1.f;
}

template <bool MAP>
__device__ __forceinline__ void quant_tile(const float* W, int K, int N, const float* cs, unsigned char* WT, float* swout, unsigned* t, int item, int nblk, int lane) {
    const int kb = item / nblk, nb = item - kb * nblk, k0 = 64 * kb, nn = 64 * nb + lane, src = MAP ? in_src_col(nn) : nn;
    const float sc = src >= 0 ? cs[src] : 1.f, inv = src >= 0 ? 1.f / sc : 0.f;
    if (swout && kb == 0) swout[nn] = sc;
    const float* wp = W + (size_t)k0 * N + (src >= 0 ? src : 0);
#pragma unroll 4
    for (int s = 0; s < 16; ++s) { const float v0 = wp[(size_t)(4 * s) * N], v1 = wp[(size_t)(4 * s + 1) * N], v2 = wp[(size_t)(4 * s + 2) * N], v3 = wp[(size_t)(4 * s + 3) * N];
        t[lane * 17 + s] = pack4q(v0 * inv, v1 * inv, v2 * inv, v3 * inv); }
    asm volatile("s_waitcnt lgkmcnt(0)" ::: "memory");
#pragma unroll
    for (int j = 0; j < 4; ++j) { const int idx = lane + 64 * j, n = idx >> 2, c = idx & 3; const unsigned* s = t + n * 17 + 4 * c;
        u32x4 o; o.x = s[0]; o.y = s[1]; o.z = s[2]; o.w = s[3];
        *(u32x4*)(WT + (size_t)(64 * nb + n) * K + k0 + 16 * c) = o; }
    asm volatile("s_waitcnt lgkmcnt(0)" ::: "memory");
}

struct Args { const float* in[9]; float* out; unsigned char* ws; int ph_lo, ph_hi; };

__global__ void __launch_bounds__(512, 2) mega_fwd(Args args) {
    extern __shared__ __attribute__((aligned(16))) unsigned char lds[];
    cg::grid_group grid = cg::this_grid();
    const int G = gridDim.x, bx = blockIdx.x, NGW = G * 8;
#define PH_IDS int tid = threadIdx.x; asm volatile("" : "+v"(tid)); const int lane = tid & 63, wave = __builtin_amdgcn_readfirstlane(tid >> 6), gw = bx * 8 + wave; (void)lane; (void)gw; PH_PTRS
#define PH_PTRS     unsigned long long wz_ = 0; asm volatile("" : "+s"(wz_)); unsigned char* ws = args.ws + wz_;     \
    const float* x_in = args.in[0]; const float* w_in = args.in[1]; const float* b_forget = args.in[2]; const float* b_gate = args.in[3]; \
    const float* w_up_a = args.in[4]; const float* w_up_b = args.in[5]; const float* w_out = args.in[6]; const float* ln_g = args.in[7]; const float* ln_b = args.in[8]; \
    float* out = args.out; \
    bf16* XB = (bf16*)(ws + WS_XB); bf16* WIN = (bf16*)(ws + WS_WIN); bf16* WUA = (bf16*)(ws + WS_WUA); bf16* WUB = (bf16*)(ws + WS_WUB); bf16* WOUT = (bf16*)(ws + WS_WOUT); \
    bf16* H = (bf16*)(ws + WS_H); bf16* OA = (bf16*)(ws + WS_OA); bf16* MF = (bf16*)(ws + WS_MF); \
    float* LSE = (float*)(ws + WS_LSE); float* LOGF = (float*)(ws + WS_LOGF); float* CUM = (float*)(ws + WS_CUM); float* COS = (float*)(ws + WS_COS); float* SIN = (float*)(ws + WS_SIN); float* NRM = (float*)(ws + WS_NRM); float* SC = (float*)(ws + WS_SC); \
    unsigned char* XQ = ws + WS_XB; unsigned char* WINQ = ws + WS_WIN; unsigned char* WUAQ = ws + WS_WUA; unsigned char* WUBQ = ws + WS_WUB; \
    (void)x_in; (void)w_in; (void)b_forget; (void)b_gate; (void)w_up_a; (void)w_up_b; (void)w_out; (void)ln_g; (void)ln_b; (void)out; (void)XB; (void)WIN; (void)WUA; (void)WUB; (void)WOUT; (void)H; (void)OA; (void)MF; (void)LSE; (void)LOGF; (void)CUM; (void)COS; (void)SIN; (void)NRM; (void)SC; (void)XQ; (void)WINQ; (void)WUAQ; (void)WUBQ
    const int lo = args.ph_lo, hi = args.ph_hi;
#define IN(k) (lo <= (k) && (k) < hi)
#ifndef XCDBAR
#define XCDBAR 1
#endif
    volatile LAS unsigned* bst = (volatile LAS unsigned*)((LAS unsigned char*)lds + LDS_BARST_OFF);
    if (threadIdx.x < 2) bst[threadIdx.x] = 0u;
    __syncthreads();
    XcdBarrier xbar = xcd_barrier_post((unsigned*)(args.ws + WS_BAR), bst);
#define SEAM(k) do { if ((k) + 1 < hi) { if (!XCDBAR || (k) == 0) grid.sync(); else xcd_barrier(xbar); } } while (0)

    if (IN(0)) { PH_IDS;
        {   float* red = (float*)lds; constexpr int CG_IN = (NIN + 255) / 256, CG_UP = DM / 256, CG_L = CG_IN + 3 * CG_UP;
            for (int it = bx; it < DEPTH * CG_L; it += G) {
                const int l = it / CG_L; int r = it - l * CG_L; const float* W; int K, N; float* cs;
                if (r < CG_IN) { W = w_in + (size_t)l * DM * NIN; K = DM; N = NIN; cs = SC + SC_CSIN + l * NPAD; }
                else if (r < CG_IN + CG_UP) { r -= CG_IN; W = w_up_a + (size_t)l * WA * DM; K = WA; N = DM; cs = SC + SC_SWUA + l * DM; }
                else if (r < CG_IN + 2 * CG_UP) { r -= CG_IN + CG_UP; W = w_up_b + (size_t)l * WA * DM; K = WA; N = DM; cs = SC + SC_SWUB + l * DM; }
                else { r -= CG_IN + 2 * CG_UP; W = w_out + (size_t)l * DM * DM; K = DM; N = DM; cs = SC + SC_SWOUT + l * DM; }
                const int col = 256 * r + 4 * lane; f32x4 mx = {0.f, 0.f, 0.f, 0.f};
                if (col < N) { const float* wp = W + col;
#pragma unroll 8
                    for (int k = wave; k < K; k += 8) { const f32x4 v = *(const f32x4*)(wp + (size_t)k * N);
                        mx[0] = fmaxf(mx[0], fabsf(v[0])); mx[1] = fmaxf(mx[1], fabsf(v[1])); mx[2] = fmaxf(mx[2], fabsf(v[2])); mx[3] = fmaxf(mx[3], fabsf(v[3])); } }
                *(f32x4*)(red + wave * 256 + 4 * lane) = mx;
                __syncthreads();
                if (tid < 256 && 256 * r + tid < N) { float m = 0.f; for (int w = 0; w < 8; ++w) m = fmaxf(m, red[w * 256 + tid]); cs[256 * r + tid] = m > 0.f ? m * (1.f / 127.f) : 1.f; }
                __syncthreads();
            }
        }
        for (int idx = bx * 512 + tid; idx < SEQ * 64; idx += G * 512) {
            const int pos = idx >> 6, i = idx & 63;
            const float inv_freq = exp2f(-(float)i * (1.f / 64.f) * 13.287712379549449f);
            const float ang = (float)pos * inv_freq;
            const double rev = (double)ang * 0.15915494309189535; const float fr = (float)(rev - floor(rev));
            COS[idx] = __builtin_amdgcn_cosf(fr); SIN[idx] = __builtin_amdgcn_sinf(fr);
        }
        for (int m = gw; m < M; m += NGW) { f32x4 v[8];
#pragma unroll
            for (int j = 0; j < 8; ++j) v[j] = *(const f32x4*)(x_in + (size_t)m * DM + 4 * lane + 256 * j);
            quant_row(v, XQ + (size_t)m * DM, SC + SC_SX + m, lane); }
        SEAM(0);
    }
    if (IN(1)) { PH_IDS;
        unsigned* t = (unsigned*)(lds + wave * 16384);
        constexpr int T_IN = (DM / 64) * (NPAD / 64), T_UP = (WA / 64) * (DM / 64), T_OUT = (DM / 64) * (DM / 64), T_L = T_IN + 2 * T_UP + T_OUT;
        for (int it = gw; it < DEPTH * T_L; it += NGW) {
            const int l = it / T_L; int r = it - l * T_L;
            if (r < T_IN) { quant_tile<true>(w_in + (size_t)l * DM * NIN, DM, NIN, SC + SC_CSIN + l * NPAD, WINQ + (size_t)l * NPAD * DM, SC + SC_SWIN + l * NPAD, t, r, NPAD / 64, lane); continue; } r -= T_IN;
            if (r < T_UP) { quant_tile<false>(w_up_a + (size_t)l * WA * DM, WA, DM, SC + SC_SWUA + l * DM, WUAQ + (size_t)l * DM * WA, nullptr, t, r, DM / 64, lane); continue; } r -= T_UP;
            if (r < T_UP) { quant_tile<false>(w_up_b + (size_t)l * WA * DM, WA, DM, SC + SC_SWUB + l * DM, WUBQ + (size_t)l * DM * WA, nullptr, t, r, DM / 64, lane); continue; } r -= T_UP;
            quant_tile<false>(w_out + (size_t)l * DM * DM, DM, DM, SC + SC_SWOUT + l * DM, ws + WS_WOUT + (size_t)l * DM * DM, nullptr, t, r, DM / 64, lane);
        }
        SEAM(1);
    }

    for (int l = 0; l < DEPTH; ++l) {
        const int pb = 2 + 7 * l;
        if (IN(pb + 0)) { PH_IDS;
            if (bx == 0 && tid < 96) NRM[tid] = 0.f;
            pg8::Gemm g{(const bf16*)XQ, (const bf16*)(WINQ + (size_t)l * NPAD * DM), M, NPAD, DM / 2, DM / 2};   pg8::StaticOrder S; S.init(M, NPAD, G, bx);
            pg8::EpiIn E{H, NPAD, COS, SIN, LOGF, b_forget + l * NH, SC + SC_SX, SC + SC_SWIN + l * NPAD};
            pg8::gemm_phase<pg8::EpiIn, pg8::StaticOrder, true, true, true>((PG8_LAS unsigned char*)lds, g, S, E);
            SEAM(pb + 0);
        }
        if (IN(pb + 1)) { PH_IDS;
            {
                float* red = (float*)lds;
                for (int b = 0; b < BATCH; ++b) {
                    float mq[3] = {0.f, 0.f, 0.f}, mk[3] = {0.f, 0.f, 0.f};
                    for (int s = gw; s < SEQ; s += NGW) { const bf16* hr = H + ((size_t)b * SEQ + s) * NPAD;
#pragma unroll
                        for (int j = 0; j < 3; ++j) { const u32x4 q = *(const u32x4*)(hr + C_QB + 8 * (lane + 64 * j)), k = *(const u32x4*)(hr + C_KB + 8 * (lane + 64 * j));
                            float sq = 0.f, sk = 0.f;
#pragma unroll
                            for (int e = 0; e < 4; ++e) { sq += bflo(q[e]) * bflo(q[e]) + bfhi(q[e]) * bfhi(q[e]); sk += bflo(k[e]) * bflo(k[e]) + bfhi(k[e]) * bfhi(k[e]); }
#pragma unroll
                            for (int o = 1; o < 16; o <<= 1) { sq += __shfl_xor(sq, o); sk += __shfl_xor(sk, o); }
                            mq[j] = fmaxf(mq[j], sq); mk[j] = fmaxf(mk[j], sk); } }
                    if ((lane & 15) == 0) {
#pragma unroll
                        for (int j = 0; j < 3; ++j) { red[wave * 24 + (lane >> 4) + 4 * j] = mq[j]; red[wave * 24 + 12 + (lane >> 4) + 4 * j] = mk[j]; } }
                    __syncthreads();
                    if (tid < 24) { float v = 0.f; for (int w = 0; w < 8; ++w) v = fmaxf(v, red[w * 24 + tid]); atomicMax((unsigned*)NRM + (tid < 12 ? 0 : 48) + b * NH + (tid % 12), __float_as_uint(v)); }
                    __syncthreads();
                }
            }
            if (bx < BATCH * NH) {
                const int b = bx / NH, h = bx - b * NH; float* red = (float*)lds;
                float v[16]; float run = 0.f;
#pragma unroll
                for (int j = 0; j < 16; j += 4) { const f32x4 lf = *(const f32x4*)(LOGF + (size_t)bx * SEQ + 16 * tid + j);
                    run += lf[0]; v[j] = run; run += lf[1]; v[j + 1] = run; run += lf[2]; v[j + 2] = run; run += lf[3]; v[j + 3] = run; }
                float inc = run;
#pragma unroll
                for (int o = 1; o < 64; o <<= 1) { const float t = __shfl_up(inc, o); if (lane >= o) inc += t; }
                if (lane == 63) red[wave] = inc;
                __syncthreads();
                float off = inc - run;
                for (int w = 0; w < wave; ++w) off += red[w];
                float* cp = CUM + (size_t)bx * SEQ + 16 * tid;
#pragma unroll
                for (int j = 0; j < 16; j += 4) *(f32x4*)(cp + j) = (f32x4){v[j] + off, v[j + 1] + off, v[j + 2] + off, v[j + 3] + off};
                __syncthreads();
            }
            constexpr int NIT = 3 * 1536;
            const int cnt = bx < NIT ? (NIT - bx + G - 1) / G : 0;
#define DIL_REF(R, n) do { const int L_ = bx + (n) * G;   \
            const int bh_ = L_ / 96, rb_ = L_ - bh_ * 96, b_ = bh_ / NH, h_ = bh_ - b_ * NH, g_ = rb_ >> 5, r_ = rb_ & 31, dsh = 2 * g_, d_ = 1 << dsh; \
            const int qb = r_ & ((32 >> dsh) - 1), res = r_ >> (5 - dsh); \
            const size_t tok0 = (size_t)b_ * SEQ + res, rq = (size_t)qb * 256 * d_; \
            R.Q = H + (tok0 + rq) * NPAD + C_QA + h_ * HD; R.K = H + tok0 * NPAD + C_KA + h_ * HD; R.V = H + tok0 * NPAD + C_VA + h_ * HD; \
            R.O = OA + (size_t)g_ * OA_STRIDE + (tok0 + rq) * WA + h_ * HD; R.LSE = LSE + (size_t)g_ * LSE_STRIDE + (tok0 + rq) * NH + h_; R.CUM = nullptr; \
            R.P0 = qb * 256; R.pq = d_ * NPAD; R.po = d_ * WA; R.pl = d_ * NH; R.skv = SEQ >> dsh; R.thr = 0.f; } while (0)
            if (cnt > 0) {
                at::BlkRef cur, nxt; at::Seam S{};     DIL_REF(cur, 0);
                at::attn_prime<false>(cur, 129, (char*)lds, S);
                for (int n = 0; n < cnt; ++n) {
                    if (n + 1 < cnt) DIL_REF(nxt, n + 1); else nxt = cur;
                    at::attn_block<false, true, 129>(cur, nxt, (char*)lds, S);
                    cur = nxt;
                }
            }
#undef DIL_REF
            SEAM(pb + 1);
        }
        if (IN(pb + 2)) { PH_IDS;
            constexpr int NIT = BATCH * NH * 32;
            const int cnt = bx < NIT ? (NIT - bx + G - 1) / G : 0;
#define FOX_REF(R, n) do { const int L_ = bx + (n) * G; const int bh = L_ >> 5, qb = (L_ + ((G & 31) == 0 ? 5 * (n) : 0)) & 31  , b_ = bh / NH, h_ = bh - b_ * NH; \
            R.Q = H + ((size_t)b_ * SEQ + (size_t)qb * 256) * NPAD + C_QB + h_ * HD; R.K = H + (size_t)b_ * SEQ * NPAD + C_KB + h_ * HD; R.V = H + (size_t)b_ * SEQ * NPAD + C_VB + h_ * HD; \
            R.O = (bf16*)R.Q; R.LSE = nullptr; R.CUM = CUM + (size_t)bh * SEQ; R.P0 = qb * 256; R.pq = NPAD; R.po = NPAD; R.pl = 0; R.skv = SEQ; R.thr = 30.f + 2.f * sqrtf(NRM[bh] * NRM[48 + bh]) * 0.08838834764831845f; } while (0)
            if (cnt > 0) {
                at::BlkRef cur, nxt; at::Seam S{};     FOX_REF(cur, 0);
                at::attn_prime<true>(cur, SEQ, (char*)lds, S);
                for (int n = 0; n < cnt; ++n) {
                    if (n + 1 < cnt) FOX_REF(nxt, n + 1); else nxt = cur;
                    at::attn_block<true, false, SEQ>(cur, nxt, (char*)lds, S);
                    cur = nxt;
                }
            }
#undef FOX_REF
            SEAM(pb + 2);
        }

        if (IN(pb + 3)) { PH_IDS;
            for (int m = gw; m < M; m += NGW) {
                bf16* hr = H + (size_t)m * NPAD; float va[3][8], vb[3][8]; float ama = 0.f, amb = 0.f;
                u32x4 A0[3], A1[3], A2[3], ZA[3], OB[3], ZB[3]; float L0[3], L1[3], L2[3];
#pragma unroll
                for (int j = 0; j < 3; ++j) {
                    const int col = 8 * (lane + 64 * j), hh = col >> 7; const bf16* oa = OA + (size_t)m * WA + col;
                    A0[j] = *(const u32x4*)oa; A1[j] = *(const u32x4*)(oa + OA_STRIDE); A2[j] = *(const u32x4*)(oa + 2 * OA_STRIDE); ZA[j] = *(const u32x4*)(hr + C_ZA + col);
                    OB[j] = *(const u32x4*)(hr + C_QB + col); ZB[j] = *(const u32x4*)(hr + C_ZB + col);
                    L0[j] = LSE[(size_t)m * NH + hh]; L1[j] = LSE[LSE_STRIDE + (size_t)m * NH + hh]; L2[j] = LSE[2 * LSE_STRIDE + (size_t)m * NH + hh]; }
                asm volatile("" ::: "memory");
#pragma unroll
                for (int j = 0; j < 3; ++j) {
                    const float l0 = L0[j], l1 = L1[j], l2 = L2[j];
                    const float mx = fmaxf(l0, fmaxf(l1, l2)); float e0 = __expf(l0 - mx), e1 = __expf(l1 - mx), e2 = __expf(l2 - mx);
                    const float inv = __builtin_amdgcn_rcpf(e0 + e1 + e2); e0 *= inv; e1 *= inv; e2 *= inv;
                    const u32x4 a0 = A0[j], a1 = A1[j], a2 = A2[j], za = ZA[j], ob = OB[j], zb = ZB[j];
#pragma unroll
                    for (int k = 0; k < 4; ++k) { const float zl = bflo(za[k]), zh = bfhi(za[k]), yl = bflo(zb[k]), yh = bfhi(zb[k]);
                        va[j][2 * k] = (e0 * bflo(a0[k]) + e1 * bflo(a1[k]) + e2 * bflo(a2[k])) * zl * __builtin_amdgcn_rcpf(1.f + __expf(-zl));
                        va[j][2 * k + 1] = (e0 * bfhi(a0[k]) + e1 * bfhi(a1[k]) + e2 * bfhi(a2[k])) * zh * __builtin_amdgcn_rcpf(1.f + __expf(-zh));
                        vb[j][2 * k] = bflo(ob[k]) * yl * __builtin_amdgcn_rcpf(1.f + __expf(-yl)); vb[j][2 * k + 1] = bfhi(ob[k]) * yh * __builtin_amdgcn_rcpf(1.f + __expf(-yh));
                        ama = fmaxf(ama, fmaxf(fabsf(va[j][2 * k]), fabsf(va[j][2 * k + 1]))); amb = fmaxf(amb, fmaxf(fabsf(vb[j][2 * k]), fabsf(vb[j][2 * k + 1]))); }
                }
                ama = wave_max(ama); amb = wave_max(amb);
                const float ia = ama > 0.f ? 127.f / ama : 0.f, ib = amb > 0.f ? 127.f / amb : 0.f;
                unsigned char* qa = (unsigned char*)OA + (size_t)m * (2 * WA); unsigned char* qb = (unsigned char*)(hr + C_QB);
#pragma unroll
                for (int j = 0; j < 3; ++j) { const int col = 8 * (lane + 64 * j);
                    unsigned long long pa = (unsigned long long)pack4q(va[j][0] * ia, va[j][1] * ia, va[j][2] * ia, va[j][3] * ia) | ((unsigned long long)pack4q(va[j][4] * ia, va[j][5] * ia, va[j][6] * ia, va[j][7] * ia) << 32);
                    unsigned long long pb = (unsigned long long)pack4q(vb[j][0] * ib, vb[j][1] * ib, vb[j][2] * ib, vb[j][3] * ib) | ((unsigned long long)pack4q(vb[j][4] * ib, vb[j][5] * ib, vb[j][6] * ib, vb[j][7] * ib) << 32);
                    *(unsigned long long*)(qa + col) = pa; *(unsigned long long*)(qb + col) = pb; }
                if (lane == 0) { SC[SC_SAA + m] = ama > 0.f ? ama * (1.f / 127.f) : 1.f; SC[SC_SAB + m] = amb > 0.f ? amb * (1.f / 127.f) : 1.f; }
            }
            SEAM(pb + 3);
        }

        if (IN(pb + 4)) { PH_IDS;
            { pg8::Gemm g{OA, (const bf16*)(WUAQ + (size_t)l * DM * WA), M, DM, WA / 2, WA}; pg8::StaticOrder S; S.init(M, DM, G, bx);
              pg8::EpiGate<false> E{H + C_G, NPAD, b_gate + (size_t)l * 2 * DM, nullptr, MF, DM, SC + SC_SAA, SC + SC_SWUA + l * DM};
              pg8::gemm_phase<pg8::EpiGate<false>, pg8::StaticOrder, true, true, true>((PG8_LAS unsigned char*)lds, g, S, E); }
            { pg8::Gemm g{H + C_QB, (const bf16*)(WUBQ + (size_t)l * DM * WA), M, DM, WA / 2, NPAD}; pg8::StaticOrder S; S.init(M, DM, G, bx);
              pg8::EpiGate<true> E{H + C_G + DM, NPAD, b_gate + (size_t)l * 2 * DM + DM, MF, XB, DM, SC + SC_SAB, SC + SC_SWUB + l * DM};
              pg8::gemm_phase<pg8::EpiGate<true>, pg8::StaticOrder, true, true, true>((PG8_LAS unsigned char*)lds, g, S, E); }
            SEAM(pb + 4);
        }
        if (IN(pb + 5)) { PH_IDS;
            {
                unsigned char* MQ = ws + WS_MF; float* SM = (float*)(ws + WS_SM);
                for (int m = gw; m < M; m += NGW) { u32x4 r4[4]; float amax = 0.f;
#pragma unroll
                    for (int j = 0; j < 4; ++j) { r4[j] = *(const u32x4*)(XB + (size_t)m * DM + 8 * (lane + 64 * j));
#pragma unroll
                        for (int k = 0; k < 4; ++k) amax = fmaxf(amax, fmaxf(fabsf(bflo(r4[j][k])), fabsf(bfhi(r4[j][k])))); }
                    amax = wave_max(amax); const float inv = amax > 0.f ? 127.f / amax : 0.f;
#pragma unroll
                    for (int j = 0; j < 4; ++j) { const unsigned long long p = (unsigned long long)pack4q(bflo(r4[j][0]) * inv, bfhi(r4[j][0]) * inv, bflo(r4[j][1]) * inv, bfhi(r4[j][1]) * inv) |
                            ((unsigned long long)pack4q(bflo(r4[j][2]) * inv, bfhi(r4[j][2]) * inv, bflo(r4[j][3]) * inv, bfhi(r4[j][3]) * inv) << 32);
                        *(unsigned long long*)(MQ + (size_t)m * DM + 8 * (lane + 64 * j)) = p; }
                    if (lane == 0) SM[m] = amax > 0.f ? amax * (1.f / 127.f) : 1.f; }
                if (hi - lo > 1) xcd_barrier(xbar);
            }
            pg8::Gemm g{(const bf16*)(ws + WS_MF), (const bf16*)(ws + WS_WOUT + (size_t)l * DM * DM), M, DM, DM / 2, DM / 2}; pg8::StaticOrder S; S.init(M, DM, G, bx);
            pg8::EpiOut E{l == 0 ? x_in : out, out, DM, ALPHA, l == 0 ? nullptr : (const float*)(ws + WS_STATS), ln_g + (size_t)(l > 0 ? l - 1 : 0) * DM, ln_b + (size_t)(l > 0 ? l - 1 : 0) * DM, (const float*)(ws + WS_SM), SC + SC_SWOUT + l * DM};
            pg8::gemm_phase<pg8::EpiOut, pg8::StaticOrder, true, true, true>((PG8_LAS unsigned char*)lds, g, S, E);
            SEAM(pb + 5);
        }

        if (IN(pb + 6)) { PH_IDS;
            const float* gg = ln_g + (size_t)l * DM; const float* bb = ln_b + (size_t)l * DM;
            for (int m = gw; m < M; m += NGW) {
                float* row = out + (size_t)m * DM; f32x4 v[8]; float s = 0.f;
#pragma unroll
                for (int j = 0; j < 8; ++j) { v[j] = *(const f32x4*)(row + 4 * lane + 256 * j); s += (v[j][0] + v[j][1]) + (v[j][2] + v[j][3]); }
                const float mean = wave_sum(s) * (1.f / DM); float s2 = 0.f;
#pragma unroll
                for (int j = 0; j < 8; ++j) { v[j] = v[j] - mean; s2 += (v[j][0] * v[j][0] + v[j][1] * v[j][1]) + (v[j][2] * v[j][2] + v[j][3] * v[j][3]); }
                const float rstd = 1.f / sqrtf(wave_sum(s2) * (1.f / DM) + LN_EPS);
                const bool lastl = l == DEPTH - 1;
#pragma unroll
                for (int j = 0; j < 8; ++j) { const int c = 4 * lane + 256 * j; const f32x4 gv = *(const f32x4*)(gg + c), bv = *(const f32x4*)(bb + c);
                    v[j] = v[j] * rstd * gv + bv; if (lastl) *(f32x4*)(row + c) = v[j]; }
                if (!lastl) { if (lane == 0) { float* st = (float*)(ws + WS_STATS) + 2 * (size_t)m; st[0] = mean; st[1] = rstd; }
                    quant_row(v, XQ + (size_t)m * DM, SC + SC_SX + m, lane); }
            }
            SEAM(pb + 6);
        }
    }
#undef IN
#undef SEAM
}

extern "C" void kernel_launch(void* const* d_in, const int* in_sizes, int n_in, void* d_out, int out_size, void* d_ws, size_t ws_size, hipStream_t stream) {
    static int grid = 0;
    if (grid == 0) {
        if (n_in != 9 || in_sizes[0] != M * DM || out_size != M * DM || ws_size < WS_END) { fprintf(stderr, "kernel_launch: unexpected shapes / workspace (n_in %d, ws %zu)\n", n_in, ws_size); grid = -1; return; }
        int dev = 0, cus = 0, per_cu = 0;
        (void)hipGetDevice(&dev); (void)hipDeviceGetAttribute(&cus, hipDeviceAttributeMultiprocessorCount, dev);
        if (hipFuncSetAttribute((const void*)mega_fwd, hipFuncAttributeMaxDynamicSharedMemorySize, LDS_BYTES) != hipSuccess) { fprintf(stderr, "kernel_launch: hipFuncSetAttribute failed\n"); grid = -1; return; }
        if (hipOccupancyMaxActiveBlocksPerMultiprocessor(&per_cu, (const void*)mega_fwd, 512, LDS_BYTES) != hipSuccess || per_cu < 1) { fprintf(stderr, "kernel_launch: occupancy query says %d\n", per_cu); per_cu = 1; }
        (void)hipGetLastError();
        if (cus <= 0) cus = 256;
        grid = cus * per_cu;
    }
    if (grid < 0) return;
    if (hipMemsetAsync((char*)d_ws + WS_BAR, 0, XCD_BAR_WORDS * 4, stream) != hipSuccess) { fprintf(stderr, "kernel_launch: hipMemsetAsync of the barrier words failed\n"); return; }
    Args a{};
    for (int i = 0; i < 9; ++i) a.in[i] = (const float*)d_in[i];
    a.out = (float*)d_out; a.ws = (unsigned char*)d_ws;
    a.ph_lo = 0; a.ph_hi = NPH;
    void* kargs[] = {&a};
    hipError_t e = hipLaunchCooperativeKernel((const void*)mega_fwd, dim3(grid), dim3(512), kargs, LDS_BYTES, stream);
    if (e != hipSuccess) fprintf(stderr, "kernel_launch: cooperative launch failed: %s (grid %d)\n", hipGetErrorString(e), grid);
}
```

```cpp
#include <hip/hip_runtime.h>
#include <hip/hip_cooperative_groups.h>
#include <cstdio>
#include <cstdint>
namespace cg = cooperative_groups;
namespace pg8 {
#define PG8_LAS __attribute__((address_space(3)))
typedef unsigned short bf16_t;
typedef short bf16x8 __attribute__((ext_vector_type(8)));
typedef float f32x4 __attribute__((ext_vector_type(4)));
typedef unsigned u32x4 __attribute__((ext_vector_type(4)));
constexpr int BM = 256, BK = 64, HALF = 128, HTB = HALF * BK * 2  , STAGE_BYTES = 8 * HTB, NXCD = 8, WGM = 8;

__host__ __device__ __forceinline__ int lds_byte(int r, int c) { const int st = (r >> 4) * 2 + (c >> 5), rr = r & 15, cc = c & 31, ob = rr * 64 + cc * 2; return st * 1024 + (ob ^ (((ob >> 9) & 1) << 5)); }
__host__ __device__ __forceinline__ void stage_rc(int b, int& R, int& C) { const int st = b / 1024, sb = b % 1024, swz = sb ^ (((sb >> 9) & 1) << 5); R = (st >> 1) * 16 + swz / 64; C = (st & 1) * 32 + (swz % 64) / 2; }
__host__ __device__ __forceinline__ int perm32(int rho) { const int n = rho >> 4, i = rho & 15; return 8 * (i >> 2) + 4 * n + (i & 3); }

struct Unit { int pm, pn; };
struct Gemm { const bf16_t* A; const bf16_t* Bt; int M, N, K, lda; };

struct StaticOrder {
    int nM, nN, nwg, G, c;
    __host__ __device__ void init(int M, int N, int G_, int c_) { nM = M / BM; nN = N / BM; nwg = nM * nN; G = G_; c = c_; }
    __host__ __device__ bool next(int i, Unit& u) const {
        const long L = (long)i * G + c; if (L >= nwg) return false;
        int wgid = (int)L; { const int q = nwg / NXCD, r = nwg % NXCD, xcd = wgid % NXCD, off = wgid / NXCD; wgid = (xcd < r ? xcd * (q + 1) : r * (q + 1) + (xcd - r) * q) + off; }
        const int nig = WGM * nN, gid = wgid / nig, fm = gid * WGM, gsz = (nM - fm) < WGM ? (nM - fm) : WGM;
        u.pm = fm + ((wgid % nig) % gsz); u.pn = (wgid % nig) / gsz; return true;
    }
    __device__ __forceinline__ void a_ready(const Unit&) const {}
    __device__ __forceinline__ void done(const Unit&) const {}
};

__device__ __forceinline__ unsigned cvt_pk_bf16(float lo, float hi) { unsigned r; asm volatile("v_cvt_pk_bf16_f32 %0, %1, %2" : "=v"(r) : "v"(lo), "v"(hi)); return r; }
typedef float f32x2 __attribute__((ext_vector_type(2)));
typedef unsigned u32x2 __attribute__((ext_vector_type(2)));
typedef int i32x4 __attribute__((ext_vector_type(4)));
template <bool I8> struct AccSel { typedef f32x4 type; };
template <> struct AccSel<true> { typedef i32x4 type; };
__device__ __forceinline__ f32x4 cvt4(i32x4 a, float s) { return (f32x4){(float)a[0] * s, (float)a[1] * s, (float)a[2] * s, (float)a[3] * s}; }
__device__ __forceinline__ float bf_lo(unsigned w) { return __uint_as_float(w << 16); }
__device__ __forceinline__ float bf_hi(unsigned w) { return __uint_as_float(w & 0xffff0000u); }
__device__ __forceinline__ float sigm(float z) { return __builtin_amdgcn_rcpf(1.f + __builtin_amdgcn_exp2f(-1.4426950408889634f * z)); }
__device__ __forceinline__ float logsig(float z) { return fminf(z, 0.f) - log1pf(expf(-fabsf(z))); }

struct EpiIn {
    static constexpr bool PERM = true, AFTER_DRAIN = false;
    bf16_t* H; int ldh; const float* cosT; const float* sinT; float* logf; const float* bfg; const float* sx; const float* sw;
    __device__ __forceinline__ void operator()(const i32x4 (&acc)[2][2][4][2], const Unit& u, int wr, int wc, int fr, int fq) const {
        asm volatile("" : "+v"(fr), "+v"(fq));
        const int row0 = u.pm * BM + wr * 64 + fr;
        if (u.pn == 64) {
            if (wc == 0 && fq < 2) {
                const f32x4 b0 = *(const f32x4*)(bfg + 8 * fq); const f32x4 b1 = fq == 0 ? *(const f32x4*)(bfg + 4) : (f32x4){0.f, 0.f, 0.f, 0.f};
                const f32x4 w0 = *(const f32x4*)(sw + u.pn * BM + 8 * fq), w1 = *(const f32x4*)(sw + u.pn * BM + 8 * fq + 4);
#pragma unroll
                for (int ai = 0; ai < 2; ++ai)
#pragma unroll
                    for (int m = 0; m < 4; ++m) { const int row = row0 + ai * HALF + m * 16; const float sr = sx[row];
                        float* o = logf + ((size_t)(row >> 13) * 12 + 8 * fq) * 8192 + (row & 8191);
                        const f32x4 v0 = cvt4(acc[ai][0][m][0], sr) * w0 + b0; o[0] = logsig(v0[0]); o[8192] = logsig(v0[1]); o[2 * 8192] = logsig(v0[2]); o[3 * 8192] = logsig(v0[3]);
                        if (fq == 0) { const f32x4 v1 = cvt4(acc[ai][0][m][1], sr) * w1 + b1; o[4 * 8192] = logsig(v1[0]); o[5 * 8192] = logsig(v1[1]); o[6 * 8192] = logsig(v1[2]); o[7 * 8192] = logsig(v1[3]); } }
            }
            return;
        }
        const bool rope = u.pn < 12;
        const int i0 = 16 * wc + 4 * fq;
#pragma unroll
        for (int bj = 0; bj < 2; ++bj) { const int col0 = u.pn * BM + bj * HALF + wc * 32 + 8 * fq;
            const f32x4 w0 = *(const f32x4*)(sw + col0), w1 = *(const f32x4*)(sw + col0 + 4);
#pragma unroll
            for (int ai = 0; ai < 2; ++ai)
#pragma unroll
                for (int m = 0; m < 4; ++m) { const int row = row0 + ai * HALF + m * 16; const float sr = sx[row];
                    f32x4 v0 = cvt4(acc[ai][bj][m][0], sr) * w0, v1 = cvt4(acc[ai][bj][m][1], sr) * w1;
                    if (rope) { const int pos = row & 8191; const f32x4 c = *(const f32x4*)(cosT + pos * 64 + i0), s = *(const f32x4*)(sinT + pos * 64 + i0);
                        const f32x4 o0 = v0 * c - v1 * s, o1 = v0 * s + v1 * c; v0 = o0; v1 = o1; }
                    u32x4 w; w.x = cvt_pk_bf16(v0[0], v0[1]); w.y = cvt_pk_bf16(v0[2], v0[3]); w.z = cvt_pk_bf16(v1[0], v1[1]); w.w = cvt_pk_bf16(v1[2], v1[3]);
                    *(u32x4*)(H + (size_t)row * ldh + col0) = w; } }
    }
};
template <bool ADD> struct EpiGate {
    static constexpr bool PERM = true, AFTER_DRAIN = false; static constexpr int NB = 2;
    const bf16_t* Hg; int ldh; const float* bg; const bf16_t* Mf; bf16_t* O; int ldo; const float* sa; const float* sb;
    __device__ __forceinline__ void operator()(const i32x4 (&acc)[2][2][4][2], const Unit& u, int wr, int wc, int fr, int fq) const {
        asm volatile("" : "+v"(fr), "+v"(fq));
        const int row0 = u.pm * BM + wr * 64 + fr;
#pragma unroll
        for (int bj = 0; bj < 2; ++bj) { const int col0 = u.pn * BM + bj * HALF + wc * 32 + 8 * fq;
            const f32x4 g0 = *(const f32x4*)(bg + col0), g1 = *(const f32x4*)(bg + col0 + 4), w0 = *(const f32x4*)(sb + col0), w1 = *(const f32x4*)(sb + col0 + 4);
#pragma unroll
            for (int ai = 0; ai < 2; ++ai)
#pragma unroll
              for (int mb = 0; mb < 4; mb += NB) {
                u32x4 gl[NB], pm[NB]; float sr[NB];
#pragma unroll
                for (int q = 0; q < NB; ++q) { const int row = row0 + ai * HALF + (mb + q) * 16;
                    gl[q] = *(const u32x4*)(Hg + (size_t)row * ldh + col0); if (ADD) pm[q] = *(const u32x4*)(Mf + (size_t)row * ldo + col0); sr[q] = sa[row]; }
                asm volatile("" ::: "memory");
#pragma unroll
                for (int q = 0; q < NB; ++q) { const int m = mb + q; const int row = row0 + ai * HALF + m * 16;
                    f32x4 v0 = cvt4(acc[ai][bj][m][0], sr[q]) * w0, v1 = cvt4(acc[ai][bj][m][1], sr[q]) * w1;
                    v0[0] *= sigm(bf_lo(gl[q].x) + g0[0]); v0[1] *= sigm(bf_hi(gl[q].x) + g0[1]); v0[2] *= sigm(bf_lo(gl[q].y) + g0[2]); v0[3] *= sigm(bf_hi(gl[q].y) + g0[3]);
                    v1[0] *= sigm(bf_lo(gl[q].z) + g1[0]); v1[1] *= sigm(bf_hi(gl[q].z) + g1[1]); v1[2] *= sigm(bf_lo(gl[q].w) + g1[2]); v1[3] *= sigm(bf_hi(gl[q].w) + g1[3]);
                    if (ADD) { v0[0] += bf_lo(pm[q].x); v0[1] += bf_hi(pm[q].x); v0[2] += bf_lo(pm[q].y); v0[3] += bf_hi(pm[q].y); v1[0] += bf_lo(pm[q].z); v1[1] += bf_hi(pm[q].z); v1[2] += bf_lo(pm[q].w); v1[3] += bf_hi(pm[q].w); }
                    u32x4 w; w.x = cvt_pk_bf16(v0[0], v0[1]); w.y = cvt_pk_bf16(v0[2], v0[3]); w.z = cvt_pk_bf16(v1[0], v1[1]); w.w = cvt_pk_bf16(v1[2], v1[3]);
                    *(u32x4*)(O + (size_t)row * ldo + col0) = w; }
                asm volatile("" ::: "memory"); } }
    }
};
struct EpiOut {
    static constexpr bool PERM = false, AFTER_DRAIN = false;
    const float* X; float* T; int ldc; float alpha; const float* stats; const float* lg; const float* lb; const float* sa; const float* sb;
    __device__ __forceinline__ void operator()(const i32x4 (&acc)[2][2][4][2], const Unit& u, int wr, int wc, int fr, int fq) const {
        asm volatile("" : "+v"(fr), "+v"(fq));
        const int row0 = u.pm * BM + wr * 64 + fr, col0 = u.pn * BM + wc * 32 + 4 * fq;
#pragma unroll
        for (int ai = 0; ai < 2; ++ai)
#pragma unroll
            for (int mp = 0; mp < 4; mp += 2) { f32x4 xv0[2][2], xv1[2][2]; float mu0 = 0.f, mu1 = 0.f, rs0 = 1.f, rs1 = 1.f;
                const int rowa = row0 + ai * HALF + mp * 16, rowb = rowa + 16; const size_t offa = (size_t)rowa * ldc + col0, offb = (size_t)rowb * ldc + col0;
                if (stats) { mu0 = stats[2 * rowa]; rs0 = stats[2 * rowa + 1]; mu1 = stats[2 * rowb]; rs1 = stats[2 * rowb + 1]; }
                const float sra = sa[rowa], srb = sa[rowb];
#pragma unroll
                for (int bj = 0; bj < 2; ++bj)
#pragma unroll
                    for (int n = 0; n < 2; ++n) { xv0[bj][n] = *(const f32x4*)(X + offa + bj * HALF + n * 16); xv1[bj][n] = *(const f32x4*)(X + offb + bj * HALF + n * 16); }
                asm volatile("" ::: "memory");
#pragma unroll
                for (int bj = 0; bj < 2; ++bj)
#pragma unroll
                    for (int n = 0; n < 2; ++n) { f32x4 xa = xv0[bj][n], xb = xv1[bj][n];
                        if (stats) { const f32x4 gv = *(const f32x4*)(lg + col0 + bj * HALF + n * 16), bv = *(const f32x4*)(lb + col0 + bj * HALF + n * 16);
                            xa = (xa - mu0) * rs0 * gv + bv; xb = (xb - mu1) * rs1 * gv + bv; }
                        const f32x4 wv = *(const f32x4*)(sb + col0 + bj * HALF + n * 16);
                        *(f32x4*)(T + offa + bj * HALF + n * 16) = xa * alpha + cvt4(acc[ai][bj][mp][n], sra) * wv;
                        *(f32x4*)(T + offb + bj * HALF + n * 16) = xb * alpha + cvt4(acc[ai][bj][mp + 1][n], srb) * wv; }
                asm volatile("" ::: "memory"); }
    }
};
template <class Epi, class Sched, bool ALIGN_EPI = false, bool SP2 = false, bool I8 = false>
__device__ __forceinline__ void gemm_phase(PG8_LAS unsigned char* lds, const Gemm g, const Sched& S, const Epi& E) {
    int tid = threadIdx.x; asm volatile("" : "+v"(tid));
    const int wid = __builtin_amdgcn_readfirstlane(tid >> 6), lane = tid & 63, wr = wid >> 2, wc = wid & 3, fr = lane & 15, fq = lane >> 4;
    const int K = g.K, nt = K / BK;
    unsigned voffA[2], voffB[2];
#pragma unroll
    for (int i = 0; i < 2; ++i) { int R, C; stage_rc(tid * 16 + i * 8192, R, C); const int Rb = Epi::PERM ? ((R & ~31) + perm32(R & 31)) : R;
        voffA[i] = (unsigned)(R * g.lda + C) * 2u; voffB[i] = (unsigned)(Rb * K + C) * 2u; }
    const size_t kstep = (size_t)(BK * 2);
    const size_t hstepA = (size_t)HALF * g.lda * 2, hstepB = (size_t)HALF * K * 2;
    const size_t tstepA = 2 * hstepA, tstepB = 2 * hstepB;
    const unsigned ldsw = (unsigned)wid * 1024u;
    const int aoff = lds_byte(wr * 64 + fr, fq * 8), boff = lds_byte(wc * 32 + fr, fq * 8);
#define PG8_SA(b, h) (((b) * 2 + (h)) * HTB)
#define PG8_SB(b, h) ((4 + (b) * 2 + (h)) * HTB)
#define PG8_STAGE(bufoff, gbase, voff) do { _Pragma("unroll") for (int _i = 0; _i < 2; ++_i) \
        __builtin_amdgcn_global_load_lds((const unsigned*)((const char*)(gbase) + (voff)[_i]), (PG8_LAS unsigned*)(lds + (bufoff) + ldsw + _i * 8192), 16, 0, 0); } while (0)
#define PG8_LDA(dst, b, h) do { _Pragma("unroll") for (int m = 0; m < 4; ++m) _Pragma("unroll") for (int k = 0; k < 2; ++k) dst[m][k] = *(const PG8_LAS bf16x8*)(lds + PG8_SA(b, h) + aoff + m * 2048 + k * 1024); } while (0)
#define PG8_LDB(dst, b, h) do { _Pragma("unroll") for (int n = 0; n < 2; ++n) _Pragma("unroll") for (int k = 0; k < 2; ++k) dst[n][k] = *(const PG8_LAS bf16x8*)(lds + PG8_SB(b, h) + boff + n * 2048 + k * 1024); } while (0)
#define PG8_MMA(ai, bj, At, Bt) do { __builtin_amdgcn_s_setprio(1); _Pragma("unroll") for (int m = 0; m < 4; ++m) _Pragma("unroll") for (int n = 0; n < 2; ++n) _Pragma("unroll") for (int k = 0; k < 2; ++k) \
        { if constexpr (I8) acc[ai][bj][m][n] = __builtin_amdgcn_mfma_i32_16x16x64_i8(__builtin_bit_cast(i32x4, Bt[n][k]), __builtin_bit_cast(i32x4, At[m][k]), acc[ai][bj][m][n], 0, 0, 0); \
          else acc[ai][bj][m][n] = __builtin_amdgcn_mfma_f32_16x16x32_bf16(Bt[n][k], At[m][k], acc[ai][bj][m][n], 0, 0, 0); } __builtin_amdgcn_s_setprio(0); } while (0)
#define PG8_WAIT_V(n) asm volatile("s_waitcnt vmcnt(" #n ")" ::: "memory")
#define PG8_WAIT_L(n) asm volatile("s_waitcnt lgkmcnt(" #n ")" ::: "memory")
#define PG8_BAR __builtin_amdgcn_s_barrier()
#define PG8_SCHED __builtin_amdgcn_sched_barrier(0)
    Unit cur, nxt; int ui = 0;
    if (!S.next(0, cur)) return;
    typedef typename AccSel<I8>::type AccT; AccT acc[2][2][4][2];
#pragma unroll
    for (int a = 0; a < 2; ++a)
#pragma unroll
        for (int b = 0; b < 2; ++b)
#pragma unroll
            for (int m = 0; m < 4; ++m)
#pragma unroll
                for (int n = 0; n < 2; ++n) acc[a][b][m][n] = AccT{};
    bf16x8 At[4][2], B0[2][2], B1[2][2];
    const char* cA = (const char*)g.A + (size_t)cur.pm * tstepA; const char* cB = (const char*)g.Bt + (size_t)cur.pn * tstepB;
    S.a_ready(cur);
    if constexpr (SP2) {
        PG8_STAGE(PG8_SB(0, 0), cB, voffB); PG8_STAGE(PG8_SB(0, 1), cB + hstepB, voffB); PG8_STAGE(PG8_SA(0, 0), cA, voffA); PG8_STAGE(PG8_SA(0, 1), cA + hstepA, voffA);
        if (wr == 1) PG8_BAR;
        PG8_WAIT_V(2); PG8_BAR;
        PG8_STAGE(PG8_SB(1, 0), cB + kstep, voffB); PG8_STAGE(PG8_SA(1, 0), cA + kstep, voffA); PG8_STAGE(PG8_SB(1, 1), cB + hstepB + kstep, voffB);
        PG8_WAIT_V(6); PG8_BAR;
    } else {
        PG8_STAGE(PG8_SB(0, 0), cB, voffB); PG8_STAGE(PG8_SA(0, 0), cA, voffA); PG8_STAGE(PG8_SB(0, 1), cB + hstepB, voffB); PG8_STAGE(PG8_SA(0, 1), cA + hstepA, voffA);
        if (wr == 1) PG8_BAR;
        PG8_WAIT_V(4); PG8_BAR;
        PG8_STAGE(PG8_SB(1, 0), cB + kstep, voffB); PG8_STAGE(PG8_SA(1, 0), cA + kstep, voffA); PG8_STAGE(PG8_SB(1, 1), cB + hstepB + kstep, voffB);
        PG8_WAIT_V(6); PG8_BAR;
    }
    for (;;) {
        const bool has_next = S.next(ui + 1, nxt);
        const char* nA = has_next ? (const char*)g.A + (size_t)nxt.pm * tstepA : cA; const char* nB = has_next ? (const char*)g.Bt + (size_t)nxt.pn * tstepB : cB;
        for (int t = 0; t < nt; t += 2) {
            const bool last = (t == nt - 2);
            const char* a1 = cA + (size_t)(t + 1) * kstep;
            const char* a2 = last ? nA : cA + (size_t)(t + 2) * kstep; const char* b2 = last ? nB : cB + (size_t)(t + 2) * kstep;
            const char* a3 = a2 + kstep; const char* b3 = b2 + kstep;
            if (last && has_next) S.a_ready(nxt);
            if constexpr (SP2) {
            PG8_LDB(B0, 0, 0); PG8_LDB(B1, 0, 1); PG8_SCHED; PG8_LDA(At, 0, 0); PG8_STAGE(PG8_SA(1, 1), a1 + hstepA, voffA);
            PG8_WAIT_V(8); PG8_WAIT_L(0); PG8_BAR; PG8_MMA(0, 0, At, B0); PG8_MMA(0, 1, At, B1); PG8_BAR; PG8_SCHED;
            PG8_LDA(At, 0, 1); PG8_STAGE(PG8_SB(0, 0), b2, voffB); PG8_STAGE(PG8_SB(0, 1), b2 + hstepB, voffB); PG8_STAGE(PG8_SA(0, 0), a2, voffA);
            PG8_WAIT_V(8); PG8_WAIT_L(0); PG8_BAR; PG8_MMA(1, 0, At, B0); PG8_MMA(1, 1, At, B1); PG8_BAR; PG8_SCHED;
            PG8_LDB(B0, 1, 0); PG8_LDB(B1, 1, 1); PG8_SCHED; PG8_LDA(At, 1, 0); PG8_STAGE(PG8_SA(0, 1), a2 + hstepA, voffA);
            PG8_WAIT_V(8); PG8_WAIT_L(0); PG8_BAR; PG8_MMA(0, 0, At, B0); PG8_MMA(0, 1, At, B1); PG8_BAR; PG8_SCHED;
            PG8_LDA(At, 1, 1); PG8_STAGE(PG8_SB(1, 0), b3, voffB); PG8_STAGE(PG8_SB(1, 1), b3 + hstepB, voffB); PG8_STAGE(PG8_SA(1, 0), a3, voffA);
            PG8_WAIT_V(8); PG8_WAIT_L(0); PG8_BAR; PG8_MMA(1, 0, At, B0); PG8_MMA(1, 1, At, B1); PG8_BAR; PG8_SCHED;
            } else {
            PG8_LDB(B0, 0, 0); PG8_SCHED; PG8_LDA(At, 0, 0); PG8_STAGE(PG8_SA(1, 1), a1 + hstepA, voffA);
            PG8_WAIT_L(8); PG8_BAR; PG8_WAIT_L(0); PG8_MMA(0, 0, At, B0); PG8_BAR; PG8_SCHED;
            PG8_LDB(B1, 0, 1); PG8_STAGE(PG8_SB(0, 0), b2, voffB);
            PG8_BAR; PG8_WAIT_L(0); PG8_MMA(0, 1, At, B1); PG8_BAR;
            PG8_LDA(At, 0, 1); PG8_STAGE(PG8_SA(0, 0), a2, voffA);
            PG8_BAR; PG8_WAIT_L(0); PG8_MMA(1, 0, At, B0); PG8_BAR; PG8_SCHED;
            PG8_STAGE(PG8_SB(0, 1), b2 + hstepB, voffB);
            PG8_WAIT_V(6); PG8_BAR; PG8_MMA(1, 1, At, B1); PG8_BAR;
            PG8_LDB(B0, 1, 0); PG8_SCHED; PG8_LDA(At, 1, 0); PG8_STAGE(PG8_SA(0, 1), a2 + hstepA, voffA);
            PG8_WAIT_L(8); PG8_BAR; PG8_WAIT_L(0); PG8_MMA(0, 0, At, B0); PG8_BAR; PG8_SCHED;
            PG8_LDB(B1, 1, 1); PG8_STAGE(PG8_SB(1, 0), b3, voffB);
            PG8_BAR; PG8_WAIT_L(0); PG8_MMA(0, 1, At, B1); PG8_BAR;
            PG8_LDA(At, 1, 1); PG8_STAGE(PG8_SA(1, 0), a3, voffA);
            PG8_BAR; PG8_WAIT_L(0); PG8_MMA(1, 0, At, B0); PG8_BAR; PG8_SCHED;
            PG8_STAGE(PG8_SB(1, 1), b3 + hstepB, voffB);
            PG8_WAIT_V(6); PG8_BAR; PG8_MMA(1, 1, At, B1); PG8_BAR;
            }
        }
        if constexpr (ALIGN_EPI) { if (wr == 0) PG8_BAR; }
        if constexpr (!Epi::AFTER_DRAIN) { E(acc, cur, wr, wc, fr, fq); S.done(cur); }
        if (!has_next) break;
#pragma unroll
        for (int a = 0; a < 2; ++a)
#pragma unroll
            for (int b = 0; b < 2; ++b)
#pragma unroll
                for (int m = 0; m < 4; ++m)
#pragma unroll
                    for (int n = 0; n < 2; ++n) acc[a][b][m][n] = AccT{};
        cur = nxt; cA = nA; cB = nB; ++ui;
        if constexpr (ALIGN_EPI) { if (wr == 1) PG8_BAR; }
    }
    PG8_WAIT_V(0);
    if constexpr (!ALIGN_EPI) { if (wr == 0) PG8_BAR; }
    PG8_BAR;
    if constexpr (Epi::AFTER_DRAIN) { E.fused(acc, cur, wr, wc, fr, fq, lds, wid, lane); S.done(cur); }
#undef PG8_SA
#undef PG8_SB
#undef PG8_STAGE
#undef PG8_LDA
#undef PG8_LDB
#undef PG8_MMA
#undef PG8_WAIT_V
#undef PG8_WAIT_L
#undef PG8_BAR
#undef PG8_SCHED
}
}
namespace at {
typedef unsigned short bf16;
typedef short bf16x8 __attribute__((ext_vector_type(8)));
typedef short s16x4 __attribute__((ext_vector_type(4)));
typedef float f32x16 __attribute__((ext_vector_type(16)));
typedef float f32x4 __attribute__((ext_vector_type(4)));
typedef unsigned u32x4 __attribute__((ext_vector_type(4)));
constexpr int D = 128;
constexpr float SCALE = 0.08838834764831845f, INV_SCALE = 11.313708498984761f, THR = 8.f;
constexpr int NW = 8, QBLK = 32, KVBLK = 64, QB = NW * QBLK;
constexpr int SHM_V = KVBLK * D * 2, SHM_K = KVBLK * D * 2;
constexpr int LDS_ATT = 2 * SHM_V + 2 * SHM_K + NW * 64 * 4;
constexpr int BIAS_OFF = LDS_ATT, JLW_OFF = BIAS_OFF + 8192 * 4, LDS_TOTAL = JLW_OFF + 16;

#define KSWZ(row, colB) ((row) * 256 + ((colB) ^ (((row) & 7) << 4)))
#define SBAR() __builtin_amdgcn_sched_barrier(0)
#define LBAR() do { asm volatile("s_waitcnt lgkmcnt(0)" ::: "memory"); __builtin_amdgcn_s_barrier(); asm volatile("" ::: "memory"); } while (0)
__device__ __forceinline__ int v_st(int k, int c) { const int kk = (k & ~0xC) | ((k & 4) << 1) | ((k & 8) >> 1); return ((kk >> 3) * 4 + (c >> 5)) * 512 + ((kk & 7) * 32 + (c & 31)) * 2; }
__device__ __forceinline__ int v_rd_base(int lane) { return ((lane & 3) << 3) | (((lane >> 2) & 3) << 6) | (((lane >> 4) & 1) << 5) | (((lane >> 5) & 1) << 8); }
constexpr int v_rd_off(int d0, int ks, int half) { return d0 * 512 + ks * 4096 + half * 2048; }
__device__ __forceinline__ int crow(int r, int hi) { return (r & 3) + 8 * (r >> 2) + 4 * hi; }
__device__ __forceinline__ unsigned cvtpk(float lo, float hi) { unsigned r; asm volatile("v_cvt_pk_bf16_f32 %0, %1, %2" : "=v"(r) : "v"(lo), "v"(hi)); return r; }
__device__ __forceinline__ bf16x8 load8(const bf16* p) { return *reinterpret_cast<const bf16x8*>(p); }
__device__ __forceinline__ void mask_tile(f32x16& p0, f32x16& p1, int dq, unsigned W) {
    const float NEG = -__builtin_inff();
#pragma unroll
    for (int r = 0; r < 16; ++r) {
        const int c = (r & 3) + 8 * (r >> 2);
        if ((unsigned)(dq - c) >= W) p0[r] = NEG;
        if ((unsigned)(dq - c - 32) >= W) p1[r] = NEG;
    }
}
__device__ __forceinline__ void partialSM(f32x16& p0, f32x16& p1, float& m_reg, float& mn, float& alpha) {
    float pmax = p0[0]; for (int r = 1; r < 16; ++r) pmax = fmaxf(pmax, p0[r]); for (int r = 0; r < 16; ++r) pmax = fmaxf(pmax, p1[r]);
    { auto rr = __builtin_amdgcn_permlane32_swap(__float_as_uint(pmax), __float_as_uint(pmax), false, false);
      pmax = fmaxf(__uint_as_float(rr[0]), __uint_as_float(rr[1])); }
    constexpr float C2 = 1.4426950408889634f * SCALE;
    if (__builtin_expect(__all((pmax - m_reg) * SCALE <= THR), 1)) { mn = m_reg; alpha = 1.f; }
    else { mn = fmaxf(m_reg, pmax); alpha = __builtin_amdgcn_exp2f((m_reg - mn) * C2); m_reg = mn; }
    const float mnL = -mn * C2;
    for (int r = 0; r < 16; ++r) p0[r] = fmaf(p0[r], C2, mnL); for (int r = 0; r < 16; ++r) p1[r] = fmaf(p1[r], C2, mnL);
    for (int r = 0; r < 16; ++r) p0[r] = __builtin_amdgcn_exp2f(p0[r]);
}
__device__ __forceinline__ void finishSM(f32x16& p0, f32x16& p1, float alpha, float& l_reg, bf16x8& pa0, bf16x8& pa1, bf16x8& pa2, bf16x8& pa3) {
    for (int r = 0; r < 16; ++r) p1[r] = __builtin_amdgcn_exp2f(p1[r]);
    float ps = 0; for (int r = 0; r < 16; ++r) ps += p0[r]; for (int r = 0; r < 16; ++r) ps += p1[r];
    { auto rr = __builtin_amdgcn_permlane32_swap(__float_as_uint(ps), __float_as_uint(ps), false, false);
      ps = __uint_as_float(rr[0]) + __uint_as_float(rr[1]); }
    l_reg = l_reg * alpha + ps;
#define PK4(P, B_, OUT) do { unsigned a0 = cvtpk(P[B_+0], P[B_+1]), a1 = cvtpk(P[B_+2], P[B_+3]);                          \
        unsigned b0 = cvtpk(P[B_+4], P[B_+5]), b1 = cvtpk(P[B_+6], P[B_+7]);                                             \
        auto r0 = __builtin_amdgcn_permlane32_swap(a0, b0, false, false); auto r1 = __builtin_amdgcn_permlane32_swap(a1, b1, false, false); \
        u32x4 w = {r0[0], r1[0], r0[1], r1[1]}; OUT = *reinterpret_cast<bf16x8*>(&w); } while (0)
    PK4(p0, 0, pa0); PK4(p0, 8, pa1); PK4(p1, 0, pa2); PK4(p1, 8, pa3);
#undef PK4
}
template <int KB, bool SK>
__device__ __forceinline__ void qkt(f32x16& p0, f32x16& p1, const char* K_lds, int r32, int hi, const bf16x8* qr, bool act) {
    if (SK && !act) { const float NEG = -__builtin_inff();
#pragma unroll
        for (int r = 0; r < 16; ++r) { p0[r] = NEG; p1[r] = NEG; } return; }
    p0 = f32x16{}; p1 = f32x16{};
    const char* kb[4];
#pragma unroll
    for (int dd = 0; dd < 4; ++dd) kb[dd] = K_lds + KB * SHM_K + KSWZ(r32, (dd * 16 + hi * 8) * 2);
#pragma unroll
    for (int d0 = 0; d0 < 8; ++d0) { const char* a = kb[d0 & 3] + (d0 >> 2) * 128;
        bf16x8 b0 = *reinterpret_cast<const bf16x8*>(a);
        bf16x8 b1 = *reinterpret_cast<const bf16x8*>(a + 32 * 256);
        p0 = __builtin_amdgcn_mfma_f32_32x32x16_bf16(b0, qr[d0], p0, 0, 0, 0);
        p1 = __builtin_amdgcn_mfma_f32_32x32x16_bf16(b1, qr[d0], p1, 0, 0, 0); }
}
template <int VB, bool SK>
__device__ __forceinline__ void pv_tile(f32x16* o, int vb0, bf16x8 pa0, bf16x8 pa1, bf16x8 pa2, bf16x8 pa3, bool act) {
    if (SK && !act) return;
#define TRRD(dst, off) asm volatile("ds_read_b64_tr_b16 %0, %1 offset:%2" : "=&v"(dst) : "v"(vb0), "i"(off) : "memory")
#define PV_D0(d0) do { s16x4 l0, l1, l2, l3, h0, h1, h2, h3; constexpr int b_ = VB * SHM_V + v_rd_off(d0, 0, 0); \
        TRRD(l0, b_); TRRD(h0, b_ + 2048); TRRD(l1, b_ + 4096); TRRD(h1, b_ + 6144); TRRD(l2, b_ + 8192); TRRD(h2, b_ + 10240); TRRD(l3, b_ + 12288); TRRD(h3, b_ + 14336); \
        asm volatile("s_waitcnt lgkmcnt(0)" ::: "memory"); SBAR();   \
        o[d0] = __builtin_amdgcn_mfma_f32_32x32x16_bf16(pa0, (bf16x8){l0[0], l0[1], l0[2], l0[3], h0[0], h0[1], h0[2], h0[3]}, o[d0], 0, 0, 0);   \
        o[d0] = __builtin_amdgcn_mfma_f32_32x32x16_bf16(pa1, (bf16x8){l1[0], l1[1], l1[2], l1[3], h1[0], h1[1], h1[2], h1[3]}, o[d0], 0, 0, 0);   \
        o[d0] = __builtin_amdgcn_mfma_f32_32x32x16_bf16(pa2, (bf16x8){l2[0], l2[1], l2[2], l2[3], h2[0], h2[1], h2[2], h2[3]}, o[d0], 0, 0, 0);   \
        o[d0] = __builtin_amdgcn_mfma_f32_32x32x16_bf16(pa3, (bf16x8){l3[0], l3[1], l3[2], l3[3], h3[0], h3[1], h3[2], h3[3]}, o[d0], 0, 0, 0); } while (0)
    PV_D0(0); PV_D0(1); PV_D0(2); PV_D0(3);
#undef PV_D0
#undef TRRD
}
struct BlkRef { const bf16* Q; const bf16* K; const bf16* V; bf16* O; float* LSE; const float* CUM; int P0, pq, po, pl, skv; float thr; };
struct Seam { bf16x8 qr[8]; bf16x8 st_v0[1], st_v1[1], st_k0[1], st_k1[1]; int jlo; };
__device__ __forceinline__ int swa_jlo(int P0, int W) { const int lowk = P0 - W + 1; return lowk > 0 ? lowk / KVBLK : 0; }
#define ROW(p, k0, rr, pit) ((p) + (size_t)((k0) + (rr)) * (pit) + sc)
#define VMW() asm volatile("s_waitcnt vmcnt(0)" ::: "memory")
#define VMWN(n) asm volatile("s_waitcnt vmcnt(%0)" :: "i"(n) : "memory")
#define SLOAD_H(Z, Kp, Vp, k0, pit) do { S.st_v0[Z] = load8(ROW(Vp, k0, sr, pit)); S.st_v1[Z] = load8(ROW(Vp, k0, 32 + sr, pit));              \
                         S.st_k0[Z] = load8(ROW(Kp, k0, sr, pit)); S.st_k1[Z] = load8(ROW(Kp, k0, 32 + sr, pit)); } while (0)
#define SWRITE_HK(Z, bf) do { *(bf16x8*)(K_lds + (bf) * SHM_K + kws) = S.st_k0[Z]; *(bf16x8*)(K_lds + (bf) * SHM_K + kws + 32 * 256) = S.st_k1[Z]; } while (0)
#define SWRITE_HV(Z, bf) do { *(bf16x8*)(V_lds + (bf) * SHM_V + vst0) = S.st_v0[Z]; *(bf16x8*)(V_lds + (bf) * SHM_V + vst1) = S.st_v1[Z]; } while (0)
#define SWRITE_H(Z, bf) do { SWRITE_HV(Z, bf); SWRITE_HK(Z, bf); } while (0)
__device__ __forceinline__ int fox_jlo(const BlkRef& R, char* lds) {
    int tid = threadIdx.x; asm volatile("" : "+v"(tid));
    int* jlw = (int*)(lds + JLW_OFF); int nt0 = R.P0 / KVBLK; asm volatile("" : "+s"(nt0));
    if (tid == 0) *jlw = nt0;
    __syncthreads();
    if (tid < nt0) { if (R.CUM[R.P0] - R.CUM[KVBLK * tid + KVBLK - 1] >= -R.thr) atomicMin(jlw, tid); }
    __syncthreads();
    return *jlw;
}
template <bool FOX>
__device__ __forceinline__ void attn_prime(const BlkRef& cur, int W, char* lds, Seam& S) {
    int tid = threadIdx.x; asm volatile("" : "+v"(tid));
    const int wid = __builtin_amdgcn_readfirstlane(tid >> 6), lane = tid & 63, r32 = lane & 31, hi = lane >> 5;
    const int sr = tid >> 4, sc = (tid & 15) * 8, kws = KSWZ(sr, sc * 2); char* K_lds = lds + 2 * SHM_V;
    S.jlo = FOX ? fox_jlo(cur, lds) : swa_jlo(cur.P0, W);
    const int kb0 = S.jlo * KVBLK;
    for (int d0 = 0; d0 < 8; ++d0) S.qr[d0] = load8(cur.Q + (size_t)(wid * QBLK + r32) * cur.pq + d0 * 16 + hi * 8);
    SLOAD_H(0, cur.K, cur.V, kb0, cur.pq); VMW(); SWRITE_HK(0, 0);
    __syncthreads();
}
template <bool FOX, bool SK, int W>
__device__ __forceinline__ void attn_block(const BlkRef& cur, const BlkRef& nxt, char* lds, Seam& S) {
    int tid = threadIdx.x; asm volatile("" : "+v"(tid));
    const int wid = __builtin_amdgcn_readfirstlane(tid >> 6), lane = tid & 63, r32 = lane & 31, hi = lane >> 5;
    const int j_lo = S.jlo;
    int j_hi = (cur.P0 + QB - 1) / KVBLK + 1; if (j_hi > cur.skv / KVBLK) j_hi = cur.skv / KVBLK;
    const int NT = j_hi - j_lo;
    const int qlo = cur.P0 + wid * QBLK, qm = qlo + r32 - 4 * hi;
    char* V_lds = lds; char* K_lds = lds + 2 * SHM_V;
    float* ws = (float*)(lds + 2 * SHM_V + 2 * SHM_K) + wid * 64; float* li_l = ws, * al_l = ws + 32;
    float* bias = (float*)(lds + BIAS_OFF);
    const int sr = tid >> 4, sc = (tid & 15) * 8, vst0 = v_st(sr, sc), vst1 = v_st(32 + sr, sc), kws = KSWZ(sr, sc * 2);
    const int vb0 = (int)(uintptr_t)V_lds + v_rd_base(lane);
    const bf16* Kh = cur.K; const bf16* Vh = cur.V; const int pq = cur.pq;
    if (FOX) {
        const float cref = cur.CUM[cur.P0]; const int nb_ = cur.P0 + QB;
        for (int j = j_lo * KVBLK + tid; j < nb_; j += NW * 64) bias[j] = (cref - cur.CUM[j]) * INV_SCALE;
    }
    if (FOX) __syncthreads();
    float m_reg = -1e30f, l_reg = 0; f32x16 o[4] = {};
#define RESC(a) do { if (__any((a) < 1.f)) { if (hi == 0) al_l[r32] = (a); asm volatile("s_waitcnt lgkmcnt(0)" ::: "memory");              \
                     for (int d_ = 0; d_ < 4; ++d_) for (int r = 0; r < 16; ++r) o[d_][r] *= al_l[crow(r, hi)]; } } while (0)
#define KBASE(t) ((j_lo + (t)) * KVBLK)
#define ACT(t) (KBASE(t) <= qlo + QBLK - 1 && KBASE(t) + KVBLK - 1 >= qlo - W + 1)
#define MASKT(P0_, P1_, t) do { const int kb_ = KBASE(t); \
        if (FOX) { const float* bp_ = bias + kb_ + 4 * hi; _Pragma("unroll") for (int g_ = 0; g_ < 4; ++g_) { const f32x4 b0_ = *(const f32x4*)(bp_ + 8 * g_), b1_ = *(const f32x4*)(bp_ + 32 + 8 * g_); \
            _Pragma("unroll") for (int e_ = 0; e_ < 4; ++e_) { P0_[4 * g_ + e_] += b0_[e_]; P1_[4 * g_ + e_] += b1_[e_]; } } } \
        if ((!SK || ACT(t)) && (kb_ + KVBLK - 1 > qlo || kb_ <= qlo + QBLK - 1 - W)) mask_tile(P0_, P1_, qm - kb_, (unsigned)W); } while (0)
    f32x16 pA0, pA1, pB0, pB1; float mnA, mnB, alA, alB; bf16x8 pa0, pa1, pa2, pa3;
    SWRITE_HV(0, 0); SBAR();
    if (NT > 1) { SLOAD_H(0, Kh, Vh, KBASE(1), pq); }
    SBAR(); qkt<0, SK>(pA0, pA1, K_lds, r32, hi, S.qr, ACT(0));
    MASKT(pA0, pA1, 0); partialSM(pA0, pA1, m_reg, mnA, alA);
    if (NT > 1) { VMW(); SWRITE_H(0, 1); }
    __syncthreads();
#define HALF_STEP(PX0, PX1, mnX, alX, PY0, PY1, alY, t, KB, VB, SB) do {                                                      \
        SBAR(); qkt<KB, SK>(PX0, PX1, K_lds, r32, hi, S.qr, ACT(t));                                             \
        finishSM(PY0, PY1, alY, l_reg, pa0, pa1, pa2, pa3); SBAR();                                                           \
        if ((t) + 1 < NT) { SLOAD_H(0, Kh, Vh, KBASE((t) + 1), pq); SBAR(); }                                               \
        pv_tile<VB, SK>(o, vb0, pa0, pa1, pa2, pa3, ACT((t) - 1)); MASKT(PX0, PX1, (t)); partialSM(PX0, PX1, m_reg, mnX, alX);                                        \
        __syncthreads();                                                                                                      \
        if ((t) + 1 < NT) { VMW(); SWRITE_H(0, SB); }                                                                          \
        RESC(alX); __syncthreads(); } while (0)
    for (int t = 1; t + 1 < NT; t += 2) {
        HALF_STEP(pB0, pB1, mnB, alB, pA0, pA1, alA, t, 1, 0, 0);
        HALF_STEP(pA0, pA1, mnA, alA, pB0, pB1, alB, t + 1, 0, 1, 1);
    }
    const bool even = (NT & 1) == 0;
    if (even) { SBAR(); qkt<1, SK>(pB0, pB1, K_lds, r32, hi, S.qr, ACT(NT - 1)); SBAR(); }
    const int jln = FOX ? fox_jlo(nxt, lds) : swa_jlo(nxt.P0, W); const int kbn = jln * KVBLK; S.jlo = jln;
    SLOAD_H(0, nxt.K, nxt.V, kbn, nxt.pq); SBAR();
#pragma unroll
    for (int d0 = 0; d0 < 8; ++d0) S.qr[d0] = load8(nxt.Q + (size_t)(wid * QBLK + r32) * nxt.pq + d0 * 16 + hi * 8);
    SBAR();
    finishSM(pA0, pA1, alA, l_reg, pa0, pa1, pa2, pa3); SBAR();
    pv_tile<0, SK>(o, vb0, pa0, pa1, pa2, pa3, ACT(even ? NT - 2 : NT - 1));
    if (even) { MASKT(pB0, pB1, NT - 1); partialSM(pB0, pB1, m_reg, mnB, alB); __syncthreads(); RESC(alB);
        finishSM(pB0, pB1, alB, l_reg, pa0, pa1, pa2, pa3); SBAR(); pv_tile<1, SK>(o, vb0, pa0, pa1, pa2, pa3, ACT(NT - 1)); }
    SBAR(); VMWN(8); SWRITE_HK(0, 0); SBAR();
    if (hi == 0) li_l[r32] = l_reg; asm volatile("s_waitcnt lgkmcnt(0)" ::: "memory");
    if (!FOX) { if (hi == 0) cur.LSE[(size_t)(wid * QBLK + r32) * cur.pl] = m_reg * SCALE + __logf(l_reg); }
    float rli[16];
#pragma unroll
    for (int r = 0; r < 16; ++r) rli[r] = __builtin_amdgcn_rcpf(li_l[crow(r, hi)]);
    bf16* Ow = cur.O + (size_t)(wid * QBLK) * cur.po;
#pragma unroll
    for (int r = 0; r < 16; ++r) { const int orow = crow(r, hi);
#pragma unroll
        for (int d0 = 0; d0 < 4; ++d0) { const float v = o[d0][r] * rli[r];
            const float vn = __shfl_xor(v, 1);
            if ((r32 & 1) == 0) *(unsigned*)(Ow + (size_t)orow * cur.po + d0 * 32 + r32) = cvtpk(v, vn); } }
    __syncthreads();
#undef RESC
#undef KBASE
#undef ACT
#undef MASKT
#undef HALF_STEP
}
#undef ROW
#undef VMW
#undef VMWN
#undef SLOAD_H
#undef SWRITE_HK
#undef SWRITE_HV
#undef SWRITE_H
}
#define LAS __attribute__((address_space(3)))
#define XB_TMO      128
#define XB_XCNT(j)  (256  + 64 * (j))
#define XB_XSUB(j)  (1280 + 64 * (j))
#define XB_XGEN(j)  (2304 + 64 * (j))
#define XB_TOP      3328
#define XB_TOPGEN   3392
#define XCD_BAR_WORDS 3456
#define XB_SPIN_CAP (1u << 18)

__device__ __forceinline__ unsigned xb_ld(unsigned* p)              { return __hip_atomic_load(p, __ATOMIC_RELAXED, __HIP_MEMORY_SCOPE_AGENT); }
__device__ __forceinline__ unsigned xb_add(unsigned* p, unsigned v) { return __hip_atomic_fetch_add(p, v, __ATOMIC_RELAXED, __HIP_MEMORY_SCOPE_AGENT); }
__device__ __forceinline__ unsigned xb_xcc_id() { return (unsigned)__builtin_amdgcn_s_getreg((3 << 11) | 20) & 0xFu; }
#define XB_SPIN(cond, bar) do { unsigned _sp = 0; while (cond) { __builtin_amdgcn_s_sleep(1); \
    if ((++_sp & 255u) == 0u) { if (xb_ld(&(bar)[XB_TMO])) break; if (_sp > XB_SPIN_CAP) { atomicAdd(&(bar)[XB_TMO], 1u); break; } } } } while (0)

struct XcdBarrier {
    unsigned* bar; unsigned x;
    volatile LAS unsigned* st;
};

__device__ __forceinline__ XcdBarrier xcd_barrier_post(unsigned* bar, volatile LAS unsigned* st) {
    XcdBarrier b; b.bar = bar; b.x = xb_xcc_id(); b.st = st;
    if (threadIdx.x == 0) (void)xb_add(&bar[XB_XCNT(b.x)], 1u);
    return b;
}
__device__ __forceinline__ void xcd_barrier_complete(unsigned* bar, unsigned x, unsigned& nloc, unsigned& nx) {
    const unsigned G = gridDim.x * gridDim.y * gridDim.z;
    unsigned sum, cnt, mine, sp = 0u;
    for (;;) {
        sum = 0u; cnt = 0u; mine = 0u;
#pragma unroll
        for (unsigned j = 0; j < 16; ++j) { const unsigned c = xb_ld(&bar[XB_XCNT(j)]); sum += c; cnt += (c > 0u) ? 1u : 0u; mine = (j == x) ? c : mine; }
        if (sum == G) break;
        __builtin_amdgcn_s_sleep(1);
        if ((++sp & 255u) == 0u) { if (xb_ld(&bar[XB_TMO])) break; if (sp > XB_SPIN_CAP) { atomicAdd(&bar[XB_TMO], 1u); break; } }
    }
    nloc = mine > 0u ? mine : 1u; nx = cnt > 0u ? cnt : 1u;
}

__device__ __forceinline__ void xcd_barrier(const XcdBarrier& b) {
    asm volatile("s_waitcnt vmcnt(0)" ::: "memory");
    __syncthreads();
    if (threadIdx.x == 0) {
        unsigned* bar = b.bar;
        __builtin_amdgcn_s_waitcnt(0);
        unsigned nloc = b.st[0], nx = b.st[1];
        if (nloc == 0u) { xcd_barrier_complete(bar, b.x, nloc, nx); b.st[0] = nloc; b.st[1] = nx; }
        const unsigned old = xb_add(&bar[XB_XSUB(b.x)], 1u);
        const unsigned gen = old / nloc;
        if (old + 1u == (gen + 1u) * nloc) {
            __builtin_amdgcn_fence(__ATOMIC_RELEASE, "agent");
            asm volatile("s_waitcnt vmcnt(0)" ::: "memory");
            const unsigned og = xb_add(&bar[XB_TOP], 1u);
            const unsigned tg = og / nx;
            if (og + 1u == (tg + 1u) * nx) xb_add(&bar[XB_TOPGEN], 1u);
            else XB_SPIN(xb_ld(&bar[XB_TOPGEN]) == tg, bar);
            __builtin_amdgcn_fence(__ATOMIC_ACQUIRE, "agent");
            xb_add(&bar[XB_XGEN(b.x)], 1u);
            asm volatile("s_waitcnt vmcnt(0)" ::: "memory");
        } else {
            XB_SPIN(xb_ld(&bar[XB_XGEN(b.x)]) == gen, bar);
            __builtin_amdgcn_fence(__ATOMIC_ACQUIRE, "agent");
            asm volatile("s_waitcnt vmcnt(0)" ::: "memory");
        }
    }
    __syncthreads();
}
constexpr int BATCH = 4, SEQ = 8192, DM = 2048, M = BATCH * SEQ, NH = 12, HD = 128, WA = 1536, DEPTH = 4;
constexpr int NIN = 16396, NPAD = 16640;
constexpr int C_QA = 0, C_KA = 1536, C_VA = 3072, C_ZA = 4608, C_QB = 6144, C_KB = 7680, C_VB = 9216, C_ZB = 10752, C_G = 12288, C_F = 16384;
constexpr float LN_EPS = 1e-5f, ALPHA = 1.6817928305074290f;
constexpr size_t MiB = 1u << 20;
constexpr size_t WS_XB = 0, WS_WIN = 128 * MiB, WS_WUA = 388 * MiB, WS_WUB = 412 * MiB, WS_WOUT = 436 * MiB, WS_H = 468 * MiB, WS_OA = 1508 * MiB,
                 WS_LSE = 1796 * MiB, WS_LOGF = 1802 * MiB, WS_CUM = 1804 * MiB, WS_COS = 1806 * MiB, WS_SIN = 1808 * MiB, WS_NRM = 1810 * MiB, WS_SC = 1811 * MiB, WS_BAR = 1812 * MiB, WS_END = 1813 * MiB;
constexpr size_t SC_SX = 0, SC_SAA = 32768, SC_SAB = 65536, SC_SWIN = 98304, SC_SWUA = SC_SWIN + 4 * 16640, SC_SWUB = SC_SWUA + 4 * 2048, SC_CSIN = SC_SWUB + 4 * 2048, SC_SWOUT = SC_CSIN + 4 * 16640;
constexpr size_t WS_STATS = WS_BAR + 65536;
constexpr size_t WS_SM = WS_BAR + 393216;
constexpr size_t WS_MF = WS_OA + 96 * MiB;
constexpr size_t OA_STRIDE = (size_t)M * WA, LSE_STRIDE = (size_t)M * NH;
constexpr int LDS_BYTES = 147456, LDS_BARST_OFF = 139264;
constexpr int NPH = 2 + 7 * DEPTH;
typedef unsigned short bf16;
typedef float f32x4 __attribute__((ext_vector_type(4)));
typedef unsigned u32x4 __attribute__((ext_vector_type(4)));

__device__ __forceinline__ unsigned f2bf(float f) { unsigned u = __builtin_bit_cast(unsigned, f); return (u + 0x7fffu + ((u >> 16) & 1u)) >> 16; }
__device__ __forceinline__ unsigned pk2(float lo, float hi) { return f2bf(lo) | (f2bf(hi) << 16); }
__device__ __forceinline__ float bflo(unsigned w) { return __uint_as_float(w << 16); }
__device__ __forceinline__ float bfhi(unsigned w) { return __uint_as_float(w & 0xffff0000u); }
__device__ __forceinline__ float wave_sum(float v) {
#pragma unroll
    for (int o = 1; o < 64; o <<= 1) v += __shfl_xor(v, o);
    return v;
}
__device__ __forceinline__ int in_src_col(int n) {
    if (n < C_VA) { const int hb = n >> 7, p = n & 127; return hb * 128 + 4 * (p >> 3) + (p & 3) + 64 * ((p >> 2) & 1); }
    if (n < C_G) return n;
    if (n < C_F) return n + 12;
    if (n < C_F + 12) return n - C_F + 12288;
    return -1;
}
__device__ __forceinline__ unsigned q8(float v) { return (unsigned)__float2int_rn(v) & 0xffu; }
__device__ __forceinline__ unsigned pack4q(float a, float b, float c, float d) { return q8(a) | (q8(b) << 8) | (q8(c) << 16) | (q8(d) << 24); }
__device__ __forceinline__ float wave_max(float v) {
#pragma unroll
    for (int o = 1; o < 64; o <<= 1) v = fmaxf(v, __shfl_xor(v, o));
    return v;
}
__device__ __forceinline__ void quant_row(const f32x4 (&v)[8], unsigned char* qrow, float* scale, int lane) {
    float amax = 0.f;
#pragma unroll
    for (int j = 0; j < 8; ++j) amax = fmaxf(amax, fmaxf(fmaxf(fabsf(v[j][0]), fabsf(v[j][1])), fmaxf(fabsf(v[j][2]), fabsf(v[j][3]))));
    amax = wave_max(amax); const float inv = amax > 0.f ? 127.f / amax : 0.f;
#pragma unroll
    for (int j = 0; j < 8; ++j) *(unsigned*)(qrow + 4 * lane + 256 * j) = pack4q(v[j][0] * inv, v[j][1] * inv, v[j][2] * inv, v[j][3] * inv);
    if (lane == 0) *scale = amax > 0.f ? amax * (1.f / 127.f) : 1.f;
}

template <bool MAP>
__device__ __forceinline__ void quant_tile(const float* W, int K, int N, const float* cs, unsigned char* WT, float* swout, unsigned* t, int item, int nblk, int lane) {
    const int kb = item / nblk, nb = item - kb * nblk, k0 = 64 * kb, nn = 64 * nb + lane, src = MAP ? in_src_col(nn) : nn;
    const float sc = src >= 0 ? cs[src] : 1.f, inv = src >= 0 ? 1.f / sc : 0.f;
    if (swout && kb == 0) swout[nn] = sc;
    const float* wp = W + (size_t)k0 * N + (src >= 0 ? src : 0);
#pragma unroll 4
    for (int s = 0; s < 16; ++s) { const float v0 = wp[(size_t)(4 * s) * N], v1 = wp[(size_t)(4 * s + 1) * N], v2 = wp[(size_t)(4 * s + 2) * N], v3 = wp[(size_t)(4 * s + 3) * N];
        t[lane * 17 + s] = pack4q(v0 * inv, v1 * inv, v2 * inv, v3 * inv); }
    asm volatile("s_waitcnt lgkmcnt(0)" ::: "memory");
#pragma unroll
    for (int j = 0; j < 4; ++j) { const int idx = lane + 64 * j, n = idx >> 2, c = idx & 3; const unsigned* s = t + n * 17 + 4 * c;
        u32x4 o; o.x = s[0]; o.y = s[1]; o.z = s[2]; o.w = s[3];
        *(u32x4*)(WT + (size_t)(64 * nb + n) * K + k0 + 16 * c) = o; }
    asm volatile("s_waitcnt lgkmcnt(0)" ::: "memory");
}

struct Args { const float* in[9]; float* out; unsigned char* ws; int ph_lo, ph_hi; };

__global__ void __launch_bounds__(512, 2) mega_fwd(Args args) {
    extern __shared__ __attribute__((aligned(16))) unsigned char lds[];
    cg::grid_group grid = cg::this_grid();
    const int G = gridDim.x, bx = blockIdx.x, NGW = G * 8;
    const int vcu = (G % 8 == 0) ? (bx % 8) * (G / 8) + bx / 8 : bx;
#define PH_IDS int tid = threadIdx.x; asm volatile("" : "+v"(tid)); const int lane = tid & 63, wave = __builtin_amdgcn_readfirstlane(tid >> 6), gw = bx * 8 + wave; (void)lane; (void)gw; PH_PTRS
#define PH_PTRS     unsigned long long wz_ = 0; asm volatile("" : "+s"(wz_)); unsigned char* ws = args.ws + wz_;     \
    const float* x_in = args.in[0]; const float* w_in = args.in[1]; const float* b_forget = args.in[2]; const float* b_gate = args.in[3]; \
    const float* w_up_a = args.in[4]; const float* w_up_b = args.in[5]; const float* w_out = args.in[6]; const float* ln_g = args.in[7]; const float* ln_b = args.in[8]; \
    float* out = args.out; \
    bf16* XB = (bf16*)(ws + WS_XB); bf16* WIN = (bf16*)(ws + WS_WIN); bf16* WUA = (bf16*)(ws + WS_WUA); bf16* WUB = (bf16*)(ws + WS_WUB); bf16* WOUT = (bf16*)(ws + WS_WOUT); \
    bf16* H = (bf16*)(ws + WS_H); bf16* OA = (bf16*)(ws + WS_OA); bf16* MF = (bf16*)(ws + WS_MF); \
    float* LSE = (float*)(ws + WS_LSE); float* LOGF = (float*)(ws + WS_LOGF); float* CUM = (float*)(ws + WS_CUM); float* COS = (float*)(ws + WS_COS); float* SIN = (float*)(ws + WS_SIN); float* NRM = (float*)(ws + WS_NRM); float* SC = (float*)(ws + WS_SC); \
    unsigned char* XQ = ws + WS_XB; unsigned char* WINQ = ws + WS_WIN; unsigned char* WUAQ = ws + WS_WUA; unsigned char* WUBQ = ws + WS_WUB; \
    (void)x_in; (void)w_in; (void)b_forget; (void)b_gate; (void)w_up_a; (void)w_up_b; (void)w_out; (void)ln_g; (void)ln_b; (void)out; (void)XB; (void)WIN; (void)WUA; (void)WUB; (void)WOUT; (void)H; (void)OA; (void)MF; (void)LSE; (void)LOGF; (void)CUM; (void)COS; (void)SIN; (void)NRM; (void)SC; (void)XQ; (void)WINQ; (void)WUAQ; (void)WUBQ
    const int lo = args.ph_lo, hi = args.ph_hi;
#define IN(k) (lo <= (k) && (k) < hi)
#ifndef XCDBAR
#define XCDBAR 1
#endif
    volatile LAS unsigned* bst = (volatile LAS unsigned*)((LAS unsigned char*)lds + LDS_BARST_OFF);
    if (threadIdx.x < 2) bst[threadIdx.x] = 0u;
    __syncthreads();
    XcdBarrier xbar = xcd_barrier_post((unsigned*)(args.ws + WS_BAR), bst);
#define SEAM(k) do { if ((k) + 1 < hi) { if (!XCDBAR || (k) == 0) grid.sync(); else xcd_barrier(xbar); } } while (0)

    if (IN(0)) { PH_IDS;
        {   float* red = (float*)lds; constexpr int CG_IN = (NIN + 255) / 256, CG_UP = DM / 256, CG_L = CG_IN + 3 * CG_UP;
            for (int it = bx; it < DEPTH * CG_L; it += G) {
                const int l = it / CG_L; int r = it - l * CG_L; const float* W; int K, N; float* cs;
                if (r < CG_IN) { W = w_in + (size_t)l * DM * NIN; K = DM; N = NIN; cs = SC + SC_CSIN + l * NPAD; }
                else if (r < CG_IN + CG_UP) { r -= CG_IN; W = w_up_a + (size_t)l * WA * DM; K = WA; N = DM; cs = SC + SC_SWUA + l * DM; }
                else if (r < CG_IN + 2 * CG_UP) { r -= CG_IN + CG_UP; W = w_up_b + (size_t)l * WA * DM; K = WA; N = DM; cs = SC + SC_SWUB + l * DM; }
                else { r -= CG_IN + 2 * CG_UP; W = w_out + (size_t)l * DM * DM; K = DM; N = DM; cs = SC + SC_SWOUT + l * DM; }
                const int col = 256 * r + 4 * lane; f32x4 mx = {0.f, 0.f, 0.f, 0.f};
                if (col < N) { const float* wp = W + col;
#pragma unroll 8
                    for (int k = wave; k < K; k += 8) { const f32x4 v = *(const f32x4*)(wp + (size_t)k * N);
                        mx[0] = fmaxf(mx[0], fabsf(v[0])); mx[1] = fmaxf(mx[1], fabsf(v[1])); mx[2] = fmaxf(mx[2], fabsf(v[2])); mx[3] = fmaxf(mx[3], fabsf(v[3])); } }
                *(f32x4*)(red + wave * 256 + 4 * lane) = mx;
                __syncthreads();
                if (tid < 256 && 256 * r + tid < N) { float m = 0.f; for (int w = 0; w < 8; ++w) m = fmaxf(m, red[w * 256 + tid]); cs[256 * r + tid] = m > 0.f ? m * (1.f / 127.f) : 1.f; }
                __syncthreads();
            }
        }
        for (int idx = bx * 512 + tid; idx < SEQ * 64; idx += G * 512) {
            const int pos = idx >> 6, i = idx & 63;
            const float inv_freq = exp2f(-(float)i * (1.f / 64.f) * 13.287712379549449f);
            const float ang = (float)pos * inv_freq;
            const double rev = (double)ang * 0.15915494309189535; const float fr = (float)(rev - floor(rev));
            COS[idx] = __builtin_amdgcn_cosf(fr); SIN[idx] = __builtin_amdgcn_sinf(fr);
        }
        for (int m = gw; m < M; m += NGW) { f32x4 v[8];
#pragma unroll
            for (int j = 0; j < 8; ++j) v[j] = *(const f32x4*)(x_in + (size_t)m * DM + 4 * lane + 256 * j);
            quant_row(v, XQ + (size_t)m * DM, SC + SC_SX + m, lane); }
        SEAM(0);
    }
    if (IN(1)) { PH_IDS;
        unsigned* t = (unsigned*)(lds + wave * 16384);
        constexpr int T_IN = (DM / 64) * (NPAD / 64), T_UP = (WA / 64) * (DM / 64), T_OUT = (DM / 64) * (DM / 64), T_L = T_IN + 2 * T_UP + T_OUT;
        for (int it = gw; it < DEPTH * T_L; it += NGW) {
            const int l = it / T_L; int r = it - l * T_L;
            if (r < T_IN) { quant_tile<true>(w_in + (size_t)l * DM * NIN, DM, NIN, SC + SC_CSIN + l * NPAD, WINQ + (size_t)l * NPAD * DM, SC + SC_SWIN + l * NPAD, t, r, NPAD / 64, lane); continue; } r -= T_IN;
            if (r < T_UP) { quant_tile<false>(w_up_a + (size_t)l * WA * DM, WA, DM, SC + SC_SWUA + l * DM, WUAQ + (size_t)l * DM * WA, nullptr, t, r, DM / 64, lane); continue; } r -= T_UP;
            if (r < T_UP) { quant_tile<false>(w_up_b + (size_t)l * WA * DM, WA, DM, SC + SC_SWUB + l * DM, WUBQ + (size_t)l * DM * WA, nullptr, t, r, DM / 64, lane); continue; } r -= T_UP;
            quant_tile<false>(w_out + (size_t)l * DM * DM, DM, DM, SC + SC_SWOUT + l * DM, ws + WS_WOUT + (size_t)l * DM * DM, nullptr, t, r, DM / 64, lane);
        }
        SEAM(1);
    }

    for (int l = 0; l < DEPTH; ++l) {
        const int pb = 2 + 7 * l;
        if (IN(pb + 0)) { PH_IDS;
            if (bx == 0 && tid < 96) NRM[tid] = 0.f;
            pg8::Gemm g{(const bf16*)XQ, (const bf16*)(WINQ + (size_t)l * NPAD * DM), M, NPAD, DM / 2, DM / 2};   pg8::StaticOrder S; S.init(M, NPAD, G, bx);
            pg8::EpiIn E{H, NPAD, COS, SIN, LOGF, b_forget + l * NH, SC + SC_SX, SC + SC_SWIN + l * NPAD};
            pg8::gemm_phase<pg8::EpiIn, pg8::StaticOrder, true, true, true>((PG8_LAS unsigned char*)lds, g, S, E);
            SEAM(pb + 0);
        }
        if (IN(pb + 1)) { PH_IDS;
            {
                float* red = (float*)lds;
                for (int b = 0; b < BATCH; ++b) {
                    float mq[3] = {0.f, 0.f, 0.f}, mk[3] = {0.f, 0.f, 0.f};
                    for (int s = gw; s < SEQ; s += NGW) { const bf16* hr = H + ((size_t)b * SEQ + s) * NPAD;
#pragma unroll
                        for (int j = 0; j < 3; ++j) { const u32x4 q = *(const u32x4*)(hr + C_QB + 8 * (lane + 64 * j)), k = *(const u32x4*)(hr + C_KB + 8 * (lane + 64 * j));
                            float sq = 0.f, sk = 0.f;
#pragma unroll
                            for (int e = 0; e < 4; ++e) { sq += bflo(q[e]) * bflo(q[e]) + bfhi(q[e]) * bfhi(q[e]); sk += bflo(k[e]) * bflo(k[e]) + bfhi(k[e]) * bfhi(k[e]); }
#pragma unroll
                            for (int o = 1; o < 16; o <<= 1) { sq += __shfl_xor(sq, o); sk += __shfl_xor(sk, o); }
                            mq[j] = fmaxf(mq[j], sq); mk[j] = fmaxf(mk[j], sk); } }
                    if ((lane & 15) == 0) {
#pragma unroll
                        for (int j = 0; j < 3; ++j) { red[wave * 24 + (lane >> 4) + 4 * j] = mq[j]; red[wave * 24 + 12 + (lane >> 4) + 4 * j] = mk[j]; } }
                    __syncthreads();
                    if (tid < 24) { float v = 0.f; for (int w = 0; w < 8; ++w) v = fmaxf(v, red[w * 24 + tid]); atomicMax((unsigned*)NRM + (tid < 12 ? 0 : 48) + b * NH + (tid % 12), __float_as_uint(v)); }
                    __syncthreads();
                }
            }
            if (bx < BATCH * NH) {
                const int b = bx / NH, h = bx - b * NH; float* red = (float*)lds;
                float v[16]; float run = 0.f;
#pragma unroll
                for (int j = 0; j < 16; j += 4) { const f32x4 lf = *(const f32x4*)(LOGF + (size_t)bx * SEQ + 16 * tid + j);
                    run += lf[0]; v[j] = run; run += lf[1]; v[j + 1] = run; run += lf[2]; v[j + 2] = run; run += lf[3]; v[j + 3] = run; }
                float inc = run;
#pragma unroll
                for (int o = 1; o < 64; o <<= 1) { const float t = __shfl_up(inc, o); if (lane >= o) inc += t; }
                if (lane == 63) red[wave] = inc;
                __syncthreads();
                float off = inc - run;
                for (int w = 0; w < wave; ++w) off += red[w];
                float* cp = CUM + (size_t)bx * SEQ + 16 * tid;
#pragma unroll
                for (int j = 0; j < 16; j += 4) *(f32x4*)(cp + j) = (f32x4){v[j] + off, v[j + 1] + off, v[j + 2] + off, v[j + 3] + off};
                __syncthreads();
            }
            constexpr int NIT = 3 * 1536;
            const int cnt = vcu < NIT ? (NIT - vcu + G - 1) / G : 0;
#define DIL_REF(R, n) do { const int L_ = vcu + (n) * G;   \
            const int bh_ = L_ / 96, rb_ = L_ - bh_ * 96, b_ = bh_ / NH, h_ = bh_ - b_ * NH, g_ = rb_ >> 5, r_ = rb_ & 31, dsh = 2 * g_, d_ = 1 << dsh; \
            const int qb = r_ & ((32 >> dsh) - 1), res = r_ >> (5 - dsh); \
            const size_t tok0 = (size_t)b_ * SEQ + res, rq = (size_t)qb * 256 * d_; \
            R.Q = H + (tok0 + rq) * NPAD + C_QA + h_ * HD; R.K = H + tok0 * NPAD + C_KA + h_ * HD; R.V = H + tok0 * NPAD + C_VA + h_ * HD; \
            R.O = OA + (size_t)g_ * OA_STRIDE + (tok0 + rq) * WA + h_ * HD; R.LSE = LSE + (size_t)g_ * LSE_STRIDE + (tok0 + rq) * NH + h_; R.CUM = nullptr; \
            R.P0 = qb * 256; R.pq = d_ * NPAD; R.po = d_ * WA; R.pl = d_ * NH; R.skv = SEQ >> dsh; R.thr = 0.f; } while (0)
            if (cnt > 0) {
                at::BlkRef cur, nxt; at::Seam S{};     DIL_REF(cur, 0);
                at::attn_prime<false>(cur, 129, (char*)lds, S);
                for (int n = 0; n < cnt; ++n) {
                    if (n + 1 < cnt) DIL_REF(nxt, n + 1); else nxt = cur;
                    at::attn_block<false, true, 129>(cur, nxt, (char*)lds, S);
                    cur = nxt;
                }
            }
#undef DIL_REF
            SEAM(pb + 1);
        }
        if (IN(pb + 2)) { PH_IDS;
            constexpr int NIT = BATCH * NH * 32;
            const int cnt = vcu < NIT ? (NIT - vcu + G - 1) / G : 0;
#define FOX_REF(R, n) do { const int L_ = vcu + (n) * G; const int bh = L_ >> 5, qb = (L_ + ((G & 31) == 0 ? 5 * (n) : 0)) & 31  , b_ = bh / NH, h_ = bh - b_ * NH; \
            R.Q = H + ((size_t)b_ * SEQ + (size_t)qb * 256) * NPAD + C_QB + h_ * HD; R.K = H + (size_t)b_ * SEQ * NPAD + C_KB + h_ * HD; R.V = H + (size_t)b_ * SEQ * NPAD + C_VB + h_ * HD; \
            R.O = (bf16*)R.Q; R.LSE = nullptr; R.CUM = CUM + (size_t)bh * SEQ; R.P0 = qb * 256; R.pq = NPAD; R.po = NPAD; R.pl = 0; R.skv = SEQ; R.thr = 30.f + 2.f * sqrtf(NRM[bh] * NRM[48 + bh]) * 0.08838834764831845f; } while (0)
            if (cnt > 0) {
                at::BlkRef cur, nxt; at::Seam S{};     FOX_REF(cur, 0);
                at::attn_prime<true>(cur, SEQ, (char*)lds, S);
                for (int n = 0; n < cnt; ++n) {
                    if (n + 1 < cnt) FOX_REF(nxt, n + 1); else nxt = cur;
                    at::attn_block<true, false, SEQ>(cur, nxt, (char*)lds, S);
                    cur = nxt;
                }
            }
#undef FOX_REF
            SEAM(pb + 2);
        }

        if (IN(pb + 3)) { PH_IDS;
            for (int m = gw; m < M; m += NGW) {
                bf16* hr = H + (size_t)m * NPAD; float va[3][8], vb[3][8]; float ama = 0.f, amb = 0.f;
                u32x4 A0[3], A1[3], A2[3], ZA[3], OB[3], ZB[3]; float L0[3], L1[3], L2[3];
#pragma unroll
                for (int j = 0; j < 3; ++j) {
                    const int col = 8 * (lane + 64 * j), hh = col >> 7; const bf16* oa = OA + (size_t)m * WA + col;
                    A0[j] = *(const u32x4*)oa; A1[j] = *(const u32x4*)(oa + OA_STRIDE); A2[j] = *(const u32x4*)(oa + 2 * OA_STRIDE); ZA[j] = *(const u32x4*)(hr + C_ZA + col);
                    OB[j] = *(const u32x4*)(hr + C_QB + col); ZB[j] = *(const u32x4*)(hr + C_ZB + col);
                    L0[j] = LSE[(size_t)m * NH + hh]; L1[j] = LSE[LSE_STRIDE + (size_t)m * NH + hh]; L2[j] = LSE[2 * LSE_STRIDE + (size_t)m * NH + hh]; }
                asm volatile("" ::: "memory");
#pragma unroll
                for (int j = 0; j < 3; ++j) {
                    const float l0 = L0[j], l1 = L1[j], l2 = L2[j];
                    const float mx = fmaxf(l0, fmaxf(l1, l2)); float e0 = __expf(l0 - mx), e1 = __expf(l1 - mx), e2 = __expf(l2 - mx);
                    const float inv = __builtin_amdgcn_rcpf(e0 + e1 + e2); e0 *= inv; e1 *= inv; e2 *= inv;
                    const u32x4 a0 = A0[j], a1 = A1[j], a2 = A2[j], za = ZA[j], ob = OB[j], zb = ZB[j];
#pragma unroll
                    for (int k = 0; k < 4; ++k) { const float zl = bflo(za[k]), zh = bfhi(za[k]), yl = bflo(zb[k]), yh = bfhi(zb[k]);
                        va[j][2 * k] = (e0 * bflo(a0[k]) + e1 * bflo(a1[k]) + e2 * bflo(a2[k])) * zl * __builtin_amdgcn_rcpf(1.f + __expf(-zl));
                        va[j][2 * k + 1] = (e0 * bfhi(a0[k]) + e1 * bfhi(a1[k]) + e2 * bfhi(a2[k])) * zh * __builtin_amdgcn_rcpf(1.f + __expf(-zh));
                        vb[j][2 * k] = bflo(ob[k]) * yl * __builtin_amdgcn_rcpf(1.f + __expf(-yl)); vb[j][2 * k + 1] = bfhi(ob[k]) * yh * __builtin_amdgcn_rcpf(1.f + __expf(-yh));
                        ama = fmaxf(ama, fmaxf(fabsf(va[j][2 * k]), fabsf(va[j][2 * k + 1]))); amb = fmaxf(amb, fmaxf(fabsf(vb[j][2 * k]), fabsf(vb[j][2 * k + 1]))); }
                }
                ama = wave_max(ama); amb = wave_max(amb);
                const float ia = ama > 0.f ? 127.f / ama : 0.f, ib = amb > 0.f ? 127.f / amb : 0.f;
                unsigned char* qa = (unsigned char*)OA + (size_t)m * (2 * WA); unsigned char* qb = (unsigned char*)(hr + C_QB);
#pragma unroll
                for (int j = 0; j < 3; ++j) { const int col = 8 * (lane + 64 * j);
                    unsigned long long pa = (unsigned long long)pack4q(va[j][0] * ia, va[j][1] * ia, va[j][2] * ia, va[j][3] * ia) | ((unsigned long long)pack4q(va[j][4] * ia, va[j][5] * ia, va[j][6] * ia, va[j][7] * ia) << 32);
                    unsigned long long pb = (unsigned long long)pack4q(vb[j][0] * ib, vb[j][1] * ib, vb[j][2] * ib, vb[j][3] * ib) | ((unsigned long long)pack4q(vb[j][4] * ib, vb[j][5] * ib, vb[j][6] * ib, vb[j][7] * ib) << 32);
                    *(unsigned long long*)(qa + col) = pa; *(unsigned long long*)(qb + col) = pb; }
                if (lane == 0) { SC[SC_SAA + m] = ama > 0.f ? ama * (1.f / 127.f) : 1.f; SC[SC_SAB + m] = amb > 0.f ? amb * (1.f / 127.f) : 1.f; }
            }
            SEAM(pb + 3);
        }

        if (IN(pb + 4)) { PH_IDS;
            { pg8::Gemm g{OA, (const bf16*)(WUAQ + (size_t)l * DM * WA), M, DM, WA / 2, WA}; pg8::StaticOrder S; S.init(M, DM, G, bx);
              pg8::EpiGate<false> E{H + C_G, NPAD, b_gate + (size_t)l * 2 * DM, nullptr, MF, DM, SC + SC_SAA, SC + SC_SWUA + l * DM};
              pg8::gemm_phase<pg8::EpiGate<false>, pg8::StaticOrder, true, true, true>((PG8_LAS unsigned char*)lds, g, S, E); }
            { pg8::Gemm g{H + C_QB, (const bf16*)(WUBQ + (size_t)l * DM * WA), M, DM, WA / 2, NPAD}; pg8::StaticOrder S; S.init(M, DM, G, bx);
              pg8::EpiGate<true> E{H + C_G + DM, NPAD, b_gate + (size_t)l * 2 * DM + DM, MF, XB, DM, SC + SC_SAB, SC + SC_SWUB + l * DM};
              pg8::gemm_phase<pg8::EpiGate<true>, pg8::StaticOrder, true, true, true>((PG8_LAS unsigned char*)lds, g, S, E); }
            SEAM(pb + 4);
        }
        if (IN(pb + 5)) { PH_IDS;
            {
                unsigned char* MQ = ws + WS_MF; float* SM = (float*)(ws + WS_SM);
                for (int m = gw; m < M; m += NGW) { u32x4 r4[4]; float amax = 0.f;
#pragma unroll
                    for (int j = 0; j < 4; ++j) { r4[j] = *(const u32x4*)(XB + (size_t)m * DM + 8 * (lane + 64 * j));
#pragma unroll
                        for (int k = 0; k < 4; ++k) amax = fmaxf(amax, fmaxf(fabsf(bflo(r4[j][k])), fabsf(bfhi(r4[j][k])))); }
                    amax = wave_max(amax); const float inv = amax > 0.f ? 127.f / amax : 0.f;
#pragma unroll
                    for (int j = 0; j < 4; ++j) { const unsigned long long p = (unsigned long long)pack4q(bflo(r4[j][0]) * inv, bfhi(r4[j][0]) * inv, bflo(r4[j][1]) * inv, bfhi(r4[j][1]) * inv) |
                            ((unsigned long long)pack4q(bflo(r4[j][2]) * inv, bfhi(r4[j][2]) * inv, bflo(r4[j][3]) * inv, bfhi(r4[j][3]) * inv) << 32);
                        *(unsigned long long*)(MQ + (size_t)m * DM + 8 * (lane + 64 * j)) = p; }
                    if (lane == 0) SM[m] = amax > 0.f ? amax * (1.f / 127.f) : 1.f; }
                if (hi - lo > 1) xcd_barrier(xbar);
            }
            pg8::Gemm g{(const bf16*)(ws + WS_MF), (const bf16*)(ws + WS_WOUT + (size_t)l * DM * DM), M, DM, DM / 2, DM / 2}; pg8::StaticOrder S; S.init(M, DM, G, bx);
            pg8::EpiOut E{l == 0 ? x_in : out, out, DM, ALPHA, l == 0 ? nullptr : (const float*)(ws + WS_STATS), ln_g + (size_t)(l > 0 ? l - 1 : 0) * DM, ln_b + (size_t)(l > 0 ? l - 1 : 0) * DM, (const float*)(ws + WS_SM), SC + SC_SWOUT + l * DM};
            pg8::gemm_phase<pg8::EpiOut, pg8::StaticOrder, true, true, true>((PG8_LAS unsigned char*)lds, g, S, E);
            SEAM(pb + 5);
        }

        if (IN(pb + 6)) { PH_IDS;
            const float* gg = ln_g + (size_t)l * DM; const float* bb = ln_b + (size_t)l * DM;
            for (int m = gw; m < M; m += NGW) {
                float* row = out + (size_t)m * DM; f32x4 v[8]; float s = 0.f;
#pragma unroll
                for (int j = 0; j < 8; ++j) { v[j] = *(const f32x4*)(row + 4 * lane + 256 * j); s += (v[j][0] + v[j][1]) + (v[j][2] + v[j][3]); }
                const float mean = wave_sum(s) * (1.f / DM); float s2 = 0.f;
#pragma unroll
                for (int j = 0; j < 8; ++j) { v[j] = v[j] - mean; s2 += (v[j][0] * v[j][0] + v[j][1] * v[j][1]) + (v[j][2] * v[j][2] + v[j][3] * v[j][3]); }
                const float rstd = 1.f / sqrtf(wave_sum(s2) * (1.f / DM) + LN_EPS);
                const bool lastl = l == DEPTH - 1;
#pragma unroll
                for (int j = 0; j < 8; ++j) { const int c = 4 * lane + 256 * j; const f32x4 gv = *(const f32x4*)(gg + c), bv = *(const f32x4*)(bb + c);
                    v[j] = v[j] * rstd * gv + bv; if (lastl) *(f32x4*)(row + c) = v[j]; }
                if (!lastl) { if (lane == 0) { float* st = (float*)(ws + WS_STATS) + 2 * (size_t)m; st[0] = mean; st[1] = rstd; }
                    quant_row(v, XQ + (size_t)m * DM, SC + SC_SX + m, lane); }
            }
            SEAM(pb + 6);
        }
    }
#undef IN
#undef SEAM
}

extern "C" void kernel_launch(void* const* d_in, const int* in_sizes, int n_in, void* d_out, int out_size, void* d_ws, size_t ws_size, hipStream_t stream) {
    static int grid = 0;
    if (grid == 0) {
        if (n_in != 9 || in_sizes[0] != M * DM || out_size != M * DM || ws_size < WS_END) { fprintf(stderr, "kernel_launch: unexpected shapes / workspace (n_in %d, ws %zu)\n", n_in, ws_size); grid = -1; return; }
        int dev = 0, cus = 0, per_cu = 0;
        (void)hipGetDevice(&dev); (void)hipDeviceGetAttribute(&cus, hipDeviceAttributeMultiprocessorCount, dev);
        if (hipFuncSetAttribute((const void*)mega_fwd, hipFuncAttributeMaxDynamicSharedMemorySize, LDS_BYTES) != hipSuccess) { fprintf(stderr, "kernel_launch: hipFuncSetAttribute failed\n"); grid = -1; return; }
        if (hipOccupancyMaxActiveBlocksPerMultiprocessor(&per_cu, (const void*)mega_fwd, 512, LDS_BYTES) != hipSuccess || per_cu < 1) { fprintf(stderr, "kernel_launch: occupancy query says %d\n", per_cu); per_cu = 1; }
        (void)hipGetLastError();
        if (cus <= 0) cus = 256;
        grid = cus * per_cu;
    }
    if (grid < 0) return;
    if (hipMemsetAsync((char*)d_ws + WS_BAR, 0, XCD_BAR_WORDS * 4, stream) != hipSuccess) { fprintf(stderr, "kernel_launch: hipMemsetAsync of the barrier words failed\n"); return; }
    Args a{};
    for (int i = 0; i < 9; ++i) a.in[i] = (const float*)d_in[i];
    a.out = (float*)d_out; a.ws = (unsigned char*)d_ws;
    a.ph_lo = 0; a.ph_hi = NPH;
    void* kargs[] = {&a};
    hipError_t e = hipLaunchCooperativeKernel((const void*)mega_fwd, dim3(grid), dim3(512), kargs, LDS_BYTES, stream);
    if (e != hipSuccess) fprintf(stderr, "kernel_launch: cooperative launch failed: %s (grid %d)\n", hipGetErrorString(e), grid);
}
```

```cpp
#include <hip/hip_runtime.h>
#include <hip/hip_cooperative_groups.h>
#include <cstdio>
#include <cstdint>
namespace cg = cooperative_groups;
namespace pg8 {
#define PG8_LAS __attribute__((address_space(3)))
typedef unsigned short bf16_t;
typedef short bf16x8 __attribute__((ext_vector_type(8)));
typedef float f32x4 __attribute__((ext_vector_type(4)));
typedef unsigned u32x4 __attribute__((ext_vector_type(4)));
constexpr int BM = 256, BK = 64, HALF = 128, HTB = HALF * BK * 2  , STAGE_BYTES = 8 * HTB, NXCD = 8, WGM = 8;

__host__ __device__ __forceinline__ int lds_byte(int r, int c) { const int st = (r >> 4) * 2 + (c >> 5), rr = r & 15, cc = c & 31, ob = rr * 64 + cc * 2; return st * 1024 + (ob ^ (((ob >> 9) & 1) << 5)); }
__host__ __device__ __forceinline__ void stage_rc(int b, int& R, int& C) { const int st = b / 1024, sb = b % 1024, swz = sb ^ (((sb >> 9) & 1) << 5); R = (st >> 1) * 16 + swz / 64; C = (st & 1) * 32 + (swz % 64) / 2; }
__host__ __device__ __forceinline__ int perm32(int rho) { const int n = rho >> 4, i = rho & 15; return 8 * (i >> 2) + 4 * n + (i & 3); }

struct Unit { int pm, pn; };
struct Gemm { const bf16_t* A; const bf16_t* Bt; int M, N, K, lda; };

struct StaticOrder {
    int nM, nN, nwg, G, c;
    __host__ __device__ void init(int M, int N, int G_, int c_) { nM = M / BM; nN = N / BM; nwg = nM * nN; G = G_; c = c_; }
    __host__ __device__ bool next(int i, Unit& u) const {
        const long L = (long)i * G + c; if (L >= nwg) return false;
        int wgid = (int)L; { const int q = nwg / NXCD, r = nwg % NXCD, xcd = wgid % NXCD, off = wgid / NXCD; wgid = (xcd < r ? xcd * (q + 1) : r * (q + 1) + (xcd - r) * q) + off; }
        const int nig = WGM * nN, gid = wgid / nig, fm = gid * WGM, gsz = (nM - fm) < WGM ? (nM - fm) : WGM;
        u.pm = fm + ((wgid % nig) % gsz); u.pn = (wgid % nig) / gsz; return true;
    }
    __device__ __forceinline__ void a_ready(const Unit&) const {}
    __device__ __forceinline__ void done(const Unit&) const {}
};

__device__ __forceinline__ unsigned cvt_pk_bf16(float lo, float hi) { unsigned r; asm volatile("v_cvt_pk_bf16_f32 %0, %1, %2" : "=v"(r) : "v"(lo), "v"(hi)); return r; }
typedef float f32x2 __attribute__((ext_vector_type(2)));
typedef unsigned u32x2 __attribute__((ext_vector_type(2)));
typedef int i32x4 __attribute__((ext_vector_type(4)));
template <bool I8> struct AccSel { typedef f32x4 type; };
template <> struct AccSel<true> { typedef i32x4 type; };
__device__ __forceinline__ f32x4 cvt4(i32x4 a, float s) { return (f32x4){(float)a[0] * s, (float)a[1] * s, (float)a[2] * s, (float)a[3] * s}; }
__device__ __forceinline__ float bf_lo(unsigned w) { return __uint_as_float(w << 16); }
__device__ __forceinline__ float bf_hi(unsigned w) { return __uint_as_float(w & 0xffff0000u); }
__device__ __forceinline__ float sigm(float z) { return __builtin_amdgcn_rcpf(1.f + __builtin_amdgcn_exp2f(-1.4426950408889634f * z)); }
__device__ __forceinline__ float logsig(float z) { return fminf(z, 0.f) - log1pf(expf(-fabsf(z))); }

struct EpiIn {
    static constexpr bool PERM = true, AFTER_DRAIN = false;
    bf16_t* H; int ldh; const float* cosT; const float* sinT; float* logf; const float* bfg; const float* sx; const float* sw;
    __device__ __forceinline__ void operator()(const i32x4 (&acc)[2][2][4][2], const Unit& u, int wr, int wc, int fr, int fq) const {
        asm volatile("" : "+v"(fr), "+v"(fq));
        const int row0 = u.pm * BM + wr * 64 + fr;
        if (u.pn == 64) {
            if (wc == 0 && fq < 2) {
                const f32x4 b0 = *(const f32x4*)(bfg + 8 * fq); const f32x4 b1 = fq == 0 ? *(const f32x4*)(bfg + 4) : (f32x4){0.f, 0.f, 0.f, 0.f};
                const f32x4 w0 = *(const f32x4*)(sw + u.pn * BM + 8 * fq), w1 = *(const f32x4*)(sw + u.pn * BM + 8 * fq + 4);
#pragma unroll
                for (int ai = 0; ai < 2; ++ai)
#pragma unroll
                    for (int m = 0; m < 4; ++m) { const int row = row0 + ai * HALF + m * 16; const float sr = sx[row];
                        float* o = logf + ((size_t)(row >> 13) * 12 + 8 * fq) * 8192 + (row & 8191);
                        const f32x4 v0 = cvt4(acc[ai][0][m][0], sr) * w0 + b0; o[0] = logsig(v0[0]); o[8192] = logsig(v0[1]); o[2 * 8192] = logsig(v0[2]); o[3 * 8192] = logsig(v0[3]);
                        if (fq == 0) { const f32x4 v1 = cvt4(acc[ai][0][m][1], sr) * w1 + b1; o[4 * 8192] = logsig(v1[0]); o[5 * 8192] = logsig(v1[1]); o[6 * 8192] = logsig(v1[2]); o[7 * 8192] = logsig(v1[3]); } }
            }
            return;
        }
        const bool rope = u.pn < 12;
        const int i0 = 16 * wc + 4 * fq;
#pragma unroll
        for (int bj = 0; bj < 2; ++bj) { const int col0 = u.pn * BM + bj * HALF + wc * 32 + 8 * fq;
            const f32x4 w0 = *(const f32x4*)(sw + col0), w1 = *(const f32x4*)(sw + col0 + 4);
#pragma unroll
            for (int ai = 0; ai < 2; ++ai)
#pragma unroll
                for (int m = 0; m < 4; ++m) { const int row = row0 + ai * HALF + m * 16; const float sr = sx[row];
                    f32x4 v0 = cvt4(acc[ai][bj][m][0], sr) * w0, v1 = cvt4(acc[ai][bj][m][1], sr) * w1;
                    if (rope) { const int pos = row & 8191; const f32x4 c = *(const f32x4*)(cosT + pos * 64 + i0), s = *(const f32x4*)(sinT + pos * 64 + i0);
                        const f32x4 o0 = v0 * c - v1 * s, o1 = v0 * s + v1 * c; v0 = o0; v1 = o1; }
                    u32x4 w; w.x = cvt_pk_bf16(v0[0], v0[1]); w.y = cvt_pk_bf16(v0[2], v0[3]); w.z = cvt_pk_bf16(v1[0], v1[1]); w.w = cvt_pk_bf16(v1[2], v1[3]);
                    *(u32x4*)(H + (size_t)row * ldh + col0) = w; } }
    }
};
template <bool ADD> struct EpiGate {
    static constexpr bool PERM = true, AFTER_DRAIN = false; static constexpr int NB = 2;
    const bf16_t* Hg; int ldh; const float* bg; const bf16_t* Mf; bf16_t* O; int ldo; const float* sa; const float* sb;
    __device__ __forceinline__ void operator()(const i32x4 (&acc)[2][2][4][2], const Unit& u, int wr, int wc, int fr, int fq) const {
        asm volatile("" : "+v"(fr), "+v"(fq));
        const int row0 = u.pm * BM + wr * 64 + fr;
#pragma unroll
        for (int bj = 0; bj < 2; ++bj) { const int col0 = u.pn * BM + bj * HALF + wc * 32 + 8 * fq;
            const f32x4 g0 = *(const f32x4*)(bg + col0), g1 = *(const f32x4*)(bg + col0 + 4), w0 = *(const f32x4*)(sb + col0), w1 = *(const f32x4*)(sb + col0 + 4);
#pragma unroll
            for (int ai = 0; ai < 2; ++ai)
#pragma unroll
              for (int mb = 0; mb < 4; mb += NB) {
                u32x4 gl[NB], pm[NB]; float sr[NB];
#pragma unroll
                for (int q = 0; q < NB; ++q) { const int row = row0 + ai * HALF + (mb + q) * 16;
                    gl[q] = *(const u32x4*)(Hg + (size_t)row * ldh + col0); if (ADD) pm[q] = *(const u32x4*)(Mf + (size_t)row * ldo + col0); sr[q] = sa[row]; }
                asm volatile("" ::: "memory");
#pragma unroll
                for (int q = 0; q < NB; ++q) { const int m = mb + q; const int row = row0 + ai * HALF + m * 16;
                    f32x4 v0 = cvt4(acc[ai][bj][m][0], sr[q]) * w0, v1 = cvt4(acc[ai][bj][m][1], sr[q]) * w1;
                    v0[0] *= sigm(bf_lo(gl[q].x) + g0[0]); v0[1] *= sigm(bf_hi(gl[q].x) + g0[1]); v0[2] *= sigm(bf_lo(gl[q].y) + g0[2]); v0[3] *= sigm(bf_hi(gl[q].y) + g0[3]);
                    v1[0] *= sigm(bf_lo(gl[q].z) + g1[0]); v1[1] *= sigm(bf_hi(gl[q].z) + g1[1]); v1[2] *= sigm(bf_lo(gl[q].w) + g1[2]); v1[3] *= sigm(bf_hi(gl[q].w) + g1[3]);
                    if (ADD) { v0[0] += bf_lo(pm[q].x); v0[1] += bf_hi(pm[q].x); v0[2] += bf_lo(pm[q].y); v0[3] += bf_hi(pm[q].y); v1[0] += bf_lo(pm[q].z); v1[1] += bf_hi(pm[q].z); v1[2] += bf_lo(pm[q].w); v1[3] += bf_hi(pm[q].w); }
                    u32x4 w; w.x = cvt_pk_bf16(v0[0], v0[1]); w.y = cvt_pk_bf16(v0[2], v0[3]); w.z = cvt_pk_bf16(v1[0], v1[1]); w.w = cvt_pk_bf16(v1[2], v1[3]);
                    *(u32x4*)(O + (size_t)row * ldo + col0) = w; }
                asm volatile("" ::: "memory"); } }
    }
};
struct EpiOut {
    static constexpr bool PERM = false, AFTER_DRAIN = false;
    const float* X; float* T; int ldc; float alpha; const float* stats; const float* lg; const float* lb; const float* sa; const float* sb;
    __device__ __forceinline__ void operator()(const i32x4 (&acc)[2][2][4][2], const Unit& u, int wr, int wc, int fr, int fq) const {
        asm volatile("" : "+v"(fr), "+v"(fq));
        const int row0 = u.pm * BM + wr * 64 + fr, col0 = u.pn * BM + wc * 32 + 4 * fq;
#pragma unroll
        for (int ai = 0; ai < 2; ++ai)
#pragma unroll
            for (int mp = 0; mp < 4; mp += 2) { f32x4 xv0[2][2], xv1[2][2]; float mu0 = 0.f, mu1 = 0.f, rs0 = 1.f, rs1 = 1.f;
                const int rowa = row0 + ai * HALF + mp * 16, rowb = rowa + 16; const size_t offa = (size_t)rowa * ldc + col0, offb = (size_t)rowb * ldc + col0;
                if (stats) { mu0 = stats[2 * rowa]; rs0 = stats[2 * rowa + 1]; mu1 = stats[2 * rowb]; rs1 = stats[2 * rowb + 1]; }
                const float sra = sa[rowa], srb = sa[rowb];
#pragma unroll
                for (int bj = 0; bj < 2; ++bj)
#pragma unroll
                    for (int n = 0; n < 2; ++n) { xv0[bj][n] = *(const f32x4*)(X + offa + bj * HALF + n * 16); xv1[bj][n] = *(const f32x4*)(X + offb + bj * HALF + n * 16); }
                asm volatile("" ::: "memory");
#pragma unroll
                for (int bj = 0; bj < 2; ++bj)
#pragma unroll
                    for (int n = 0; n < 2; ++n) { f32x4 xa = xv0[bj][n], xb = xv1[bj][n];
                        if (stats) { const f32x4 gv = *(const f32x4*)(lg + col0 + bj * HALF + n * 16), bv = *(const f32x4*)(lb + col0 + bj * HALF + n * 16);
                            xa = (xa - mu0) * rs0 * gv + bv; xb = (xb - mu1) * rs1 * gv + bv; }
                        const f32x4 wv = *(const f32x4*)(sb + col0 + bj * HALF + n * 16);
                        *(f32x4*)(T + offa + bj * HALF + n * 16) = xa * alpha + cvt4(acc[ai][bj][mp][n], sra) * wv;
                        *(f32x4*)(T + offb + bj * HALF + n * 16) = xb * alpha + cvt4(acc[ai][bj][mp + 1][n], srb) * wv; }
                asm volatile("" ::: "memory"); }
    }
};
template <class Epi, class Sched, bool ALIGN_EPI = false, bool SP2 = false, bool I8 = false>
__device__ __forceinline__ void gemm_phase(PG8_LAS unsigned char* lds, const Gemm g, const Sched& S, const Epi& E) {
    int tid = threadIdx.x; asm volatile("" : "+v"(tid));
    const int wid = __builtin_amdgcn_readfirstlane(tid >> 6), lane = tid & 63, wr = wid >> 2, wc = wid & 3, fr = lane & 15, fq = lane >> 4;
    const int K = g.K, nt = K / BK;
    unsigned voffA[2], voffB[2];
#pragma unroll
    for (int i = 0; i < 2; ++i) { int R, C; stage_rc(tid * 16 + i * 8192, R, C); const int Rb = Epi::PERM ? ((R & ~31) + perm32(R & 31)) : R;
        voffA[i] = (unsigned)(R * g.lda + C) * 2u; voffB[i] = (unsigned)(Rb * K + C) * 2u; }
    const size_t kstep = (size_t)(BK * 2);
    const size_t hstepA = (size_t)HALF * g.lda * 2, hstepB = (size_t)HALF * K * 2;
    const size_t tstepA = 2 * hstepA, tstepB = 2 * hstepB;
    const unsigned ldsw = (unsigned)wid * 1024u;
    const int aoff = lds_byte(wr * 64 + fr, fq * 8), boff = lds_byte(wc * 32 + fr, fq * 8);
#define PG8_SA(b, h) (((b) * 2 + (h)) * HTB)
#define PG8_SB(b, h) ((4 + (b) * 2 + (h)) * HTB)
#define PG8_STAGE(bufoff, gbase, voff) do { _Pragma("unroll") for (int _i = 0; _i < 2; ++_i) \
        __builtin_amdgcn_global_load_lds((const unsigned*)((const char*)(gbase) + (voff)[_i]), (PG8_LAS unsigned*)(lds + (bufoff) + ldsw + _i * 8192), 16, 0, 0); } while (0)
#define PG8_LDA(dst, b, h) do { _Pragma("unroll") for (int m = 0; m < 4; ++m) _Pragma("unroll") for (int k = 0; k < 2; ++k) dst[m][k] = *(const PG8_LAS bf16x8*)(lds + PG8_SA(b, h) + aoff + m * 2048 + k * 1024); } while (0)
#define PG8_LDB(dst, b, h) do { _Pragma("unroll") for (int n = 0; n < 2; ++n) _Pragma("unroll") for (int k = 0; k < 2; ++k) dst[n][k] = *(const PG8_LAS bf16x8*)(lds + PG8_SB(b, h) + boff + n * 2048 + k * 1024); } while (0)
#define PG8_MMA(ai, bj, At, Bt) do { __builtin_amdgcn_s_setprio(1); _Pragma("unroll") for (int m = 0; m < 4; ++m) _Pragma("unroll") for (int n = 0; n < 2; ++n) _Pragma("unroll") for (int k = 0; k < 2; ++k) \
        { if constexpr (I8) acc[ai][bj][m][n] = __builtin_amdgcn_mfma_i32_16x16x64_i8(__builtin_bit_cast(i32x4, Bt[n][k]), __builtin_bit_cast(i32x4, At[m][k]), acc[ai][bj][m][n], 0, 0, 0); \
          else acc[ai][bj][m][n] = __builtin_amdgcn_mfma_f32_16x16x32_bf16(Bt[n][k], At[m][k], acc[ai][bj][m][n], 0, 0, 0); } __builtin_amdgcn_s_setprio(0); } while (0)
#define PG8_WAIT_V(n) asm volatile("s_waitcnt vmcnt(" #n ")" ::: "memory")
#define PG8_WAIT_L(n) asm volatile("s_waitcnt lgkmcnt(" #n ")" ::: "memory")
#define PG8_BAR __builtin_amdgcn_s_barrier()
#define PG8_SCHED __builtin_amdgcn_sched_barrier(0)
    Unit cur, nxt; int ui = 0;
    if (!S.next(0, cur)) return;
    typedef typename AccSel<I8>::type AccT; AccT acc[2][2][4][2];
#pragma unroll
    for (int a = 0; a < 2; ++a)
#pragma unroll
        for (int b = 0; b < 2; ++b)
#pragma unroll
            for (int m = 0; m < 4; ++m)
#pragma unroll
                for (int n = 0; n < 2; ++n) acc[a][b][m][n] = AccT{};
    bf16x8 At[4][2], B0[2][2], B1[2][2];
    const char* cA = (const char*)g.A + (size_t)cur.pm * tstepA; const char* cB = (const char*)g.Bt + (size_t)cur.pn * tstepB;
    S.a_ready(cur);
    if constexpr (SP2) {
        PG8_STAGE(PG8_SB(0, 0), cB, voffB); PG8_STAGE(PG8_SB(0, 1), cB + hstepB, voffB); PG8_STAGE(PG8_SA(0, 0), cA, voffA); PG8_STAGE(PG8_SA(0, 1), cA + hstepA, voffA);
        if (wr == 1) PG8_BAR;
        PG8_WAIT_V(2); PG8_BAR;
        PG8_STAGE(PG8_SB(1, 0), cB + kstep, voffB); PG8_STAGE(PG8_SA(1, 0), cA + kstep, voffA); PG8_STAGE(PG8_SB(1, 1), cB + hstepB + kstep, voffB);
        PG8_WAIT_V(6); PG8_BAR;
    } else {
        PG8_STAGE(PG8_SB(0, 0), cB, voffB); PG8_STAGE(PG8_SA(0, 0), cA, voffA); PG8_STAGE(PG8_SB(0, 1), cB + hstepB, voffB); PG8_STAGE(PG8_SA(0, 1), cA + hstepA, voffA);
        if (wr == 1) PG8_BAR;
        PG8_WAIT_V(4); PG8_BAR;
        PG8_STAGE(PG8_SB(1, 0), cB + kstep, voffB); PG8_STAGE(PG8_SA(1, 0), cA + kstep, voffA); PG8_STAGE(PG8_SB(1, 1), cB + hstepB + kstep, voffB);
        PG8_WAIT_V(6); PG8_BAR;
    }
    for (;;) {
        const bool has_next = S.next(ui + 1, nxt);
        const char* nA = has_next ? (const char*)g.A + (size_t)nxt.pm * tstepA : cA; const char* nB = has_next ? (const char*)g.Bt + (size_t)nxt.pn * tstepB : cB;
        for (int t = 0; t < nt; t += 2) {
            const bool last = (t == nt - 2);
            const char* a1 = cA + (size_t)(t + 1) * kstep;
            const char* a2 = last ? nA : cA + (size_t)(t + 2) * kstep; const char* b2 = last ? nB : cB + (size_t)(t + 2) * kstep;
            const char* a3 = a2 + kstep; const char* b3 = b2 + kstep;
            if (last && has_next) S.a_ready(nxt);
            if constexpr (SP2) {
            PG8_LDB(B0, 0, 0); PG8_LDB(B1, 0, 1); PG8_SCHED; PG8_LDA(At, 0, 0); PG8_STAGE(PG8_SA(1, 1), a1 + hstepA, voffA);
            PG8_WAIT_V(8); PG8_WAIT_L(0); PG8_BAR; PG8_MMA(0, 0, At, B0); PG8_MMA(0, 1, At, B1); PG8_BAR; PG8_SCHED;
            PG8_LDA(At, 0, 1); PG8_STAGE(PG8_SB(0, 0), b2, voffB); PG8_STAGE(PG8_SB(0, 1), b2 + hstepB, voffB); PG8_STAGE(PG8_SA(0, 0), a2, voffA);
            PG8_WAIT_V(8); PG8_WAIT_L(0); PG8_BAR; PG8_MMA(1, 0, At, B0); PG8_MMA(1, 1, At, B1); PG8_BAR; PG8_SCHED;
            PG8_LDB(B0, 1, 0); PG8_LDB(B1, 1, 1); PG8_SCHED; PG8_LDA(At, 1, 0); PG8_STAGE(PG8_SA(0, 1), a2 + hstepA, voffA);
            PG8_WAIT_V(8); PG8_WAIT_L(0); PG8_BAR; PG8_MMA(0, 0, At, B0); PG8_MMA(0, 1, At, B1); PG8_BAR; PG8_SCHED;
            PG8_LDA(At, 1, 1); PG8_STAGE(PG8_SB(1, 0), b3, voffB); PG8_STAGE(PG8_SB(1, 1), b3 + hstepB, voffB); PG8_STAGE(PG8_SA(1, 0), a3, voffA);
            PG8_WAIT_V(8); PG8_WAIT_L(0); PG8_BAR; PG8_MMA(1, 0, At, B0); PG8_MMA(1, 1, At, B1); PG8_BAR; PG8_SCHED;
            } else {
            PG8_LDB(B0, 0, 0); PG8_SCHED; PG8_LDA(At, 0, 0); PG8_STAGE(PG8_SA(1, 1), a1 + hstepA, voffA);
            PG8_WAIT_L(8); PG8_BAR; PG8_WAIT_L(0); PG8_MMA(0, 0, At, B0); PG8_BAR; PG8_SCHED;
            PG8_LDB(B1, 0, 1); PG8_STAGE(PG8_SB(0, 0), b2, voffB);
            PG8_BAR; PG8_WAIT_L(0); PG8_MMA(0, 1, At, B1); PG8_BAR;
            PG8_LDA(At, 0, 1); PG8_STAGE(PG8_SA(0, 0), a2, voffA);
            PG8_BAR; PG8_WAIT_L(0); PG8_MMA(1, 0, At, B0); PG8_BAR; PG8_SCHED;
            PG8_STAGE(PG8_SB(0, 1), b2 + hstepB, voffB);
            PG8_WAIT_V(6); PG8_BAR; PG8_MMA(1, 1, At, B1); PG8_BAR;
            PG8_LDB(B0, 1, 0); PG8_SCHED; PG8_LDA(At, 1, 0); PG8_STAGE(PG8_SA(0, 1), a2 + hstepA, voffA);
            PG8_WAIT_L(8); PG8_BAR; PG8_WAIT_L(0); PG8_MMA(0, 0, At, B0); PG8_BAR; PG8_SCHED;
            PG8_LDB(B1, 1, 1); PG8_STAGE(PG8_SB(1, 0), b3, voffB);
            PG8_BAR; PG8_WAIT_L(0); PG8_MMA(0, 1, At, B1); PG8_BAR;
            PG8_LDA(At, 1, 1); PG8_STAGE(PG8_SA(1, 0), a3, voffA);
            PG8_BAR; PG8_WAIT_L(0); PG8_MMA(1, 0, At, B0); PG8_BAR; PG8_SCHED;
            PG8_STAGE(PG8_SB(1, 1), b3 + hstepB, voffB);
            PG8_WAIT_V(6); PG8_BAR; PG8_MMA(1, 1, At, B1); PG8_BAR;
            }
        }
        if constexpr (ALIGN_EPI) { if (wr == 0) PG8_BAR; }
        if constexpr (!Epi::AFTER_DRAIN) { E(acc, cur, wr, wc, fr, fq); S.done(cur); }
        if (!has_next) break;
#pragma unroll
        for (int a = 0; a < 2; ++a)
#pragma unroll
            for (int b = 0; b < 2; ++b)
#pragma unroll
                for (int m = 0; m < 4; ++m)
#pragma unroll
                    for (int n = 0; n < 2; ++n) acc[a][b][m][n] = AccT{};
        cur = nxt; cA = nA; cB = nB; ++ui;
        if constexpr (ALIGN_EPI) { if (wr == 1) PG8_BAR; }
    }
    PG8_WAIT_V(0);
    if constexpr (!ALIGN_EPI) { if (wr == 0) PG8_BAR; }
    PG8_BAR;
    if constexpr (Epi::AFTER_DRAIN) { E.fused(acc, cur, wr, wc, fr, fq, lds, wid, lane); S.done(cur); }
#undef PG8_SA
#undef PG8_SB
#undef PG8_STAGE
#undef PG8_LDA
#undef PG8_LDB
#undef PG8_MMA
#undef PG8_WAIT_V
#undef PG8_WAIT_L
#undef PG8_BAR
#undef PG8_SCHED
}
}
namespace at {
typedef unsigned short bf16;
typedef short bf16x8 __attribute__((ext_vector_type(8)));
typedef short s16x4 __attribute__((ext_vector_type(4)));
typedef float f32x16 __attribute__((ext_vector_type(16)));
typedef float f32x4 __attribute__((ext_vector_type(4)));
typedef unsigned u32x4 __attribute__((ext_vector_type(4)));
constexpr int D = 128;
constexpr float SCALE = 0.08838834764831845f, INV_SCALE = 11.313708498984761f, THR = 8.f;
constexpr int NW = 8, QBLK = 32, KVBLK = 64, QB = NW * QBLK;
constexpr int SHM_V = KVBLK * D * 2, SHM_K = KVBLK * D * 2;
constexpr int LDS_ATT = 2 * SHM_V + 2 * SHM_K + NW * 64 * 4;
constexpr int BIAS_OFF = LDS_ATT, JLW_OFF = BIAS_OFF + 8192 * 4, LDS_TOTAL = JLW_OFF + 16;

#define KSWZ(row, colB) ((row) * 256 + ((colB) ^ (((row) & 7) << 4)))
#define SBAR() __builtin_amdgcn_sched_barrier(0)
#define LBAR() do { asm volatile("s_waitcnt lgkmcnt(0)" ::: "memory"); __builtin_amdgcn_s_barrier(); asm volatile("" ::: "memory"); } while (0)
__device__ __forceinline__ int v_st(int k, int c) { const int kk = (k & ~0xC) | ((k & 4) << 1) | ((k & 8) >> 1); return ((kk >> 3) * 4 + (c >> 5)) * 512 + ((kk & 7) * 32 + (c & 31)) * 2; }
__device__ __forceinline__ int v_rd_base(int lane) { return ((lane & 3) << 3) | (((lane >> 2) & 3) << 6) | (((lane >> 4) & 1) << 5) | (((lane >> 5) & 1) << 8); }
constexpr int v_rd_off(int d0, int ks, int half) { return d0 * 512 + ks * 4096 + half * 2048; }
__device__ __forceinline__ int crow(int r, int hi) { return (r & 3) + 8 * (r >> 2) + 4 * hi; }
__device__ __forceinline__ unsigned cvtpk(float lo, float hi) { unsigned r; asm volatile("v_cvt_pk_bf16_f32 %0, %1, %2" : "=v"(r) : "v"(lo), "v"(hi)); return r; }
__device__ __forceinline__ bf16x8 load8(const bf16* p) { return *reinterpret_cast<const bf16x8*>(p); }
__device__ __forceinline__ void mask_tile(f32x16& p0, f32x16& p1, int dq, unsigned W) {
    const float NEG = -__builtin_inff();
#pragma unroll
    for (int r = 0; r < 16; ++r) {
        const int c = (r & 3) + 8 * (r >> 2);
        if ((unsigned)(dq - c) >= W) p0[r] = NEG;
        if ((unsigned)(dq - c - 32) >= W) p1[r] = NEG;
    }
}
__device__ __forceinline__ void partialSM(f32x16& p0, f32x16& p1, float& m_reg, float& mn, float& alpha) {
    float pmax = p0[0]; for (int r = 1; r < 16; ++r) pmax = fmaxf(pmax, p0[r]); for (int r = 0; r < 16; ++r) pmax = fmaxf(pmax, p1[r]);
    { auto rr = __builtin_amdgcn_permlane32_swap(__float_as_uint(pmax), __float_as_uint(pmax), false, false);
      pmax = fmaxf(__uint_as_float(rr[0]), __uint_as_float(rr[1])); }
    constexpr float C2 = 1.4426950408889634f * SCALE;
    if (__builtin_expect(__all((pmax - m_reg) * SCALE <= THR), 1)) { mn = m_reg; alpha = 1.f; }
    else { mn = fmaxf(m_reg, pmax); alpha = __builtin_amdgcn_exp2f((m_reg - mn) * C2); m_reg = mn; }
    const float mnL = -mn * C2;
    for (int r = 0; r < 16; ++r) p0[r] = fmaf(p0[r], C2, mnL); for (int r = 0; r < 16; ++r) p1[r] = fmaf(p1[r], C2, mnL);
    for (int r = 0; r < 16; ++r) p0[r] = __builtin_amdgcn_exp2f(p0[r]);
}
__device__ __forceinline__ void finishSM(f32x16& p0, f32x16& p1, float alpha, float& l_reg, bf16x8& pa0, bf16x8& pa1, bf16x8& pa2, bf16x8& pa3) {
    for (int r = 0; r < 16; ++r) p1[r] = __builtin_amdgcn_exp2f(p1[r]);
    float ps = 0; for (int r = 0; r < 16; ++r) ps += p0[r]; for (int r = 0; r < 16; ++r) ps += p1[r];
    { auto rr = __builtin_amdgcn_permlane32_swap(__float_as_uint(ps), __float_as_uint(ps), false, false);
      ps = __uint_as_float(rr[0]) + __uint_as_float(rr[1]); }
    l_reg = l_reg * alpha + ps;
#define PK4(P, B_, OUT) do { unsigned a0 = cvtpk(P[B_+0], P[B_+1]), a1 = cvtpk(P[B_+2], P[B_+3]);                          \
        unsigned b0 = cvtpk(P[B_+4], P[B_+5]), b1 = cvtpk(P[B_+6], P[B_+7]);                                             \
        auto r0 = __builtin_amdgcn_permlane32_swap(a0, b0, false, false); auto r1 = __builtin_amdgcn_permlane32_swap(a1, b1, false, false); \
        u32x4 w = {r0[0], r1[0], r0[1], r1[1]}; OUT = *reinterpret_cast<bf16x8*>(&w); } while (0)
    PK4(p0, 0, pa0); PK4(p0, 8, pa1); PK4(p1, 0, pa2); PK4(p1, 8, pa3);
#undef PK4
}
template <int KB, bool SK>
__device__ __forceinline__ void qkt(f32x16& p0, f32x16& p1, const char* K_lds, int r32, int hi, const bf16x8* qr, bool act) {
    if (SK && !act) { const float NEG = -__builtin_inff();
#pragma unroll
        for (int r = 0; r < 16; ++r) { p0[r] = NEG; p1[r] = NEG; } return; }
    p0 = f32x16{}; p1 = f32x16{};
    const char* kb[4];
#pragma unroll
    for (int dd = 0; dd < 4; ++dd) kb[dd] = K_lds + KB * SHM_K + KSWZ(r32, (dd * 16 + hi * 8) * 2);
#pragma unroll
    for (int d0 = 0; d0 < 8; ++d0) { const char* a = kb[d0 & 3] + (d0 >> 2) * 128;
        bf16x8 b0 = *reinterpret_cast<const bf16x8*>(a);
        bf16x8 b1 = *reinterpret_cast<const bf16x8*>(a + 32 * 256);
        p0 = __builtin_amdgcn_mfma_f32_32x32x16_bf16(b0, qr[d0], p0, 0, 0, 0);
        p1 = __builtin_amdgcn_mfma_f32_32x32x16_bf16(b1, qr[d0], p1, 0, 0, 0); }
}
template <int VB, bool SK>
__device__ __forceinline__ void pv_tile(f32x16* o, int vb0, bf16x8 pa0, bf16x8 pa1, bf16x8 pa2, bf16x8 pa3, bool act) {
    if (SK && !act) return;
#define TRRD(dst, off) asm volatile("ds_read_b64_tr_b16 %0, %1 offset:%2" : "=&v"(dst) : "v"(vb0), "i"(off) : "memory")
#define PV_D0(d0) do { s16x4 l0, l1, l2, l3, h0, h1, h2, h3; constexpr int b_ = VB * SHM_V + v_rd_off(d0, 0, 0); \
        TRRD(l0, b_); TRRD(h0, b_ + 2048); TRRD(l1, b_ + 4096); TRRD(h1, b_ + 6144); TRRD(l2, b_ + 8192); TRRD(h2, b_ + 10240); TRRD(l3, b_ + 12288); TRRD(h3, b_ + 14336); \
        asm volatile("s_waitcnt lgkmcnt(0)" ::: "memory"); SBAR();   \
        o[d0] = __builtin_amdgcn_mfma_f32_32x32x16_bf16(pa0, (bf16x8){l0[0], l0[1], l0[2], l0[3], h0[0], h0[1], h0[2], h0[3]}, o[d0], 0, 0, 0);   \
        o[d0] = __builtin_amdgcn_mfma_f32_32x32x16_bf16(pa1, (bf16x8){l1[0], l1[1], l1[2], l1[3], h1[0], h1[1], h1[2], h1[3]}, o[d0], 0, 0, 0);   \
        o[d0] = __builtin_amdgcn_mfma_f32_32x32x16_bf16(pa2, (bf16x8){l2[0], l2[1], l2[2], l2[3], h2[0], h2[1], h2[2], h2[3]}, o[d0], 0, 0, 0);   \
        o[d0] = __builtin_amdgcn_mfma_f32_32x32x16_bf16(pa3, (bf16x8){l3[0], l3[1], l3[2], l3[3], h3[0], h3[1], h3[2], h3[3]}, o[d0], 0, 0, 0); } while (0)
    PV_D0(0); PV_D0(1); PV_D0(2); PV_D0(3);
#undef PV_D0
#undef TRRD
}
struct BlkRef { const bf16* Q; const bf16* K; const bf16* V; bf16* O; float* LSE; const float* CUM; int P0, pq, po, pl, skv; float thr; };
struct Seam { bf16x8 qr[8]; bf16x8 st_v0[1], st_v1[1], st_k0[1], st_k1[1]; int jlo; };
__device__ __forceinline__ int swa_jlo(int P0, int W) { const int lowk = P0 - W + 1; return lowk > 0 ? lowk / KVBLK : 0; }
#define ROW(p, k0, rr, pit) ((p) + (size_t)((k0) + (rr)) * (pit) + sc)
#define VMW() asm volatile("s_waitcnt vmcnt(0)" ::: "memory")
#define VMWN(n) asm volatile("s_waitcnt vmcnt(%0)" :: "i"(n) : "memory")
#define SLOAD_H(Z, Kp, Vp, k0, pit) do { S.st_v0[Z] = load8(ROW(Vp, k0, sr, pit)); S.st_v1[Z] = load8(ROW(Vp, k0, 32 + sr, pit));              \
                         S.st_k0[Z] = load8(ROW(Kp, k0, sr, pit)); S.st_k1[Z] = load8(ROW(Kp, k0, 32 + sr, pit)); } while (0)
#define SWRITE_HK(Z, bf) do { *(bf16x8*)(K_lds + (bf) * SHM_K + kws) = S.st_k0[Z]; *(bf16x8*)(K_lds + (bf) * SHM_K + kws + 32 * 256) = S.st_k1[Z]; } while (0)
#define SWRITE_HV(Z, bf) do { *(bf16x8*)(V_lds + (bf) * SHM_V + vst0) = S.st_v0[Z]; *(bf16x8*)(V_lds + (bf) * SHM_V + vst1) = S.st_v1[Z]; } while (0)
#define SWRITE_H(Z, bf) do { SWRITE_HV(Z, bf); SWRITE_HK(Z, bf); } while (0)
__device__ __forceinline__ int fox_jlo(const BlkRef& R, char* lds) {
    int tid = threadIdx.x; asm volatile("" : "+v"(tid));
    int* jlw = (int*)(lds + JLW_OFF); int nt0 = R.P0 / KVBLK; asm volatile("" : "+s"(nt0));
    if (tid == 0) *jlw = nt0;
    __syncthreads();
    if (tid < nt0) { if (R.CUM[R.P0] - R.CUM[KVBLK * tid + KVBLK - 1] >= -R.thr) atomicMin(jlw, tid); }
    __syncthreads();
    return *jlw;
}
template <bool FOX>
__device__ __forceinline__ void attn_prime(const BlkRef& cur, int W, char* lds, Seam& S) {
    int tid = threadIdx.x; asm volatile("" : "+v"(tid));
    const int wid = __builtin_amdgcn_readfirstlane(tid >> 6), lane = tid & 63, r32 = lane & 31, hi = lane >> 5;
    const int sr = tid >> 4, sc = (tid & 15) * 8, kws = KSWZ(sr, sc * 2); char* K_lds = lds + 2 * SHM_V;
    S.jlo = FOX ? fox_jlo(cur, lds) : swa_jlo(cur.P0, W);
    const int kb0 = S.jlo * KVBLK;
    for (int d0 = 0; d0 < 8; ++d0) S.qr[d0] = load8(cur.Q + (size_t)(wid * QBLK + r32) * cur.pq + d0 * 16 + hi * 8);
    SLOAD_H(0, cur.K, cur.V, kb0, cur.pq); VMW(); SWRITE_HK(0, 0);
    __syncthreads();
}
template <bool FOX, bool SK, int W>
__device__ __forceinline__ void attn_block(const BlkRef& cur, const BlkRef& nxt, char* lds, Seam& S) {
    int tid = threadIdx.x; asm volatile("" : "+v"(tid));
    const int wid = __builtin_amdgcn_readfirstlane(tid >> 6), lane = tid & 63, r32 = lane & 31, hi = lane >> 5;
    const int j_lo = S.jlo;
    int j_hi = (cur.P0 + QB - 1) / KVBLK + 1; if (j_hi > cur.skv / KVBLK) j_hi = cur.skv / KVBLK;
    const int NT = j_hi - j_lo;
    const int qlo = cur.P0 + wid * QBLK, qm = qlo + r32 - 4 * hi;
    char* V_lds = lds; char* K_lds = lds + 2 * SHM_V;
    float* ws = (float*)(lds + 2 * SHM_V + 2 * SHM_K) + wid * 64; float* li_l = ws, * al_l = ws + 32;
    float* bias = (float*)(lds + BIAS_OFF);
    const int sr = tid >> 4, sc = (tid & 15) * 8, vst0 = v_st(sr, sc), vst1 = vst0 + 8192  , kws = KSWZ(sr, sc * 2);
    const int vb0 = (int)(uintptr_t)V_lds + v_rd_base(lane);
    const bf16* Kh = cur.K; const bf16* Vh = cur.V; const int pq = cur.pq;
    if (FOX) {
        const float cref = cur.CUM[cur.P0]; const int nb_ = cur.P0 + QB;
        for (int j = j_lo * KVBLK + tid; j < nb_; j += NW * 64) bias[j] = (cref - cur.CUM[j]) * INV_SCALE;
    }
    if (FOX) __syncthreads();
    float m_reg = -1e30f, l_reg = 0; f32x16 o[4] = {};
#define RESC(a) do { if (__any((a) < 1.f)) { if (hi == 0) al_l[r32] = (a); asm volatile("s_waitcnt lgkmcnt(0)" ::: "memory");              \
                     for (int d_ = 0; d_ < 4; ++d_) for (int r = 0; r < 16; ++r) o[d_][r] *= al_l[crow(r, hi)]; } } while (0)
#define KBASE(t) ((j_lo + (t)) * KVBLK)
#define ACT(t) (KBASE(t) <= qlo + QBLK - 1 && KBASE(t) + KVBLK - 1 >= qlo - W + 1)
#define MASKT(P0_, P1_, t) do { const int kb_ = KBASE(t); \
        if (FOX) { const float* bp_ = bias + kb_ + 4 * hi; _Pragma("unroll") for (int g_ = 0; g_ < 4; ++g_) { const f32x4 b0_ = *(const f32x4*)(bp_ + 8 * g_), b1_ = *(const f32x4*)(bp_ + 32 + 8 * g_); \
            _Pragma("unroll") for (int e_ = 0; e_ < 4; ++e_) { P0_[4 * g_ + e_] += b0_[e_]; P1_[4 * g_ + e_] += b1_[e_]; } } } \
        if ((!SK || ACT(t)) && (kb_ + KVBLK - 1 > qlo || kb_ <= qlo + QBLK - 1 - W)) mask_tile(P0_, P1_, qm - kb_, (unsigned)W); } while (0)
    f32x16 pA0, pA1, pB0, pB1; float mnA, mnB, alA, alB; bf16x8 pa0, pa1, pa2, pa3;
    SWRITE_HV(0, 0); SBAR();
    if (NT > 1) { SLOAD_H(0, Kh, Vh, KBASE(1), pq); }
    SBAR(); qkt<0, SK>(pA0, pA1, K_lds, r32, hi, S.qr, ACT(0));
    MASKT(pA0, pA1, 0); partialSM(pA0, pA1, m_reg, mnA, alA);
    if (NT > 1) { VMW(); SWRITE_H(0, 1); }
    __syncthreads();
#define HALF_STEP(PX0, PX1, mnX, alX, PY0, PY1, alY, t, KB, VB, SB) do {                                                      \
        SBAR(); qkt<KB, SK>(PX0, PX1, K_lds, r32, hi, S.qr, ACT(t));                                             \
        finishSM(PY0, PY1, alY, l_reg, pa0, pa1, pa2, pa3); SBAR();                                                           \
        if ((t) + 1 < NT) { SLOAD_H(0, Kh, Vh, KBASE((t) + 1), pq); SBAR(); }                                               \
        pv_tile<VB, SK>(o, vb0, pa0, pa1, pa2, pa3, ACT((t) - 1)); MASKT(PX0, PX1, (t)); partialSM(PX0, PX1, m_reg, mnX, alX);                                        \
        __syncthreads();                                                                                                      \
        if ((t) + 1 < NT) { VMW(); SWRITE_H(0, SB); }                                                                          \
        RESC(alX); __syncthreads(); } while (0)
    for (int t = 1; t + 1 < NT; t += 2) {
        HALF_STEP(pB0, pB1, mnB, alB, pA0, pA1, alA, t, 1, 0, 0);
        HALF_STEP(pA0, pA1, mnA, alA, pB0, pB1, alB, t + 1, 0, 1, 1);
    }
    const bool even = (NT & 1) == 0;
    if (even) { SBAR(); qkt<1, SK>(pB0, pB1, K_lds, r32, hi, S.qr, ACT(NT - 1)); SBAR(); }
    const int jln = FOX ? fox_jlo(nxt, lds) : swa_jlo(nxt.P0, W); const int kbn = jln * KVBLK; S.jlo = jln;
    SLOAD_H(0, nxt.K, nxt.V, kbn, nxt.pq); SBAR();
#pragma unroll
    for (int d0 = 0; d0 < 8; ++d0) S.qr[d0] = load8(nxt.Q + (size_t)(wid * QBLK + r32) * nxt.pq + d0 * 16 + hi * 8);
    SBAR();
    finishSM(pA0, pA1, alA, l_reg, pa0, pa1, pa2, pa3); SBAR();
    pv_tile<0, SK>(o, vb0, pa0, pa1, pa2, pa3, ACT(even ? NT - 2 : NT - 1));
    if (even) { MASKT(pB0, pB1, NT - 1); partialSM(pB0, pB1, m_reg, mnB, alB); __syncthreads(); RESC(alB);
        finishSM(pB0, pB1, alB, l_reg, pa0, pa1, pa2, pa3); SBAR(); pv_tile<1, SK>(o, vb0, pa0, pa1, pa2, pa3, ACT(NT - 1)); }
    SBAR(); VMWN(8); SWRITE_HK(0, 0); SBAR();
    if (hi == 0) li_l[r32] = l_reg; asm volatile("s_waitcnt lgkmcnt(0)" ::: "memory");
    if (!FOX) { if (hi == 0) cur.LSE[(size_t)(wid * QBLK + r32) * cur.pl] = m_reg * SCALE + __logf(l_reg); }
    float rli[16];
#pragma unroll
    for (int r = 0; r < 16; ++r) rli[r] = __builtin_amdgcn_rcpf(li_l[crow(r, hi)]);
    bf16* Ow = cur.O + (size_t)(wid * QBLK) * cur.po;
#pragma unroll
    for (int r = 0; r < 16; ++r) { const int orow = crow(r, hi);
#pragma unroll
        for (int d0 = 0; d0 < 4; ++d0) { const float v = o[d0][r] * rli[r];
            const float vn = __shfl_xor(v, 1);
            if ((r32 & 1) == 0) *(unsigned*)(Ow + (size_t)orow * cur.po + d0 * 32 + r32) = cvtpk(v, vn); } }
    __syncthreads();
#undef RESC
#undef KBASE
#undef ACT
#undef MASKT
#undef HALF_STEP
}
#undef ROW
#undef VMW
#undef VMWN
#undef SLOAD_H
#undef SWRITE_HK
#undef SWRITE_HV
#undef SWRITE_H
}
#define LAS __attribute__((address_space(3)))
#define XB_TMO      128
#define XB_XCNT(j)  (256  + 64 * (j))
#define XB_XSUB(j)  (1280 + 64 * (j))
#define XB_XGEN(j)  (2304 + 64 * (j))
#define XB_TOP      3328
#define XB_TOPGEN   3392
#define XCD_BAR_WORDS 3456
#define XB_SPIN_CAP (1u << 18)

__device__ __forceinline__ unsigned xb_ld(unsigned* p)              { return __hip_atomic_load(p, __ATOMIC_RELAXED, __HIP_MEMORY_SCOPE_AGENT); }
__device__ __forceinline__ unsigned xb_add(unsigned* p, unsigned v) { return __hip_atomic_fetch_add(p, v, __ATOMIC_RELAXED, __HIP_MEMORY_SCOPE_AGENT); }
__device__ __forceinline__ unsigned xb_xcc_id() { return (unsigned)__builtin_amdgcn_s_getreg((3 << 11) | 20) & 0xFu; }
#define XB_SPIN(cond, bar) do { unsigned _sp = 0; while (cond) { __builtin_amdgcn_s_sleep(1); \
    if ((++_sp & 255u) == 0u) { if (xb_ld(&(bar)[XB_TMO])) break; if (_sp > XB_SPIN_CAP) { atomicAdd(&(bar)[XB_TMO], 1u); break; } } } } while (0)

struct XcdBarrier {
    unsigned* bar; unsigned x;
    volatile LAS unsigned* st;
};

__device__ __forceinline__ XcdBarrier xcd_barrier_post(unsigned* bar, volatile LAS unsigned* st) {
    XcdBarrier b; b.bar = bar; b.x = xb_xcc_id(); b.st = st;
    if (threadIdx.x == 0) (void)xb_add(&bar[XB_XCNT(b.x)], 1u);
    return b;
}
__device__ __forceinline__ void xcd_barrier_complete(unsigned* bar, unsigned x, unsigned& nloc, unsigned& nx) {
    const unsigned G = gridDim.x * gridDim.y * gridDim.z;
    unsigned sum, cnt, mine, sp = 0u;
    for (;;) {
        sum = 0u; cnt = 0u; mine = 0u;
#pragma unroll
        for (unsigned j = 0; j < 16; ++j) { const unsigned c = xb_ld(&bar[XB_XCNT(j)]); sum += c; cnt += (c > 0u) ? 1u : 0u; mine = (j == x) ? c : mine; }
        if (sum == G) break;
        __builtin_amdgcn_s_sleep(1);
        if ((++sp & 255u) == 0u) { if (xb_ld(&bar[XB_TMO])) break; if (sp > XB_SPIN_CAP) { atomicAdd(&bar[XB_TMO], 1u); break; } }
    }
    nloc = mine > 0u ? mine : 1u; nx = cnt > 0u ? cnt : 1u;
}

__device__ __forceinline__ void xcd_barrier(const XcdBarrier& b) {
    asm volatile("s_waitcnt vmcnt(0)" ::: "memory");
    __syncthreads();
    if (threadIdx.x == 0) {
        unsigned* bar = b.bar;
        __builtin_amdgcn_s_waitcnt(0);
        unsigned nloc = b.st[0], nx = b.st[1];
        if (nloc == 0u) { xcd_barrier_complete(bar, b.x, nloc, nx); b.st[0] = nloc; b.st[1] = nx; }
        const unsigned old = xb_add(&bar[XB_XSUB(b.x)], 1u);
        const unsigned gen = old / nloc;
        if (old + 1u == (gen + 1u) * nloc) {
            __builtin_amdgcn_fence(__ATOMIC_RELEASE, "agent");
            asm volatile("s_waitcnt vmcnt(0)" ::: "memory");
            const unsigned og = xb_add(&bar[XB_TOP], 1u);
            const unsigned tg = og / nx;
            if (og + 1u == (tg + 1u) * nx) xb_add(&bar[XB_TOPGEN], 1u);
            else XB_SPIN(xb_ld(&bar[XB_TOPGEN]) == tg, bar);
            __builtin_amdgcn_fence(__ATOMIC_ACQUIRE, "agent");
            xb_add(&bar[XB_XGEN(b.x)], 1u);
            asm volatile("s_waitcnt vmcnt(0)" ::: "memory");
        } else {
            XB_SPIN(xb_ld(&bar[XB_XGEN(b.x)]) == gen, bar);
            __builtin_amdgcn_fence(__ATOMIC_ACQUIRE, "agent");
            asm volatile("s_waitcnt vmcnt(0)" ::: "memory");
        }
    }
    __syncthreads();
}
constexpr int BATCH = 4, SEQ = 8192, DM = 2048, M = BATCH * SEQ, NH = 12, HD = 128, WA = 1536, DEPTH = 4;
constexpr int NIN = 16396, NPAD = 16640;
constexpr int C_QA = 0, C_KA = 1536, C_VA = 3072, C_ZA = 4608, C_QB = 6144, C_KB = 7680, C_VB = 9216, C_ZB = 10752, C_G = 12288, C_F = 16384;
constexpr float LN_EPS = 1e-5f, ALPHA = 1.6817928305074290f;
constexpr size_t MiB = 1u << 20;
constexpr size_t WS_XB = 0, WS_WIN = 128 * MiB, WS_WUA = 388 * MiB, WS_WUB = 412 * MiB, WS_WOUT = 436 * MiB, WS_H = 468 * MiB, WS_OA = 1508 * MiB,
                 WS_LSE = 1796 * MiB, WS_LOGF = 1802 * MiB, WS_CUM = 1804 * MiB, WS_COS = 1806 * MiB, WS_SIN = 1808 * MiB, WS_NRM = 1810 * MiB, WS_SC = 1811 * MiB, WS_BAR = 1812 * MiB, WS_END = 1813 * MiB;
constexpr size_t SC_SX = 0, SC_SAA = 32768, SC_SAB = 65536, SC_SWIN = 98304, SC_SWUA = SC_SWIN + 4 * 16640, SC_SWUB = SC_SWUA + 4 * 2048, SC_CSIN = SC_SWUB + 4 * 2048, SC_SWOUT = SC_CSIN + 4 * 16640;
constexpr size_t WS_STATS = WS_BAR + 65536;
constexpr size_t WS_SM = WS_BAR + 393216;
constexpr size_t WS_MF = WS_OA + 96 * MiB;
constexpr size_t OA_STRIDE = (size_t)M * WA, LSE_STRIDE = (size_t)M * NH;
constexpr int LDS_BYTES = 147456, LDS_BARST_OFF = 139264;
constexpr int NPH = 2 + 7 * DEPTH;
typedef unsigned short bf16;
typedef float f32x4 __attribute__((ext_vector_type(4)));
typedef unsigned u32x4 __attribute__((ext_vector_type(4)));

__device__ __forceinline__ unsigned f2bf(float f) { unsigned u = __builtin_bit_cast(unsigned, f); return (u + 0x7fffu + ((u >> 16) & 1u)) >> 16; }
__device__ __forceinline__ unsigned pk2(float lo, float hi) { return f2bf(lo) | (f2bf(hi) << 16); }
__device__ __forceinline__ float bflo(unsigned w) { return __uint_as_float(w << 16); }
__device__ __forceinline__ float bfhi(unsigned w) { return __uint_as_float(w & 0xffff0000u); }
__device__ __forceinline__ float wave_sum(float v) {
#pragma unroll
    for (int o = 1; o < 64; o <<= 1) v += __shfl_xor(v, o);
    return v;
}
__device__ __forceinline__ int in_src_col(int n) {
    if (n < C_VA) { const int hb = n >> 7, p = n & 127; return hb * 128 + 4 * (p >> 3) + (p & 3) + 64 * ((p >> 2) & 1); }
    if (n < C_G) return n;
    if (n < C_F) return n + 12;
    if (n < C_F + 12) return n - C_F + 12288;
    return -1;
}
__device__ __forceinline__ unsigned q8(float v) { return (unsigned)__float2int_rn(v) & 0xffu; }
__device__ __forceinline__ unsigned pack4q(float a, float b, float c, float d) { return q8(a) | (q8(b) << 8) | (q8(c) << 16) | (q8(d) << 24); }
__device__ __forceinline__ float wave_max(float v) {
#pragma unroll
    for (int o = 1; o < 64; o <<= 1) v = fmaxf(v, __shfl_xor(v, o));
    return v;
}
__device__ __forceinline__ void quant_row(const f32x4 (&v)[8], unsigned char* qrow, float* scale, int lane) {
    float amax = 0.f;
#pragma unroll
    for (int j = 0; j < 8; ++j) amax = fmaxf(amax, fmaxf(fmaxf(fabsf(v[j][0]), fabsf(v[j][1])), fmaxf(fabsf(v[j][2]), fabsf(v[j][3]))));
    amax = wave_max(amax); const float inv = amax > 0.f ? 127.f / amax : 0.f;
#pragma unroll
    for (int j = 0; j < 8; ++j) *(unsigned*)(qrow + 4 * lane + 256 * j) = pack4q(v[j][0] * inv, v[j][1] * inv, v[j][2] * inv, v[j][3] * inv);
    if (lane == 0) *scale = amax > 0.f ? amax * (1.f / 127.f) : 1.f;
}

__device__ __forceinline__ float quant_row_q(const f32x4 (&v)[8], unsigned char* qrow, float* scale, int lane, unsigned (&q)[8]) {
    float amax = 0.f;
#pragma unroll
    for (int j = 0; j < 8; ++j) amax = fmaxf(amax, fmaxf(fmaxf(fabsf(v[j][0]), fabsf(v[j][1])), fmaxf(fabsf(v[j][2]), fabsf(v[j][3]))));
    amax = wave_max(amax); const float inv = amax > 0.f ? 127.f / amax : 0.f, sc = amax > 0.f ? amax * (1.f / 127.f) : 1.f;
#pragma unroll
    for (int j = 0; j < 8; ++j) { q[j] = pack4q(v[j][0] * inv, v[j][1] * inv, v[j][2] * inv, v[j][3] * inv); *(unsigned*)(qrow + 4 * lane + 256 * j) = q[j]; }
    if (lane == 0) *scale = sc;
    return sc;
}

template <bool MAP>
__device__ __forceinline__ void quant_tile(const float* W, int K, int N, const float* cs, unsigned char* WT, float* swout, unsigned* t, int item, int nblk, int lane) {
    const int kb = item / nblk, nb = item - kb * nblk, k0 = 64 * kb, nn = 64 * nb + lane, src = MAP ? in_src_col(nn) : nn;
    const float sc = src >= 0 ? cs[src] : 1.f, inv = src >= 0 ? 1.f / sc : 0.f;
    if (swout && kb == 0) swout[nn] = sc;
    const float* wp = W + (size_t)k0 * N + (src >= 0 ? src : 0);
#pragma unroll 4
    for (int s = 0; s < 16; ++s) { const float v0 = wp[(size_t)(4 * s) * N], v1 = wp[(size_t)(4 * s + 1) * N], v2 = wp[(size_t)(4 * s + 2) * N], v3 = wp[(size_t)(4 * s + 3) * N];
        t[lane * 17 + s] = pack4q(v0 * inv, v1 * inv, v2 * inv, v3 * inv); }
    asm volatile("s_waitcnt lgkmcnt(0)" ::: "memory");
#pragma unroll
    for (int j = 0; j < 4; ++j) { const int idx = lane + 64 * j, n = idx >> 2, c = idx & 3; const unsigned* s = t + n * 17 + 4 * c;
        u32x4 o; o.x = s[0]; o.y = s[1]; o.z = s[2]; o.w = s[3];
        *(u32x4*)(WT + (size_t)(64 * nb + n) * K + k0 + 16 * c) = o; }
    asm volatile("s_waitcnt lgkmcnt(0)" ::: "memory");
}

struct Args { const float* in[9]; float* out; unsigned char* ws; int ph_lo, ph_hi; };

__global__ void __launch_bounds__(512, 2) mega_fwd(Args args) {
    extern __shared__ __attribute__((aligned(16))) unsigned char lds[];
    cg::grid_group grid = cg::this_grid();
    const int G = gridDim.x, bx = blockIdx.x, NGW = G * 8;
    const int vcu = (G % 8 == 0) ? (bx % 8) * (G / 8) + bx / 8 : bx;
#define PH_IDS int tid = threadIdx.x; asm volatile("" : "+v"(tid)); const int lane = tid & 63, wave = __builtin_amdgcn_readfirstlane(tid >> 6), gw = bx * 8 + wave; (void)lane; (void)gw; PH_PTRS
#define PH_PTRS     unsigned long long wz_ = 0; asm volatile("" : "+s"(wz_)); unsigned char* ws = args.ws + wz_;     \
    const float* x_in = args.in[0]; const float* w_in = args.in[1]; const float* b_forget = args.in[2]; const float* b_gate = args.in[3]; \
    const float* w_up_a = args.in[4]; const float* w_up_b = args.in[5]; const float* w_out = args.in[6]; const float* ln_g = args.in[7]; const float* ln_b = args.in[8]; \
    float* out = args.out; \
    bf16* XB = (bf16*)(ws + WS_XB); bf16* WIN = (bf16*)(ws + WS_WIN); bf16* WUA = (bf16*)(ws + WS_WUA); bf16* WUB = (bf16*)(ws + WS_WUB); bf16* WOUT = (bf16*)(ws + WS_WOUT); \
    bf16* H = (bf16*)(ws + WS_H); bf16* OA = (bf16*)(ws + WS_OA); bf16* MF = (bf16*)(ws + WS_MF); \
    float* LSE = (float*)(ws + WS_LSE); float* LOGF = (float*)(ws + WS_LOGF); float* CUM = (float*)(ws + WS_CUM); float* COS = (float*)(ws + WS_COS); float* SIN = (float*)(ws + WS_SIN); float* NRM = (float*)(ws + WS_NRM); float* SC = (float*)(ws + WS_SC); \
    unsigned char* XQ = ws + WS_XB; unsigned char* WINQ = ws + WS_WIN; unsigned char* WUAQ = ws + WS_WUA; unsigned char* WUBQ = ws + WS_WUB; \
    (void)x_in; (void)w_in; (void)b_forget; (void)b_gate; (void)w_up_a; (void)w_up_b; (void)w_out; (void)ln_g; (void)ln_b; (void)out; (void)XB; (void)WIN; (void)WUA; (void)WUB; (void)WOUT; (void)H; (void)OA; (void)MF; (void)LSE; (void)LOGF; (void)CUM; (void)COS; (void)SIN; (void)NRM; (void)SC; (void)XQ; (void)WINQ; (void)WUAQ; (void)WUBQ
    const int lo = args.ph_lo, hi = args.ph_hi;
#define IN(k) (lo <= (k) && (k) < hi)
#ifndef XCDBAR
#define XCDBAR 1
#endif
    volatile LAS unsigned* bst = (volatile LAS unsigned*)((LAS unsigned char*)lds + LDS_BARST_OFF);
    if (threadIdx.x < 2) bst[threadIdx.x] = 0u;
    __syncthreads();
    XcdBarrier xbar = xcd_barrier_post((unsigned*)(args.ws + WS_BAR), bst);
#define SEAM(k) do { if ((k) + 1 < hi) { if (!XCDBAR || (k) == 0) grid.sync(); else xcd_barrier(xbar); } } while (0)

    if (IN(0)) { PH_IDS;
        {   float* red = (float*)lds; constexpr int CG_IN = (NIN + 255) / 256, CG_UP = DM / 256, CG_L = CG_IN + 3 * CG_UP;
            for (int it = bx; it < DEPTH * CG_L; it += G) {
                const int l = it / CG_L; int r = it - l * CG_L; const float* W; int K, N; float* cs;
                if (r < CG_IN) { W = w_in + (size_t)l * DM * NIN; K = DM; N = NIN; cs = SC + SC_CSIN + l * NPAD; }
                else if (r < CG_IN + CG_UP) { r -= CG_IN; W = w_up_a + (size_t)l * WA * DM; K = WA; N = DM; cs = SC + SC_SWUA + l * DM; }
                else if (r < CG_IN + 2 * CG_UP) { r -= CG_IN + CG_UP; W = w_up_b + (size_t)l * WA * DM; K = WA; N = DM; cs = SC + SC_SWUB + l * DM; }
                else { r -= CG_IN + 2 * CG_UP; W = w_out + (size_t)l * DM * DM; K = DM; N = DM; cs = SC + SC_SWOUT + l * DM; }
                const int col = 256 * r + 4 * lane; f32x4 mx = {0.f, 0.f, 0.f, 0.f};
                if (col < N) { const float* wp = W + col;
#pragma unroll 8
                    for (int k = wave; k < K; k += 8) { const f32x4 v = *(const f32x4*)(wp + (size_t)k * N);
                        mx[0] = fmaxf(mx[0], fabsf(v[0])); mx[1] = fmaxf(mx[1], fabsf(v[1])); mx[2] = fmaxf(mx[2], fabsf(v[2])); mx[3] = fmaxf(mx[3], fabsf(v[3])); } }
                *(f32x4*)(red + wave * 256 + 4 * lane) = mx;
                __syncthreads();
                if (tid < 256 && 256 * r + tid < N) { float m = 0.f; for (int w = 0; w < 8; ++w) m = fmaxf(m, red[w * 256 + tid]); cs[256 * r + tid] = m > 0.f ? m * (1.f / 127.f) : 1.f; }
                __syncthreads();
            }
        }
        for (int idx = bx * 512 + tid; idx < SEQ * 64; idx += G * 512) {
            const int pos = idx >> 6, i = idx & 63;
            const float inv_freq = exp2f(-(float)i * (1.f / 64.f) * 13.287712379549449f);
            const float ang = (float)pos * inv_freq;
            const double rev = (double)ang * 0.15915494309189535; const float fr = (float)(rev - floor(rev));
            COS[idx] = __builtin_amdgcn_cosf(fr); SIN[idx] = __builtin_amdgcn_sinf(fr);
        }
        for (int m = gw; m < M; m += NGW) { f32x4 v[8];
#pragma unroll
            for (int j = 0; j < 8; ++j) v[j] = *(const f32x4*)(x_in + (size_t)m * DM + 4 * lane + 256 * j);
            quant_row(v, XQ + (size_t)m * DM, SC + SC_SX + m, lane); }
        SEAM(0);
    }
    if (IN(1)) { PH_IDS;
        unsigned* t = (unsigned*)(lds + wave * 16384);
        constexpr int T_IN = (DM / 64) * (NPAD / 64), T_UP = (WA / 64) * (DM / 64), T_OUT = (DM / 64) * (DM / 64), T_L = T_IN + 2 * T_UP + T_OUT;
        for (int it = gw; it < DEPTH * T_L; it += NGW) {
            const int l = it / T_L; int r = it - l * T_L;
            if (r < T_IN) { quant_tile<true>(w_in + (size_t)l * DM * NIN, DM, NIN, SC + SC_CSIN + l * NPAD, WINQ + (size_t)l * NPAD * DM, SC + SC_SWIN + l * NPAD, t, r, NPAD / 64, lane); continue; } r -= T_IN;
            if (r < T_UP) { quant_tile<false>(w_up_a + (size_t)l * WA * DM, WA, DM, SC + SC_SWUA + l * DM, WUAQ + (size_t)l * DM * WA, nullptr, t, r, DM / 64, lane); continue; } r -= T_UP;
            if (r < T_UP) { quant_tile<false>(w_up_b + (size_t)l * WA * DM, WA, DM, SC + SC_SWUB + l * DM, WUBQ + (size_t)l * DM * WA, nullptr, t, r, DM / 64, lane); continue; } r -= T_UP;
            quant_tile<false>(w_out + (size_t)l * DM * DM, DM, DM, SC + SC_SWOUT + l * DM, ws + WS_WOUT + (size_t)l * DM * DM, nullptr, t, r, DM / 64, lane);
        }
        SEAM(1);
    }

    for (int l = 0; l < DEPTH; ++l) {
        const int pb = 2 + 7 * l;
        if (IN(pb + 0)) { PH_IDS;
            if (bx == 0 && tid < 96) NRM[tid] = 0.f;
            const int NP1 = l == 0 ? NPAD : C_F;
            pg8::Gemm g{(const bf16*)XQ, (const bf16*)(WINQ + (size_t)l * NPAD * DM), M, NP1, DM / 2, DM / 2};   pg8::StaticOrder S; S.init(M, NP1, G, bx);
            pg8::EpiIn E{H, NPAD, COS, SIN, LOGF, b_forget + l * NH, SC + SC_SX, SC + SC_SWIN + l * NPAD};
            pg8::gemm_phase<pg8::EpiIn, pg8::StaticOrder, true, true, true>((PG8_LAS unsigned char*)lds, g, S, E);
            SEAM(pb + 0);
        }
        if (IN(pb + 1)) { PH_IDS;
            {
                float* red = (float*)lds;
                for (int b = 0; b < BATCH; ++b) {
                    float mq[3] = {0.f, 0.f, 0.f}, mk[3] = {0.f, 0.f, 0.f};
                    for (int s = gw; s < SEQ; s += NGW) { const bf16* hr = H + ((size_t)b * SEQ + s) * NPAD;
#pragma unroll
                        for (int j = 0; j < 3; ++j) { const u32x4 q = *(const u32x4*)(hr + C_QB + 8 * (lane + 64 * j)), k = *(const u32x4*)(hr + C_KB + 8 * (lane + 64 * j));
                            float sq = 0.f, sk = 0.f;
#pragma unroll
                            for (int e = 0; e < 4; ++e) { sq += bflo(q[e]) * bflo(q[e]) + bfhi(q[e]) * bfhi(q[e]); sk += bflo(k[e]) * bflo(k[e]) + bfhi(k[e]) * bfhi(k[e]); }
#pragma unroll
                            for (int o = 1; o < 16; o <<= 1) { sq += __shfl_xor(sq, o); sk += __shfl_xor(sk, o); }
                            mq[j] = fmaxf(mq[j], sq); mk[j] = fmaxf(mk[j], sk); } }
                    if ((lane & 15) == 0) {
#pragma unroll
                        for (int j = 0; j < 3; ++j) { red[wave * 24 + (lane >> 4) + 4 * j] = mq[j]; red[wave * 24 + 12 + (lane >> 4) + 4 * j] = mk[j]; } }
                    __syncthreads();
                    if (tid < 24) { float v = 0.f; for (int w = 0; w < 8; ++w) v = fmaxf(v, red[w * 24 + tid]); atomicMax((unsigned*)NRM + (tid < 12 ? 0 : 48) + b * NH + (tid % 12), __float_as_uint(v)); }
                    __syncthreads();
                }
            }
            if (bx < BATCH * NH) {
                const int b = bx / NH, h = bx - b * NH; float* red = (float*)lds;
                float v[16]; float run = 0.f;
#pragma unroll
                for (int j = 0; j < 16; j += 4) { const f32x4 lf = *(const f32x4*)(LOGF + (size_t)bx * SEQ + 16 * tid + j);
                    run += lf[0]; v[j] = run; run += lf[1]; v[j + 1] = run; run += lf[2]; v[j + 2] = run; run += lf[3]; v[j + 3] = run; }
                float inc = run;
#pragma unroll
                for (int o = 1; o < 64; o <<= 1) { const float t = __shfl_up(inc, o); if (lane >= o) inc += t; }
                if (lane == 63) red[wave] = inc;
                __syncthreads();
                float off = inc - run;
                for (int w = 0; w < wave; ++w) off += red[w];
                float* cp = CUM + (size_t)bx * SEQ + 16 * tid;
#pragma unroll
                for (int j = 0; j < 16; j += 4) *(f32x4*)(cp + j) = (f32x4){v[j] + off, v[j + 1] + off, v[j + 2] + off, v[j + 3] + off};
                __syncthreads();
            }
            constexpr int NIT = 3 * 1536;
            const int cnt = vcu < NIT ? (NIT - vcu + G - 1) / G : 0;
#define DIL_REF(R, n) do { const int L_ = vcu + (n) * G;   \
            const int bh_ = L_ / 96, rb_ = L_ - bh_ * 96, b_ = bh_ / NH, h_ = bh_ - b_ * NH, g_ = rb_ >> 5, r_ = rb_ & 31, dsh = 2 * g_, d_ = 1 << dsh; \
            const int qb = r_ & ((32 >> dsh) - 1), res = r_ >> (5 - dsh); \
            const size_t tok0 = (size_t)b_ * SEQ + res, rq = (size_t)qb * 256 * d_; \
            R.Q = H + (tok0 + rq) * NPAD + C_QA + h_ * HD; R.K = H + tok0 * NPAD + C_KA + h_ * HD; R.V = H + tok0 * NPAD + C_VA + h_ * HD; \
            R.O = OA + (size_t)g_ * OA_STRIDE + (tok0 + rq) * WA + h_ * HD; R.LSE = LSE + (size_t)g_ * LSE_STRIDE + (tok0 + rq) * NH + h_; R.CUM = nullptr; \
            R.P0 = qb * 256; R.pq = d_ * NPAD; R.po = d_ * WA; R.pl = d_ * NH; R.skv = SEQ >> dsh; R.thr = 0.f; } while (0)
            if (cnt > 0) {
                at::BlkRef cur, nxt; at::Seam S{};     DIL_REF(cur, 0);
                at::attn_prime<false>(cur, 129, (char*)lds, S);
                for (int n = 0; n < cnt; ++n) {
                    if (n + 1 < cnt) DIL_REF(nxt, n + 1); else nxt = cur;
                    at::attn_block<false, true, 129>(cur, nxt, (char*)lds, S);
                    cur = nxt;
                }
            }
#undef DIL_REF
            SEAM(pb + 1);
        }
        if (IN(pb + 2)) { PH_IDS;
            constexpr int NIT = BATCH * NH * 32;
            const int cnt = vcu < NIT ? (NIT - vcu + G - 1) / G : 0;
#define FOX_REF(R, n) do { const int L_ = vcu + (n) * G; const int bh = L_ >> 5, qb = (L_ + ((G & 31) == 0 ? 5 * (n) : 0)) & 31  , b_ = bh / NH, h_ = bh - b_ * NH; \
            R.Q = H + ((size_t)b_ * SEQ + (size_t)qb * 256) * NPAD + C_QB + h_ * HD; R.K = H + (size_t)b_ * SEQ * NPAD + C_KB + h_ * HD; R.V = H + (size_t)b_ * SEQ * NPAD + C_VB + h_ * HD; \
            R.O = (bf16*)R.Q; R.LSE = nullptr; R.CUM = CUM + (size_t)bh * SEQ; R.P0 = qb * 256; R.pq = NPAD; R.po = NPAD; R.pl = 0; R.skv = SEQ; R.thr = 30.f + 2.f * sqrtf(NRM[bh] * NRM[48 + bh]) * 0.08838834764831845f; } while (0)
            if (cnt > 0) {
                at::BlkRef cur, nxt; at::Seam S{};     FOX_REF(cur, 0);
                at::attn_prime<true>(cur, SEQ, (char*)lds, S);
                for (int n = 0; n < cnt; ++n) {
                    if (n + 1 < cnt) FOX_REF(nxt, n + 1); else nxt = cur;
                    at::attn_block<true, false, SEQ>(cur, nxt, (char*)lds, S);
                    cur = nxt;
                }
            }
#undef FOX_REF
            SEAM(pb + 2);
        }

        if (IN(pb + 3)) { PH_IDS;
            for (int m = gw; m < M; m += NGW) {
                bf16* hr = H + (size_t)m * NPAD; float va[3][8], vb[3][8]; float ama = 0.f, amb = 0.f;
                u32x4 A0[3], A1[3], A2[3], ZA[3], OB[3], ZB[3]; float L0[3], L1[3], L2[3];
#pragma unroll
                for (int j = 0; j < 3; ++j) {
                    const int col = 8 * (lane + 64 * j), hh = col >> 7; const bf16* oa = OA + (size_t)m * WA + col;
                    A0[j] = *(const u32x4*)oa; A1[j] = *(const u32x4*)(oa + OA_STRIDE); A2[j] = *(const u32x4*)(oa + 2 * OA_STRIDE); ZA[j] = *(const u32x4*)(hr + C_ZA + col);
                    OB[j] = *(const u32x4*)(hr + C_QB + col); ZB[j] = *(const u32x4*)(hr + C_ZB + col);
                    L0[j] = LSE[(size_t)m * NH + hh]; L1[j] = LSE[LSE_STRIDE + (size_t)m * NH + hh]; L2[j] = LSE[2 * LSE_STRIDE + (size_t)m * NH + hh]; }
                asm volatile("" ::: "memory");
#pragma unroll
                for (int j = 0; j < 3; ++j) {
                    const float l0 = L0[j], l1 = L1[j], l2 = L2[j];
                    const float mx = fmaxf(l0, fmaxf(l1, l2)); float e0 = __expf(l0 - mx), e1 = __expf(l1 - mx), e2 = __expf(l2 - mx);
                    const float inv = __builtin_amdgcn_rcpf(e0 + e1 + e2); e0 *= inv; e1 *= inv; e2 *= inv;
                    const u32x4 a0 = A0[j], a1 = A1[j], a2 = A2[j], za = ZA[j], ob = OB[j], zb = ZB[j];
#pragma unroll
                    for (int k = 0; k < 4; ++k) { const float zl = bflo(za[k]), zh = bfhi(za[k]), yl = bflo(zb[k]), yh = bfhi(zb[k]);
                        va[j][2 * k] = (e0 * bflo(a0[k]) + e1 * bflo(a1[k]) + e2 * bflo(a2[k])) * zl * __builtin_amdgcn_rcpf(1.f + __expf(-zl));
                        va[j][2 * k + 1] = (e0 * bfhi(a0[k]) + e1 * bfhi(a1[k]) + e2 * bfhi(a2[k])) * zh * __builtin_amdgcn_rcpf(1.f + __expf(-zh));
                        vb[j][2 * k] = bflo(ob[k]) * yl * __builtin_amdgcn_rcpf(1.f + __expf(-yl)); vb[j][2 * k + 1] = bfhi(ob[k]) * yh * __builtin_amdgcn_rcpf(1.f + __expf(-yh));
                        ama = fmaxf(ama, fmaxf(fabsf(va[j][2 * k]), fabsf(va[j][2 * k + 1]))); amb = fmaxf(amb, fmaxf(fabsf(vb[j][2 * k]), fabsf(vb[j][2 * k + 1]))); }
                }
                ama = wave_max(ama); amb = wave_max(amb);
                const float ia = ama > 0.f ? 127.f / ama : 0.f, ib = amb > 0.f ? 127.f / amb : 0.f;
                unsigned char* qa = (unsigned char*)OA + (size_t)m * (2 * WA); unsigned char* qb = (unsigned char*)(hr + C_QB);
#pragma unroll
                for (int j = 0; j < 3; ++j) { const int col = 8 * (lane + 64 * j);
                    unsigned long long pa = (unsigned long long)pack4q(va[j][0] * ia, va[j][1] * ia, va[j][2] * ia, va[j][3] * ia) | ((unsigned long long)pack4q(va[j][4] * ia, va[j][5] * ia, va[j][6] * ia, va[j][7] * ia) << 32);
                    unsigned long long pb = (unsigned long long)pack4q(vb[j][0] * ib, vb[j][1] * ib, vb[j][2] * ib, vb[j][3] * ib) | ((unsigned long long)pack4q(vb[j][4] * ib, vb[j][5] * ib, vb[j][6] * ib, vb[j][7] * ib) << 32);
                    *(unsigned long long*)(qa + col) = pa; *(unsigned long long*)(qb + col) = pb; }
                if (lane == 0) { SC[SC_SAA + m] = ama > 0.f ? ama * (1.f / 127.f) : 1.f; SC[SC_SAB + m] = amb > 0.f ? amb * (1.f / 127.f) : 1.f; }
            }
            SEAM(pb + 3);
        }

        if (IN(pb + 4)) { PH_IDS;
            { pg8::Gemm g{OA, (const bf16*)(WUAQ + (size_t)l * DM * WA), M, DM, WA / 2, WA}; pg8::StaticOrder S; S.init(M, DM, G, bx);
              pg8::EpiGate<false> E{H + C_G, NPAD, b_gate + (size_t)l * 2 * DM, nullptr, MF, DM, SC + SC_SAA, SC + SC_SWUA + l * DM};
              pg8::gemm_phase<pg8::EpiGate<false>, pg8::StaticOrder, true, true, true>((PG8_LAS unsigned char*)lds, g, S, E); }
            { pg8::Gemm g{H + C_QB, (const bf16*)(WUBQ + (size_t)l * DM * WA), M, DM, WA / 2, NPAD}; pg8::StaticOrder S; S.init(M, DM, G, bx);
              pg8::EpiGate<true> E{H + C_G + DM, NPAD, b_gate + (size_t)l * 2 * DM + DM, MF, XB, DM, SC + SC_SAB, SC + SC_SWUB + l * DM};
              pg8::gemm_phase<pg8::EpiGate<true>, pg8::StaticOrder, true, true, true>((PG8_LAS unsigned char*)lds, g, S, E); }
            SEAM(pb + 4);
        }
        if (IN(pb + 5)) { PH_IDS;
            {
                unsigned char* MQ = ws + WS_MF; float* SM = (float*)(ws + WS_SM);
                for (int m = gw; m < M; m += NGW) { u32x4 r4[4]; float amax = 0.f;
#pragma unroll
                    for (int j = 0; j < 4; ++j) { r4[j] = *(const u32x4*)(XB + (size_t)m * DM + 8 * (lane + 64 * j));
#pragma unroll
                        for (int k = 0; k < 4; ++k) amax = fmaxf(amax, fmaxf(fabsf(bflo(r4[j][k])), fabsf(bfhi(r4[j][k])))); }
                    amax = wave_max(amax); const float inv = amax > 0.f ? 127.f / amax : 0.f;
#pragma unroll
                    for (int j = 0; j < 4; ++j) { const unsigned long long p = (unsigned long long)pack4q(bflo(r4[j][0]) * inv, bfhi(r4[j][0]) * inv, bflo(r4[j][1]) * inv, bfhi(r4[j][1]) * inv) |
                            ((unsigned long long)pack4q(bflo(r4[j][2]) * inv, bfhi(r4[j][2]) * inv, bflo(r4[j][3]) * inv, bfhi(r4[j][3]) * inv) << 32);
                        *(unsigned long long*)(MQ + (size_t)m * DM + 8 * (lane + 64 * j)) = p; }
                    if (lane == 0) SM[m] = amax > 0.f ? amax * (1.f / 127.f) : 1.f; }
                if (hi - lo > 1) xcd_barrier(xbar);
            }
            pg8::Gemm g{(const bf16*)(ws + WS_MF), (const bf16*)(ws + WS_WOUT + (size_t)l * DM * DM), M, DM, DM / 2, DM / 2}; pg8::StaticOrder S; S.init(M, DM, G, bx);
            pg8::EpiOut E{l == 0 ? x_in : out, out, DM, ALPHA, l == 0 ? nullptr : (const float*)(ws + WS_STATS), ln_g + (size_t)(l > 0 ? l - 1 : 0) * DM, ln_b + (size_t)(l > 0 ? l - 1 : 0) * DM, (const float*)(ws + WS_SM), SC + SC_SWOUT + l * DM};
            pg8::gemm_phase<pg8::EpiOut, pg8::StaticOrder, true, true, true>((PG8_LAS unsigned char*)lds, g, S, E);
            SEAM(pb + 5);
        }

        if (IN(pb + 6)) { PH_IDS;
            const float* gg = ln_g + (size_t)l * DM; const float* bb = ln_b + (size_t)l * DM;
            const int ln_ = l + 1 < DEPTH ? l + 1 : l; float swf = 1.f, bff = 0.f;
            { const unsigned char* wf = WINQ + (size_t)ln_ * NPAD * DM + (size_t)C_F * DM; (void)wf;
              if (lane < 12) { swf = SC[SC_SWIN + (size_t)ln_ * NPAD + C_F + lane]; bff = b_forget[ln_ * NH + lane]; } }
            for (int m = gw; m < M; m += NGW) {
                float* row = out + (size_t)m * DM; f32x4 v[8]; float s = 0.f;
#pragma unroll
                for (int j = 0; j < 8; ++j) { v[j] = *(const f32x4*)(row + 4 * lane + 256 * j); s += (v[j][0] + v[j][1]) + (v[j][2] + v[j][3]); }
                const float mean = wave_sum(s) * (1.f / DM); float s2 = 0.f;
#pragma unroll
                for (int j = 0; j < 8; ++j) { v[j] = v[j] - mean; s2 += (v[j][0] * v[j][0] + v[j][1] * v[j][1]) + (v[j][2] * v[j][2] + v[j][3] * v[j][3]); }
                const float rstd = 1.f / sqrtf(wave_sum(s2) * (1.f / DM) + LN_EPS);
                const bool lastl = l == DEPTH - 1;
#pragma unroll
                for (int j = 0; j < 8; ++j) { const int c = 4 * lane + 256 * j; const f32x4 gv = *(const f32x4*)(gg + c), bv = *(const f32x4*)(bb + c);
                    v[j] = v[j] * rstd * gv + bv; if (lastl) *(f32x4*)(row + c) = v[j]; }
                if (!lastl) { if (lane == 0) { float* st = (float*)(ws + WS_STATS) + 2 * (size_t)m; st[0] = mean; st[1] = rstd; }
                    unsigned q[8]; const float sxr = quant_row_q(v, XQ + (size_t)m * DM, SC + SC_SX + m, lane, q);
                    float zsel = 0.f;
#define lsig_(z_) ([](float z) { return fminf(z, 0.f) - __logf(1.f + __expf(-fabsf(z))); }(z_))
#pragma unroll
                    for (int h = 0; h < 12; ++h) { int a = 0; const unsigned char* wfh = WINQ + (size_t)ln_ * NPAD * DM + (size_t)(C_F + h) * DM + 4 * lane;
#pragma unroll
                        for (int j = 0; j < 8; ++j) a = __builtin_amdgcn_sdot4((int)q[j], *(const int*)(wfh + 256 * j), a, false);
#pragma unroll
                        for (int o = 1; o < 64; o <<= 1) a += __shfl_xor(a, o);
                        if (lane == h) zsel = (float)a; }
                    if (lane < 12) LOGF[((size_t)(m >> 13) * NH + lane) * SEQ + (m & 8191)] = lsig_(zsel * sxr * swf + bff); }
            }
            SEAM(pb + 6);
        }
    }
#undef IN
#undef SEAM
}

extern "C" void kernel_launch(void* const* d_in, const int* in_sizes, int n_in, void* d_out, int out_size, void* d_ws, size_t ws_size, hipStream_t stream) {
    static int grid = 0;
    if (grid == 0) {
        if (n_in != 9 || in_sizes[0] != M * DM || out_size != M * DM || ws_size < WS_END) { fprintf(stderr, "kernel_launch: unexpected shapes / workspace (n_in %d, ws %zu)\n", n_in, ws_size); grid = -1; return; }
        int dev = 0, cus = 0, per_cu = 0;
        (void)hipGetDevice(&dev); (void)hipDeviceGetAttribute(&cus, hipDeviceAttributeMultiprocessorCount, dev);
        if (hipFuncSetAttribute((const void*)mega_fwd, hipFuncAttributeMaxDynamicSharedMemorySize, LDS_BYTES) != hipSuccess) { fprintf(stderr, "kernel_launch: hipFuncSetAttribute failed\n"); grid = -1; return; }
        if (hipOccupancyMaxActiveBlocksPerMultiprocessor(&per_cu, (const void*)mega_fwd, 512, LDS_BYTES) != hipSuccess || per_cu < 1) { fprintf(stderr, "kernel_launch: occupancy query says %d\n", per_cu); per_cu = 1; }
        (void)hipGetLastError();
        if (cus <= 0) cus = 256;
        grid = cus * per_cu;
    }
    if (grid < 0) return;
    if (hipMemsetAsync((char*)d_ws + WS_BAR, 0, XCD_BAR_WORDS * 4, stream) != hipSuccess) { fprintf(stderr, "kernel_launch: hipMemsetAsync of the barrier words failed\n"); return; }
    Args a{};
    for (int i = 0; i < 9; ++i) a.in[i] = (const float*)d_in[i];
    a.out = (float*)d_out; a.ws = (unsigned char*)d_ws;
    a.ph_lo = 0; a.ph_hi = NPH;
    void* kargs[] = {&a};
    hipError_t e = hipLaunchCooperativeKernel((const void*)mega_fwd, dim3(grid), dim3(512), kargs, LDS_BYTES, stream);
    if (e != hipSuccess) fprintf(stderr, "kernel_launch: cooperative launch failed: %s (grid %d)\n", hipGetErrorString(e), grid);
}
```

```cpp
#include <hip/hip_runtime.h>
#include <hip/hip_cooperative_groups.h>
#include <cstdio>
#include <cstdint>
namespace cg = cooperative_groups;
namespace pg8 {
#define PG8_LAS __attribute__((address_space(3)))
typedef unsigned short bf16_t;
typedef short bf16x8 __attribute__((ext_vector_type(8)));
typedef float f32x4 __attribute__((ext_vector_type(4)));
typedef unsigned u32x4 __attribute__((ext_vector_type(4)));
constexpr int BM = 256, BK = 64, HALF = 128, HTB = HALF * BK * 2  , STAGE_BYTES = 8 * HTB, NXCD = 8, WGM = 8;

__host__ __device__ __forceinline__ int lds_byte(int r, int c) { const int st = (r >> 4) * 2 + (c >> 5), rr = r & 15, cc = c & 31, ob = rr * 64 + cc * 2; return st * 1024 + (ob ^ (((ob >> 9) & 1) << 5)); }
__host__ __device__ __forceinline__ void stage_rc(int b, int& R, int& C) { const int st = b / 1024, sb = b % 1024, swz = sb ^ (((sb >> 9) & 1) << 5); R = (st >> 1) * 16 + swz / 64; C = (st & 1) * 32 + (swz % 64) / 2; }
__host__ __device__ __forceinline__ int perm32(int rho) { const int n = rho >> 4, i = rho & 15; return 8 * (i >> 2) + 4 * n + (i & 3); }

struct Unit { int pm, pn; };
struct Gemm { const bf16_t* A; const bf16_t* Bt; int M, N, K, lda; };

struct StaticOrder {
    int nM, nN, nwg, G, c;
    __host__ __device__ void init(int M, int N, int G_, int c_) { nM = M / BM; nN = N / BM; nwg = nM * nN; G = G_; c = c_; }
    __host__ __device__ bool next(int i, Unit& u) const {
        const long L = (long)i * G + c; if (L >= nwg) return false;
        int wgid = (int)L; { const int q = nwg / NXCD, r = nwg % NXCD, xcd = wgid % NXCD, off = wgid / NXCD; wgid = (xcd < r ? xcd * (q + 1) : r * (q + 1) + (xcd - r) * q) + off; }
        const int nig = WGM * nN, gid = wgid / nig, fm = gid * WGM, gsz = (nM - fm) < WGM ? (nM - fm) : WGM;
        u.pm = fm + ((wgid % nig) % gsz); u.pn = (wgid % nig) / gsz; return true;
    }
    __device__ __forceinline__ void a_ready(const Unit&) const {}
    __device__ __forceinline__ void done(const Unit&) const {}
};

__device__ __forceinline__ unsigned cvt_pk_bf16(float lo, float hi) { unsigned r; asm volatile("v_cvt_pk_bf16_f32 %0, %1, %2" : "=v"(r) : "v"(lo), "v"(hi)); return r; }
typedef float f32x2 __attribute__((ext_vector_type(2)));
typedef unsigned u32x2 __attribute__((ext_vector_type(2)));
typedef int i32x4 __attribute__((ext_vector_type(4)));
template <bool I8> struct AccSel { typedef f32x4 type; };
template <> struct AccSel<true> { typedef i32x4 type; };
__device__ __forceinline__ f32x4 cvt4(i32x4 a, float s) { return (f32x4){(float)a[0] * s, (float)a[1] * s, (float)a[2] * s, (float)a[3] * s}; }
__device__ __forceinline__ float bf_lo(unsigned w) { return __uint_as_float(w << 16); }
__device__ __forceinline__ float bf_hi(unsigned w) { return __uint_as_float(w & 0xffff0000u); }
__device__ __forceinline__ float sigm(float z) { return __builtin_amdgcn_rcpf(1.f + __builtin_amdgcn_exp2f(-1.4426950408889634f * z)); }
__device__ __forceinline__ float logsig(float z) { return fminf(z, 0.f) - log1pf(expf(-fabsf(z))); }

struct EpiIn {
    static constexpr bool PERM = true, AFTER_DRAIN = false;
    bf16_t* H; int ldh; const float* cosT; const float* sinT; float* logf; const float* bfg; const float* sx; const float* sw; float* pn2;
    __device__ __forceinline__ void operator()(const i32x4 (&acc)[2][2][4][2], const Unit& u, int wr, int wc, int fr, int fq) const {
        asm volatile("" : "+v"(fr), "+v"(fq));
        const int row0 = u.pm * BM + wr * 64 + fr;
        if (u.pn == 64) {
            if (wc == 0 && fq < 2) {
                const f32x4 b0 = *(const f32x4*)(bfg + 8 * fq); const f32x4 b1 = fq == 0 ? *(const f32x4*)(bfg + 4) : (f32x4){0.f, 0.f, 0.f, 0.f};
                const f32x4 w0 = *(const f32x4*)(sw + u.pn * BM + 8 * fq), w1 = *(const f32x4*)(sw + u.pn * BM + 8 * fq + 4);
#pragma unroll
                for (int ai = 0; ai < 2; ++ai)
#pragma unroll
                    for (int m = 0; m < 4; ++m) { const int row = row0 + ai * HALF + m * 16; const float sr = sx[row];
                        float* o = logf + ((size_t)(row >> 13) * 12 + 8 * fq) * 8192 + (row & 8191);
                        const f32x4 v0 = cvt4(acc[ai][0][m][0], sr) * w0 + b0; o[0] = logsig(v0[0]); o[8192] = logsig(v0[1]); o[2 * 8192] = logsig(v0[2]); o[3 * 8192] = logsig(v0[3]);
                        if (fq == 0) { const f32x4 v1 = cvt4(acc[ai][0][m][1], sr) * w1 + b1; o[4 * 8192] = logsig(v1[0]); o[5 * 8192] = logsig(v1[1]); o[6 * 8192] = logsig(v1[2]); o[7 * 8192] = logsig(v1[3]); } }
            }
            return;
        }
        const bool rope = u.pn < 12, nrm = u.pn >= 24 && u.pn < 36;
        const int i0 = 16 * wc + 4 * fq;
#pragma unroll
        for (int bj = 0; bj < 2; ++bj) { const int col0 = u.pn * BM + bj * HALF + wc * 32 + 8 * fq;
            const f32x4 w0 = *(const f32x4*)(sw + col0), w1 = *(const f32x4*)(sw + col0 + 4);
#pragma unroll
            for (int ai = 0; ai < 2; ++ai)
#pragma unroll
                for (int m = 0; m < 4; ++m) { const int row = row0 + ai * HALF + m * 16; const float sr = sx[row];
                    f32x4 v0 = cvt4(acc[ai][bj][m][0], sr) * w0, v1 = cvt4(acc[ai][bj][m][1], sr) * w1;
                    if (rope) { const int pos = row & 8191; const f32x4 c = *(const f32x4*)(cosT + pos * 64 + i0), s = *(const f32x4*)(sinT + pos * 64 + i0);
                        const f32x4 o0 = v0 * c - v1 * s, o1 = v0 * s + v1 * c; v0 = o0; v1 = o1; }
                    if (nrm) { float s2 = (v0[0] * v0[0] + v0[1] * v0[1]) + (v0[2] * v0[2] + v0[3] * v0[3]) + (v1[0] * v1[0] + v1[1] * v1[1]) + (v1[2] * v1[2] + v1[3] * v1[3]);
                        s2 += __shfl_xor(s2, 16); s2 += __shfl_xor(s2, 32);
                        if (fq == 0) pn2[((size_t)row * 24 + (u.pn - 24) * 2 + bj) * 4 + wc] = s2; }
                    u32x4 w; w.x = cvt_pk_bf16(v0[0], v0[1]); w.y = cvt_pk_bf16(v0[2], v0[3]); w.z = cvt_pk_bf16(v1[0], v1[1]); w.w = cvt_pk_bf16(v1[2], v1[3]);
                    *(u32x4*)(H + (size_t)row * ldh + col0) = w; } }
    }
};
template <bool ADD> struct EpiGate {
    static constexpr bool PERM = true, AFTER_DRAIN = false; static constexpr int NB = 2;
    const bf16_t* Hg; int ldh; const float* bg; const bf16_t* Mf; bf16_t* O; int ldo; const float* sa; const float* sb;
    __device__ __forceinline__ void operator()(const i32x4 (&acc)[2][2][4][2], const Unit& u, int wr, int wc, int fr, int fq) const {
        asm volatile("" : "+v"(fr), "+v"(fq));
        const int row0 = u.pm * BM + wr * 64 + fr;
#pragma unroll
        for (int bj = 0; bj < 2; ++bj) { const int col0 = u.pn * BM + bj * HALF + wc * 32 + 8 * fq;
            const f32x4 g0 = *(const f32x4*)(bg + col0), g1 = *(const f32x4*)(bg + col0 + 4), w0 = *(const f32x4*)(sb + col0), w1 = *(const f32x4*)(sb + col0 + 4);
#pragma unroll
            for (int ai = 0; ai < 2; ++ai)
#pragma unroll
              for (int mb = 0; mb < 4; mb += NB) {
                u32x4 gl[NB], pm[NB]; float sr[NB];
#pragma unroll
                for (int q = 0; q < NB; ++q) { const int row = row0 + ai * HALF + (mb + q) * 16;
                    gl[q] = *(const u32x4*)(Hg + (size_t)row * ldh + col0); if (ADD) pm[q] = *(const u32x4*)(Mf + (size_t)row * ldo + col0); sr[q] = sa[row]; }
                asm volatile("" ::: "memory");
#pragma unroll
                for (int q = 0; q < NB; ++q) { const int m = mb + q; const int row = row0 + ai * HALF + m * 16;
                    f32x4 v0 = cvt4(acc[ai][bj][m][0], sr[q]) * w0, v1 = cvt4(acc[ai][bj][m][1], sr[q]) * w1;
                    v0[0] *= sigm(bf_lo(gl[q].x) + g0[0]); v0[1] *= sigm(bf_hi(gl[q].x) + g0[1]); v0[2] *= sigm(bf_lo(gl[q].y) + g0[2]); v0[3] *= sigm(bf_hi(gl[q].y) + g0[3]);
                    v1[0] *= sigm(bf_lo(gl[q].z) + g1[0]); v1[1] *= sigm(bf_hi(gl[q].z) + g1[1]); v1[2] *= sigm(bf_lo(gl[q].w) + g1[2]); v1[3] *= sigm(bf_hi(gl[q].w) + g1[3]);
                    if (ADD) { v0[0] += bf_lo(pm[q].x); v0[1] += bf_hi(pm[q].x); v0[2] += bf_lo(pm[q].y); v0[3] += bf_hi(pm[q].y); v1[0] += bf_lo(pm[q].z); v1[1] += bf_hi(pm[q].z); v1[2] += bf_lo(pm[q].w); v1[3] += bf_hi(pm[q].w); }
                    u32x4 w; w.x = cvt_pk_bf16(v0[0], v0[1]); w.y = cvt_pk_bf16(v0[2], v0[3]); w.z = cvt_pk_bf16(v1[0], v1[1]); w.w = cvt_pk_bf16(v1[2], v1[3]);
                    *(u32x4*)(O + (size_t)row * ldo + col0) = w; }
                asm volatile("" ::: "memory"); } }
    }
};
struct EpiOut {
    static constexpr bool PERM = false, AFTER_DRAIN = false;
    const float* X; float* T; int ldc; float alpha; const float* stats; const float* lg; const float* lb; const float* sa; const float* sb;
    __device__ __forceinline__ void operator()(const i32x4 (&acc)[2][2][4][2], const Unit& u, int wr, int wc, int fr, int fq) const {
        asm volatile("" : "+v"(fr), "+v"(fq));
        const int row0 = u.pm * BM + wr * 64 + fr, col0 = u.pn * BM + wc * 32 + 4 * fq;
#pragma unroll
        for (int ai = 0; ai < 2; ++ai)
#pragma unroll
            for (int mp = 0; mp < 4; mp += 2) { f32x4 xv0[2][2], xv1[2][2]; float mu0 = 0.f, mu1 = 0.f, rs0 = 1.f, rs1 = 1.f;
                const int rowa = row0 + ai * HALF + mp * 16, rowb = rowa + 16; const size_t offa = (size_t)rowa * ldc + col0, offb = (size_t)rowb * ldc + col0;
                if (stats) { mu0 = stats[2 * rowa]; rs0 = stats[2 * rowa + 1]; mu1 = stats[2 * rowb]; rs1 = stats[2 * rowb + 1]; }
                const float sra = sa[rowa], srb = sa[rowb];
#pragma unroll
                for (int bj = 0; bj < 2; ++bj)
#pragma unroll
                    for (int n = 0; n < 2; ++n) { xv0[bj][n] = *(const f32x4*)(X + offa + bj * HALF + n * 16); xv1[bj][n] = *(const f32x4*)(X + offb + bj * HALF + n * 16); }
                asm volatile("" ::: "memory");
#pragma unroll
                for (int bj = 0; bj < 2; ++bj)
#pragma unroll
                    for (int n = 0; n < 2; ++n) { f32x4 xa = xv0[bj][n], xb = xv1[bj][n];
                        if (stats) { const f32x4 gv = *(const f32x4*)(lg + col0 + bj * HALF + n * 16), bv = *(const f32x4*)(lb + col0 + bj * HALF + n * 16);
                            xa = (xa - mu0) * rs0 * gv + bv; xb = (xb - mu1) * rs1 * gv + bv; }
                        const f32x4 wv = *(const f32x4*)(sb + col0 + bj * HALF + n * 16);
                        *(f32x4*)(T + offa + bj * HALF + n * 16) = xa * alpha + cvt4(acc[ai][bj][mp][n], sra) * wv;
                        *(f32x4*)(T + offb + bj * HALF + n * 16) = xb * alpha + cvt4(acc[ai][bj][mp + 1][n], srb) * wv; }
                asm volatile("" ::: "memory"); }
    }
};
template <class Epi, class Sched, bool ALIGN_EPI = false, bool SP2 = false, bool I8 = false>
__device__ __forceinline__ void gemm_phase(PG8_LAS unsigned char* lds, const Gemm g, const Sched& S, const Epi& E) {
    int tid = threadIdx.x; asm volatile("" : "+v"(tid));
    const int wid = __builtin_amdgcn_readfirstlane(tid >> 6), lane = tid & 63, wr = wid >> 2, wc = wid & 3, fr = lane & 15, fq = lane >> 4;
    const int K = g.K, nt = K / BK;
    unsigned voffA[2], voffB[2];
#pragma unroll
    for (int i = 0; i < 2; ++i) { int R, C; stage_rc(tid * 16 + i * 8192, R, C); const int Rb = Epi::PERM ? ((R & ~31) + perm32(R & 31)) : R;
        voffA[i] = (unsigned)(R * g.lda + C) * 2u; voffB[i] = (unsigned)(Rb * K + C) * 2u; }
    const size_t kstep = (size_t)(BK * 2);
    const size_t hstepA = (size_t)HALF * g.lda * 2, hstepB = (size_t)HALF * K * 2;
    const size_t tstepA = 2 * hstepA, tstepB = 2 * hstepB;
    const unsigned ldsw = (unsigned)wid * 1024u;
    const int aoff = lds_byte(wr * 64 + fr, fq * 8), boff = lds_byte(wc * 32 + fr, fq * 8);
#define PG8_SA(b, h) (((b) * 2 + (h)) * HTB)
#define PG8_SB(b, h) ((4 + (b) * 2 + (h)) * HTB)
#define PG8_STAGE(bufoff, gbase, voff) do { _Pragma("unroll") for (int _i = 0; _i < 2; ++_i) \
        __builtin_amdgcn_global_load_lds((const unsigned*)((const char*)(gbase) + (voff)[_i]), (PG8_LAS unsigned*)(lds + (bufoff) + ldsw + _i * 8192), 16, 0, 0); } while (0)
#define PG8_LDA(dst, b, h) do { _Pragma("unroll") for (int m = 0; m < 4; ++m) _Pragma("unroll") for (int k = 0; k < 2; ++k) dst[m][k] = *(const PG8_LAS bf16x8*)(lds + PG8_SA(b, h) + aoff + m * 2048 + k * 1024); } while (0)
#define PG8_LDB(dst, b, h) do { _Pragma("unroll") for (int n = 0; n < 2; ++n) _Pragma("unroll") for (int k = 0; k < 2; ++k) dst[n][k] = *(const PG8_LAS bf16x8*)(lds + PG8_SB(b, h) + boff + n * 2048 + k * 1024); } while (0)
#define PG8_MMA(ai, bj, At, Bt) do { __builtin_amdgcn_s_setprio(1); _Pragma("unroll") for (int m = 0; m < 4; ++m) _Pragma("unroll") for (int n = 0; n < 2; ++n) _Pragma("unroll") for (int k = 0; k < 2; ++k) \
        { if constexpr (I8) acc[ai][bj][m][n] = __builtin_amdgcn_mfma_i32_16x16x64_i8(__builtin_bit_cast(i32x4, Bt[n][k]), __builtin_bit_cast(i32x4, At[m][k]), acc[ai][bj][m][n], 0, 0, 0); \
          else acc[ai][bj][m][n] = __builtin_amdgcn_mfma_f32_16x16x32_bf16(Bt[n][k], At[m][k], acc[ai][bj][m][n], 0, 0, 0); } __builtin_amdgcn_s_setprio(0); } while (0)
#define PG8_WAIT_V(n) asm volatile("s_waitcnt vmcnt(" #n ")" ::: "memory")
#define PG8_WAIT_L(n) asm volatile("s_waitcnt lgkmcnt(" #n ")" ::: "memory")
#define PG8_BAR __builtin_amdgcn_s_barrier()
#define PG8_SCHED __builtin_amdgcn_sched_barrier(0)
    Unit cur, nxt; int ui = 0;
    if (!S.next(0, cur)) return;
    typedef typename AccSel<I8>::type AccT; AccT acc[2][2][4][2];
#pragma unroll
    for (int a = 0; a < 2; ++a)
#pragma unroll
        for (int b = 0; b < 2; ++b)
#pragma unroll
            for (int m = 0; m < 4; ++m)
#pragma unroll
                for (int n = 0; n < 2; ++n) acc[a][b][m][n] = AccT{};
    bf16x8 At[4][2], B0[2][2], B1[2][2];
    const char* cA = (const char*)g.A + (size_t)cur.pm * tstepA; const char* cB = (const char*)g.Bt + (size_t)cur.pn * tstepB;
    S.a_ready(cur);
    if constexpr (SP2) {
        PG8_STAGE(PG8_SB(0, 0), cB, voffB); PG8_STAGE(PG8_SB(0, 1), cB + hstepB, voffB); PG8_STAGE(PG8_SA(0, 0), cA, voffA); PG8_STAGE(PG8_SA(0, 1), cA + hstepA, voffA);
        if (wr == 1) PG8_BAR;
        PG8_WAIT_V(2); PG8_BAR;
        PG8_STAGE(PG8_SB(1, 0), cB + kstep, voffB); PG8_STAGE(PG8_SA(1, 0), cA + kstep, voffA); PG8_STAGE(PG8_SB(1, 1), cB + hstepB + kstep, voffB);
        PG8_WAIT_V(6); PG8_BAR;
    } else {
        PG8_STAGE(PG8_SB(0, 0), cB, voffB); PG8_STAGE(PG8_SA(0, 0), cA, voffA); PG8_STAGE(PG8_SB(0, 1), cB + hstepB, voffB); PG8_STAGE(PG8_SA(0, 1), cA + hstepA, voffA);
        if (wr == 1) PG8_BAR;
        PG8_WAIT_V(4); PG8_BAR;
        PG8_STAGE(PG8_SB(1, 0), cB + kstep, voffB); PG8_STAGE(PG8_SA(1, 0), cA + kstep, voffA); PG8_STAGE(PG8_SB(1, 1), cB + hstepB + kstep, voffB);
        PG8_WAIT_V(6); PG8_BAR;
    }
    for (;;) {
        const bool has_next = S.next(ui + 1, nxt);
        const char* nA = has_next ? (const char*)g.A + (size_t)nxt.pm * tstepA : cA; const char* nB = has_next ? (const char*)g.Bt + (size_t)nxt.pn * tstepB : cB;
        for (int t = 0; t < nt; t += 2) {
            const bool last = (t == nt - 2);
            const char* a1 = cA + (size_t)(t + 1) * kstep;
            const char* a2 = last ? nA : cA + (size_t)(t + 2) * kstep; const char* b2 = last ? nB : cB + (size_t)(t + 2) * kstep;
            const char* a3 = a2 + kstep; const char* b3 = b2 + kstep;
            if (last && has_next) S.a_ready(nxt);
            if constexpr (SP2) {
            PG8_LDB(B0, 0, 0); PG8_LDB(B1, 0, 1); PG8_SCHED; PG8_LDA(At, 0, 0); PG8_STAGE(PG8_SA(1, 1), a1 + hstepA, voffA);
            PG8_WAIT_V(8); PG8_WAIT_L(0); PG8_BAR; PG8_MMA(0, 0, At, B0); PG8_MMA(0, 1, At, B1); PG8_BAR; PG8_SCHED;
            PG8_LDA(At, 0, 1); PG8_STAGE(PG8_SB(0, 0), b2, voffB); PG8_STAGE(PG8_SB(0, 1), b2 + hstepB, voffB); PG8_STAGE(PG8_SA(0, 0), a2, voffA);
            PG8_WAIT_V(8); PG8_WAIT_L(0); PG8_BAR; PG8_MMA(1, 0, At, B0); PG8_MMA(1, 1, At, B1); PG8_BAR; PG8_SCHED;
            PG8_LDB(B0, 1, 0); PG8_LDB(B1, 1, 1); PG8_SCHED; PG8_LDA(At, 1, 0); PG8_STAGE(PG8_SA(0, 1), a2 + hstepA, voffA);
            PG8_WAIT_V(8); PG8_WAIT_L(0); PG8_BAR; PG8_MMA(0, 0, At, B0); PG8_MMA(0, 1, At, B1); PG8_BAR; PG8_SCHED;
            PG8_LDA(At, 1, 1); PG8_STAGE(PG8_SB(1, 0), b3, voffB); PG8_STAGE(PG8_SB(1, 1), b3 + hstepB, voffB); PG8_STAGE(PG8_SA(1, 0), a3, voffA);
            PG8_WAIT_V(8); PG8_WAIT_L(0); PG8_BAR; PG8_MMA(1, 0, At, B0); PG8_MMA(1, 1, At, B1); PG8_BAR; PG8_SCHED;
            } else {
            PG8_LDB(B0, 0, 0); PG8_SCHED; PG8_LDA(At, 0, 0); PG8_STAGE(PG8_SA(1, 1), a1 + hstepA, voffA);
            PG8_WAIT_L(8); PG8_BAR; PG8_WAIT_L(0); PG8_MMA(0, 0, At, B0); PG8_BAR; PG8_SCHED;
            PG8_LDB(B1, 0, 1); PG8_STAGE(PG8_SB(0, 0), b2, voffB);
            PG8_BAR; PG8_WAIT_L(0); PG8_MMA(0, 1, At, B1); PG8_BAR;
            PG8_LDA(At, 0, 1); PG8_STAGE(PG8_SA(0, 0), a2, voffA);
            PG8_BAR; PG8_WAIT_L(0); PG8_MMA(1, 0, At, B0); PG8_BAR; PG8_SCHED;
            PG8_STAGE(PG8_SB(0, 1), b2 + hstepB, voffB);
            PG8_WAIT_V(6); PG8_BAR; PG8_MMA(1, 1, At, B1); PG8_BAR;
            PG8_LDB(B0, 1, 0); PG8_SCHED; PG8_LDA(At, 1, 0); PG8_STAGE(PG8_SA(0, 1), a2 + hstepA, voffA);
            PG8_WAIT_L(8); PG8_BAR; PG8_WAIT_L(0); PG8_MMA(0, 0, At, B0); PG8_BAR; PG8_SCHED;
            PG8_LDB(B1, 1, 1); PG8_STAGE(PG8_SB(1, 0), b3, voffB);
            PG8_BAR; PG8_WAIT_L(0); PG8_MMA(0, 1, At, B1); PG8_BAR;
            PG8_LDA(At, 1, 1); PG8_STAGE(PG8_SA(1, 0), a3, voffA);
            PG8_BAR; PG8_WAIT_L(0); PG8_MMA(1, 0, At, B0); PG8_BAR; PG8_SCHED;
            PG8_STAGE(PG8_SB(1, 1), b3 + hstepB, voffB);
            PG8_WAIT_V(6); PG8_BAR; PG8_MMA(1, 1, At, B1); PG8_BAR;
            }
        }
        if constexpr (ALIGN_EPI) { if (wr == 0) PG8_BAR; }
        if constexpr (!Epi::AFTER_DRAIN) { E(acc, cur, wr, wc, fr, fq); S.done(cur); }
        if (!has_next) break;
#pragma unroll
        for (int a = 0; a < 2; ++a)
#pragma unroll
            for (int b = 0; b < 2; ++b)
#pragma unroll
                for (int m = 0; m < 4; ++m)
#pragma unroll
                    for (int n = 0; n < 2; ++n) acc[a][b][m][n] = AccT{};
        cur = nxt; cA = nA; cB = nB; ++ui;
        if constexpr (ALIGN_EPI) { if (wr == 1) PG8_BAR; }
    }
    PG8_WAIT_V(0);
    if constexpr (!ALIGN_EPI) { if (wr == 0) PG8_BAR; }
    PG8_BAR;
    if constexpr (Epi::AFTER_DRAIN) { E.fused(acc, cur, wr, wc, fr, fq, lds, wid, lane); S.done(cur); }
#undef PG8_SA
#undef PG8_SB
#undef PG8_STAGE
#undef PG8_LDA
#undef PG8_LDB
#undef PG8_MMA
#undef PG8_WAIT_V
#undef PG8_WAIT_L
#undef PG8_BAR
#undef PG8_SCHED
}
}
namespace at {
typedef unsigned short bf16;
typedef short bf16x8 __attribute__((ext_vector_type(8)));
typedef short s16x4 __attribute__((ext_vector_type(4)));
typedef float f32x16 __attribute__((ext_vector_type(16)));
typedef float f32x4 __attribute__((ext_vector_type(4)));
typedef unsigned u32x4 __attribute__((ext_vector_type(4)));
constexpr int D = 128;
constexpr float SCALE = 0.08838834764831845f, INV_SCALE = 11.313708498984761f, THR = 8.f;
constexpr int NW = 8, QBLK = 32, KVBLK = 64, QB = NW * QBLK;
constexpr int SHM_V = KVBLK * D * 2, SHM_K = KVBLK * D * 2;
constexpr int LDS_ATT = 2 * SHM_V + 2 * SHM_K + NW * 64 * 4;
constexpr int BIAS_OFF = LDS_ATT, JLW_OFF = BIAS_OFF + 8192 * 4, LDS_TOTAL = JLW_OFF + 16;

#define KSWZ(row, colB) ((row) * 256 + ((colB) ^ (((row) & 7) << 4)))
#define SBAR() __builtin_amdgcn_sched_barrier(0)
#define LBAR() do { asm volatile("s_waitcnt lgkmcnt(0)" ::: "memory"); __builtin_amdgcn_s_barrier(); asm volatile("" ::: "memory"); } while (0)
__device__ __forceinline__ int v_st(int k, int c) { const int kk = (k & ~0xC) | ((k & 4) << 1) | ((k & 8) >> 1); return ((kk >> 3) * 4 + (c >> 5)) * 512 + ((kk & 7) * 32 + (c & 31)) * 2; }
__device__ __forceinline__ int v_rd_base(int lane) { return ((lane & 3) << 3) | (((lane >> 2) & 3) << 6) | (((lane >> 4) & 1) << 5) | (((lane >> 5) & 1) << 8); }
constexpr int v_rd_off(int d0, int ks, int half) { return d0 * 512 + ks * 4096 + half * 2048; }
__device__ __forceinline__ int crow(int r, int hi) { return (r & 3) + 8 * (r >> 2) + 4 * hi; }
__device__ __forceinline__ unsigned cvtpk(float lo, float hi) { unsigned r; asm volatile("v_cvt_pk_bf16_f32 %0, %1, %2" : "=v"(r) : "v"(lo), "v"(hi)); return r; }
__device__ __forceinline__ bf16x8 load8(const bf16* p) { return *reinterpret_cast<const bf16x8*>(p); }
__device__ __forceinline__ void mask_tile(f32x16& p0, f32x16& p1, int dq, unsigned W) {
    const float NEG = -__builtin_inff();
#pragma unroll
    for (int r = 0; r < 16; ++r) {
        const int c = (r & 3) + 8 * (r >> 2);
        if ((unsigned)(dq - c) >= W) p0[r] = NEG;
        if ((unsigned)(dq - c - 32) >= W) p1[r] = NEG;
    }
}
__device__ __forceinline__ void partialSM(f32x16& p0, f32x16& p1, float& m_reg, float& mn, float& alpha) {
    float pmax = p0[0]; for (int r = 1; r < 16; ++r) pmax = fmaxf(pmax, p0[r]); for (int r = 0; r < 16; ++r) pmax = fmaxf(pmax, p1[r]);
    { auto rr = __builtin_amdgcn_permlane32_swap(__float_as_uint(pmax), __float_as_uint(pmax), false, false);
      pmax = fmaxf(__uint_as_float(rr[0]), __uint_as_float(rr[1])); }
    constexpr float C2 = 1.4426950408889634f * SCALE;
    if (__builtin_expect(__all((pmax - m_reg) * SCALE <= THR), 1)) { mn = m_reg; alpha = 1.f; }
    else { mn = fmaxf(m_reg, pmax); alpha = __builtin_amdgcn_exp2f((m_reg - mn) * C2); m_reg = mn; }
    const float mnL = -mn * C2;
    for (int r = 0; r < 16; ++r) p0[r] = fmaf(p0[r], C2, mnL); for (int r = 0; r < 16; ++r) p1[r] = fmaf(p1[r], C2, mnL);
    for (int r = 0; r < 16; ++r) p0[r] = __builtin_amdgcn_exp2f(p0[r]);
}
__device__ __forceinline__ void finishSM(f32x16& p0, f32x16& p1, float alpha, float& l_reg, bf16x8& pa0, bf16x8& pa1, bf16x8& pa2, bf16x8& pa3) {
    for (int r = 0; r < 16; ++r) p1[r] = __builtin_amdgcn_exp2f(p1[r]);
    float ps = 0; for (int r = 0; r < 16; ++r) ps += p0[r]; for (int r = 0; r < 16; ++r) ps += p1[r];
    { auto rr = __builtin_amdgcn_permlane32_swap(__float_as_uint(ps), __float_as_uint(ps), false, false);
      ps = __uint_as_float(rr[0]) + __uint_as_float(rr[1]); }
    l_reg = l_reg * alpha + ps;
#define PK4(P, B_, OUT) do { unsigned a0 = cvtpk(P[B_+0], P[B_+1]), a1 = cvtpk(P[B_+2], P[B_+3]);                          \
        unsigned b0 = cvtpk(P[B_+4], P[B_+5]), b1 = cvtpk(P[B_+6], P[B_+7]);                                             \
        auto r0 = __builtin_amdgcn_permlane32_swap(a0, b0, false, false); auto r1 = __builtin_amdgcn_permlane32_swap(a1, b1, false, false); \
        u32x4 w = {r0[0], r1[0], r0[1], r1[1]}; OUT = *reinterpret_cast<bf16x8*>(&w); } while (0)
    PK4(p0, 0, pa0); PK4(p0, 8, pa1); PK4(p1, 0, pa2); PK4(p1, 8, pa3);
#undef PK4
}
template <int KB, bool SK>
__device__ __forceinline__ void qkt(f32x16& p0, f32x16& p1, const char* K_lds, int r32, int hi, const bf16x8* qr, bool act) {
    if (SK && !act) { const float NEG = -__builtin_inff();
#pragma unroll
        for (int r = 0; r < 16; ++r) { p0[r] = NEG; p1[r] = NEG; } return; }
    p0 = f32x16{}; p1 = f32x16{};
    const char* kb[4];
#pragma unroll
    for (int dd = 0; dd < 4; ++dd) kb[dd] = K_lds + KB * SHM_K + KSWZ(r32, (dd * 16 + hi * 8) * 2);
#pragma unroll
    for (int d0 = 0; d0 < 8; ++d0) { const char* a = kb[d0 & 3] + (d0 >> 2) * 128;
        bf16x8 b0 = *reinterpret_cast<const bf16x8*>(a);
        bf16x8 b1 = *reinterpret_cast<const bf16x8*>(a + 32 * 256);
        p0 = __builtin_amdgcn_mfma_f32_32x32x16_bf16(b0, qr[d0], p0, 0, 0, 0);
        p1 = __builtin_amdgcn_mfma_f32_32x32x16_bf16(b1, qr[d0], p1, 0, 0, 0); }
}
template <int VB, bool SK>
__device__ __forceinline__ void pv_tile(f32x16* o, int vb0, bf16x8 pa0, bf16x8 pa1, bf16x8 pa2, bf16x8 pa3, bool act) {
    if (SK && !act) return;
#define TRRD(dst, off) asm volatile("ds_read_b64_tr_b16 %0, %1 offset:%2" : "=&v"(dst) : "v"(vb0), "i"(off) : "memory")
#define PV_D0(d0) do { s16x4 l0, l1, l2, l3, h0, h1, h2, h3; constexpr int b_ = VB * SHM_V + v_rd_off(d0, 0, 0); \
        TRRD(l0, b_); TRRD(h0, b_ + 2048); TRRD(l1, b_ + 4096); TRRD(h1, b_ + 6144); TRRD(l2, b_ + 8192); TRRD(h2, b_ + 10240); TRRD(l3, b_ + 12288); TRRD(h3, b_ + 14336); \
        asm volatile("s_waitcnt lgkmcnt(0)" ::: "memory"); SBAR();   \
        o[d0] = __builtin_amdgcn_mfma_f32_32x32x16_bf16(pa0, (bf16x8){l0[0], l0[1], l0[2], l0[3], h0[0], h0[1], h0[2], h0[3]}, o[d0], 0, 0, 0);   \
        o[d0] = __builtin_amdgcn_mfma_f32_32x32x16_bf16(pa1, (bf16x8){l1[0], l1[1], l1[2], l1[3], h1[0], h1[1], h1[2], h1[3]}, o[d0], 0, 0, 0);   \
        o[d0] = __builtin_amdgcn_mfma_f32_32x32x16_bf16(pa2, (bf16x8){l2[0], l2[1], l2[2], l2[3], h2[0], h2[1], h2[2], h2[3]}, o[d0], 0, 0, 0);   \
        o[d0] = __builtin_amdgcn_mfma_f32_32x32x16_bf16(pa3, (bf16x8){l3[0], l3[1], l3[2], l3[3], h3[0], h3[1], h3[2], h3[3]}, o[d0], 0, 0, 0); } while (0)
    PV_D0(0); PV_D0(1); PV_D0(2); PV_D0(3);
#undef PV_D0
#undef TRRD
}
struct BlkRef { const bf16* Q; const bf16* K; const bf16* V; bf16* O; float* LSE; const float* CUM; int P0, pq, po, pl, skv; float thr; };
struct Seam { bf16x8 qr[8]; bf16x8 st_v0[1], st_v1[1], st_k0[1], st_k1[1]; int jlo; };
__device__ __forceinline__ int swa_jlo(int P0, int W) { const int lowk = P0 - W + 1; return lowk > 0 ? lowk / KVBLK : 0; }
#define ROW(p, k0, rr, pit) ((p) + (size_t)((k0) + (rr)) * (pit) + sc)
#define VMW() asm volatile("s_waitcnt vmcnt(0)" ::: "memory")
#define VMWN(n) asm volatile("s_waitcnt vmcnt(%0)" :: "i"(n) : "memory")
#define SLOAD_H(Z, Kp, Vp, k0, pit) do { S.st_v0[Z] = load8(ROW(Vp, k0, sr, pit)); S.st_v1[Z] = load8(ROW(Vp, k0, 32 + sr, pit));              \
                         S.st_k0[Z] = load8(ROW(Kp, k0, sr, pit)); S.st_k1[Z] = load8(ROW(Kp, k0, 32 + sr, pit)); } while (0)
#define SWRITE_HK(Z, bf) do { *(bf16x8*)(K_lds + (bf) * SHM_K + kws) = S.st_k0[Z]; *(bf16x8*)(K_lds + (bf) * SHM_K + kws + 32 * 256) = S.st_k1[Z]; } while (0)
#define SWRITE_HV(Z, bf) do { *(bf16x8*)(V_lds + (bf) * SHM_V + vst0) = S.st_v0[Z]; *(bf16x8*)(V_lds + (bf) * SHM_V + vst1) = S.st_v1[Z]; } while (0)
#define SWRITE_H(Z, bf) do { SWRITE_HV(Z, bf); SWRITE_HK(Z, bf); } while (0)
__device__ __forceinline__ int fox_jlo(const BlkRef& R, char* lds) {
    int tid = threadIdx.x; asm volatile("" : "+v"(tid));
    int* jlw = (int*)(lds + JLW_OFF); int nt0 = R.P0 / KVBLK; asm volatile("" : "+s"(nt0));
    if (tid == 0) *jlw = nt0;
    __syncthreads();
    if (tid < nt0) { if (R.CUM[R.P0] - R.CUM[KVBLK * tid + KVBLK - 1] >= -R.thr) atomicMin(jlw, tid); }
    __syncthreads();
    return *jlw;
}
template <bool FOX>
__device__ __forceinline__ void attn_prime(const BlkRef& cur, int W, char* lds, Seam& S) {
    int tid = threadIdx.x; asm volatile("" : "+v"(tid));
    const int wid = __builtin_amdgcn_readfirstlane(tid >> 6), lane = tid & 63, r32 = lane & 31, hi = lane >> 5;
    const int sr = tid >> 4, sc = (tid & 15) * 8, kws = KSWZ(sr, sc * 2); char* K_lds = lds + 2 * SHM_V;
    S.jlo = FOX ? fox_jlo(cur, lds) : swa_jlo(cur.P0, W);
    const int kb0 = S.jlo * KVBLK;
    for (int d0 = 0; d0 < 8; ++d0) S.qr[d0] = load8(cur.Q + (size_t)(wid * QBLK + r32) * cur.pq + d0 * 16 + hi * 8);
    SLOAD_H(0, cur.K, cur.V, kb0, cur.pq); VMW(); SWRITE_HK(0, 0);
    __syncthreads();
}
template <bool FOX, bool SK, int W>
__device__ __forceinline__ void attn_block(const BlkRef& cur, const BlkRef& nxt, char* lds, Seam& S) {
    int tid = threadIdx.x; asm volatile("" : "+v"(tid));
    const int wid = __builtin_amdgcn_readfirstlane(tid >> 6), lane = tid & 63, r32 = lane & 31, hi = lane >> 5;
    const int j_lo = S.jlo;
    int j_hi = (cur.P0 + QB - 1) / KVBLK + 1; if (j_hi > cur.skv / KVBLK) j_hi = cur.skv / KVBLK;
    const int NT = j_hi - j_lo;
    const int qlo = cur.P0 + wid * QBLK, qm = qlo + r32 - 4 * hi;
    char* V_lds = lds; char* K_lds = lds + 2 * SHM_V;
    float* ws = (float*)(lds + 2 * SHM_V + 2 * SHM_K) + wid * 64; float* li_l = ws, * al_l = ws + 32;
    float* bias = (float*)(lds + BIAS_OFF);
    const int sr = tid >> 4, sc = (tid & 15) * 8, vst0 = v_st(sr, sc), vst1 = vst0 + 8192  , kws = KSWZ(sr, sc * 2);
    const int vb0 = (int)(uintptr_t)V_lds + v_rd_base(lane);
    const bf16* Kh = cur.K; const bf16* Vh = cur.V; const int pq = cur.pq;
    if (FOX) {
        const float cref = cur.CUM[cur.P0]; const int nb_ = cur.P0 + QB;
        for (int j = j_lo * KVBLK + tid; j < nb_; j += NW * 64) bias[j] = (cref - cur.CUM[j]) * INV_SCALE;
    }
    if (FOX) __syncthreads();
    float m_reg = -1e30f, l_reg = 0; f32x16 o[4] = {};
#define RESC(a) do { if (__any((a) < 1.f)) { if (hi == 0) al_l[r32] = (a); asm volatile("s_waitcnt lgkmcnt(0)" ::: "memory");              \
                     for (int d_ = 0; d_ < 4; ++d_) for (int r = 0; r < 16; ++r) o[d_][r] *= al_l[crow(r, hi)]; } } while (0)
#define KBASE(t) ((j_lo + (t)) * KVBLK)
#define ACT(t) (KBASE(t) <= qlo + QBLK - 1 && KBASE(t) + KVBLK - 1 >= qlo - W + 1)
#define MASKT(P0_, P1_, t) do { const int kb_ = KBASE(t); \
        if (FOX) { const float* bp_ = bias + kb_ + 4 * hi; _Pragma("unroll") for (int g_ = 0; g_ < 4; ++g_) { const f32x4 b0_ = *(const f32x4*)(bp_ + 8 * g_), b1_ = *(const f32x4*)(bp_ + 32 + 8 * g_); \
            _Pragma("unroll") for (int e_ = 0; e_ < 4; ++e_) { P0_[4 * g_ + e_] += b0_[e_]; P1_[4 * g_ + e_] += b1_[e_]; } } } \
        if ((!SK || ACT(t)) && (kb_ + KVBLK - 1 > qlo || kb_ <= qlo + QBLK - 1 - W)) mask_tile(P0_, P1_, qm - kb_, (unsigned)W); } while (0)
    f32x16 pA0, pA1, pB0, pB1; float mnA, mnB, alA, alB; bf16x8 pa0, pa1, pa2, pa3;
    SWRITE_HV(0, 0); SBAR();
    if (NT > 1) { SLOAD_H(0, Kh, Vh, KBASE(1), pq); }
    SBAR(); qkt<0, SK>(pA0, pA1, K_lds, r32, hi, S.qr, ACT(0));
    MASKT(pA0, pA1, 0); partialSM(pA0, pA1, m_reg, mnA, alA);
    if (NT > 1) { VMW(); SWRITE_H(0, 1); }
    __syncthreads();
#define HALF_STEP(PX0, PX1, mnX, alX, PY0, PY1, alY, t, KB, VB, SB) do {                                                      \
        SBAR(); qkt<KB, SK>(PX0, PX1, K_lds, r32, hi, S.qr, ACT(t));                                             \
        finishSM(PY0, PY1, alY, l_reg, pa0, pa1, pa2, pa3); SBAR();                                                           \
        if ((t) + 1 < NT) { SLOAD_H(0, Kh, Vh, KBASE((t) + 1), pq); SBAR(); }                                               \
        pv_tile<VB, SK>(o, vb0, pa0, pa1, pa2, pa3, ACT((t) - 1)); MASKT(PX0, PX1, (t)); partialSM(PX0, PX1, m_reg, mnX, alX);                                        \
        __syncthreads();                                                                                                      \
        if ((t) + 1 < NT) { VMW(); SWRITE_H(0, SB); }                                                                          \
        RESC(alX); __syncthreads(); } while (0)
    for (int t = 1; t + 1 < NT; t += 2) {
        HALF_STEP(pB0, pB1, mnB, alB, pA0, pA1, alA, t, 1, 0, 0);
        HALF_STEP(pA0, pA1, mnA, alA, pB0, pB1, alB, t + 1, 0, 1, 1);
    }
    const bool even = (NT & 1) == 0;
    if (even) { SBAR(); qkt<1, SK>(pB0, pB1, K_lds, r32, hi, S.qr, ACT(NT - 1)); SBAR(); }
    const int jln = FOX ? fox_jlo(nxt, lds) : swa_jlo(nxt.P0, W); const int kbn = jln * KVBLK; S.jlo = jln;
    SLOAD_H(0, nxt.K, nxt.V, kbn, nxt.pq); SBAR();
#pragma unroll
    for (int d0 = 0; d0 < 8; ++d0) S.qr[d0] = load8(nxt.Q + (size_t)(wid * QBLK + r32) * nxt.pq + d0 * 16 + hi * 8);
    SBAR();
    finishSM(pA0, pA1, alA, l_reg, pa0, pa1, pa2, pa3); SBAR();
    pv_tile<0, SK>(o, vb0, pa0, pa1, pa2, pa3, ACT(even ? NT - 2 : NT - 1));
    if (even) { MASKT(pB0, pB1, NT - 1); partialSM(pB0, pB1, m_reg, mnB, alB); __syncthreads(); RESC(alB);
        finishSM(pB0, pB1, alB, l_reg, pa0, pa1, pa2, pa3); SBAR(); pv_tile<1, SK>(o, vb0, pa0, pa1, pa2, pa3, ACT(NT - 1)); }
    SBAR(); VMWN(8); SWRITE_HK(0, 0); SBAR();
    if (hi == 0) li_l[r32] = l_reg; asm volatile("s_waitcnt lgkmcnt(0)" ::: "memory");
    if (!FOX) { if (hi == 0) cur.LSE[(size_t)(wid * QBLK + r32) * cur.pl] = m_reg * SCALE + __logf(l_reg); }
    float rli[16];
#pragma unroll
    for (int r = 0; r < 16; ++r) rli[r] = __builtin_amdgcn_rcpf(li_l[crow(r, hi)]);
    bf16* Ow = cur.O + (size_t)(wid * QBLK) * cur.po;
#pragma unroll
    for (int r = 0; r < 16; ++r) { const int orow = crow(r, hi);
#pragma unroll
        for (int d0 = 0; d0 < 4; ++d0) { const float v = o[d0][r] * rli[r];
            const float vn = __shfl_xor(v, 1);
            if ((r32 & 1) == 0) *(unsigned*)(Ow + (size_t)orow * cur.po + d0 * 32 + r32) = cvtpk(v, vn); } }
    __syncthreads();
#undef RESC
#undef KBASE
#undef ACT
#undef MASKT
#undef HALF_STEP
}
#undef ROW
#undef VMW
#undef VMWN
#undef SLOAD_H
#undef SWRITE_HK
#undef SWRITE_HV
#undef SWRITE_H
}
#define LAS __attribute__((address_space(3)))
#define XB_TMO      128
#define XB_XCNT(j)  (256  + 64 * (j))
#define XB_XSUB(j)  (1280 + 64 * (j))
#define XB_XGEN(j)  (2304 + 64 * (j))
#define XB_TOP      3328
#define XB_TOPGEN   3392
#define XCD_BAR_WORDS 3456
#define XB_SPIN_CAP (1u << 18)

__device__ __forceinline__ unsigned xb_ld(unsigned* p)              { return __hip_atomic_load(p, __ATOMIC_RELAXED, __HIP_MEMORY_SCOPE_AGENT); }
__device__ __forceinline__ unsigned xb_add(unsigned* p, unsigned v) { return __hip_atomic_fetch_add(p, v, __ATOMIC_RELAXED, __HIP_MEMORY_SCOPE_AGENT); }
__device__ __forceinline__ unsigned xb_xcc_id() { return (unsigned)__builtin_amdgcn_s_getreg((3 << 11) | 20) & 0xFu; }
#define XB_SPIN(cond, bar) do { unsigned _sp = 0; while (cond) { __builtin_amdgcn_s_sleep(1); \
    if ((++_sp & 255u) == 0u) { if (xb_ld(&(bar)[XB_TMO])) break; if (_sp > XB_SPIN_CAP) { atomicAdd(&(bar)[XB_TMO], 1u); break; } } } } while (0)

struct XcdBarrier {
    unsigned* bar; unsigned x;
    volatile LAS unsigned* st;
};

__device__ __forceinline__ XcdBarrier xcd_barrier_post(unsigned* bar, volatile LAS unsigned* st) {
    XcdBarrier b; b.bar = bar; b.x = xb_xcc_id(); b.st = st;
    if (threadIdx.x == 0) (void)xb_add(&bar[XB_XCNT(b.x)], 1u);
    return b;
}
__device__ __forceinline__ void xcd_barrier_complete(unsigned* bar, unsigned x, unsigned& nloc, unsigned& nx) {
    const unsigned G = gridDim.x * gridDim.y * gridDim.z;
    unsigned sum, cnt, mine, sp = 0u;
    for (;;) {
        sum = 0u; cnt = 0u; mine = 0u;
#pragma unroll
        for (unsigned j = 0; j < 16; ++j) { const unsigned c = xb_ld(&bar[XB_XCNT(j)]); sum += c; cnt += (c > 0u) ? 1u : 0u; mine = (j == x) ? c : mine; }
        if (sum == G) break;
        __builtin_amdgcn_s_sleep(1);
        if ((++sp & 255u) == 0u) { if (xb_ld(&bar[XB_TMO])) break; if (sp > XB_SPIN_CAP) { atomicAdd(&bar[XB_TMO], 1u); break; } }
    }
    nloc = mine > 0u ? mine : 1u; nx = cnt > 0u ? cnt : 1u;
}

__device__ __forceinline__ void xcd_barrier(const XcdBarrier& b) {
    asm volatile("s_waitcnt vmcnt(0)" ::: "memory");
    __syncthreads();
    if (threadIdx.x == 0) {
        unsigned* bar = b.bar;
        __builtin_amdgcn_s_waitcnt(0);
        unsigned nloc = b.st[0], nx = b.st[1];
        if (nloc == 0u) { xcd_barrier_complete(bar, b.x, nloc, nx); b.st[0] = nloc; b.st[1] = nx; }
        const unsigned old = xb_add(&bar[XB_XSUB(b.x)], 1u);
        const unsigned gen = old / nloc;
        if (old + 1u == (gen + 1u) * nloc) {
            __builtin_amdgcn_fence(__ATOMIC_RELEASE, "agent");
            asm volatile("s_waitcnt vmcnt(0)" ::: "memory");
            const unsigned og = xb_add(&bar[XB_TOP], 1u);
            const unsigned tg = og / nx;
            if (og + 1u == (tg + 1u) * nx) xb_add(&bar[XB_TOPGEN], 1u);
            else XB_SPIN(xb_ld(&bar[XB_TOPGEN]) == tg, bar);
            __builtin_amdgcn_fence(__ATOMIC_ACQUIRE, "agent");
            xb_add(&bar[XB_XGEN(b.x)], 1u);
            asm volatile("s_waitcnt vmcnt(0)" ::: "memory");
        } else {
            XB_SPIN(xb_ld(&bar[XB_XGEN(b.x)]) == gen, bar);
            __builtin_amdgcn_fence(__ATOMIC_ACQUIRE, "agent");
            asm volatile("s_waitcnt vmcnt(0)" ::: "memory");
        }
    }
    __syncthreads();
}
constexpr int BATCH = 4, SEQ = 8192, DM = 2048, M = BATCH * SEQ, NH = 12, HD = 128, WA = 1536, DEPTH = 4;
constexpr int NIN = 16396, NPAD = 16640;
constexpr int C_QA = 0, C_KA = 1536, C_VA = 3072, C_ZA = 4608, C_QB = 6144, C_KB = 7680, C_VB = 9216, C_ZB = 10752, C_G = 12288, C_F = 16384;
constexpr float LN_EPS = 1e-5f, ALPHA = 1.6817928305074290f;
constexpr size_t MiB = 1u << 20;
constexpr size_t WS_XB = 0, WS_WIN = 128 * MiB, WS_WUA = 388 * MiB, WS_WUB = 412 * MiB, WS_WOUT = 436 * MiB, WS_H = 468 * MiB, WS_OA = 1508 * MiB,
                 WS_LSE = 1796 * MiB, WS_LOGF = 1802 * MiB, WS_CUM = 1804 * MiB, WS_COS = 1806 * MiB, WS_SIN = 1808 * MiB, WS_NRM = 1810 * MiB, WS_SC = 1811 * MiB, WS_BAR = 1812 * MiB, WS_PN2 = 1813 * MiB, WS_END = 1826 * MiB;
constexpr size_t SC_SX = 0, SC_SAA = 32768, SC_SAB = 65536, SC_SWIN = 98304, SC_SWUA = SC_SWIN + 4 * 16640, SC_SWUB = SC_SWUA + 4 * 2048, SC_CSIN = SC_SWUB + 4 * 2048, SC_SWOUT = SC_CSIN + 4 * 16640;
constexpr size_t WS_STATS = WS_BAR + 65536;
constexpr size_t WS_SM = WS_BAR + 393216;
constexpr size_t WS_MF = WS_OA + 96 * MiB;
constexpr size_t OA_STRIDE = (size_t)M * WA, LSE_STRIDE = (size_t)M * NH;
constexpr int LDS_BYTES = 147456, LDS_BARST_OFF = 139264;
constexpr int NPH = 2 + 7 * DEPTH;
typedef unsigned short bf16;
typedef float f32x4 __attribute__((ext_vector_type(4)));
typedef unsigned u32x4 __attribute__((ext_vector_type(4)));

__device__ __forceinline__ unsigned f2bf(float f) { unsigned u = __builtin_bit_cast(unsigned, f); return (u + 0x7fffu + ((u >> 16) & 1u)) >> 16; }
__device__ __forceinline__ unsigned pk2(float lo, float hi) { return f2bf(lo) | (f2bf(hi) << 16); }
__device__ __forceinline__ float bflo(unsigned w) { return __uint_as_float(w << 16); }
__device__ __forceinline__ float bfhi(unsigned w) { return __uint_as_float(w & 0xffff0000u); }
__device__ __forceinline__ float wave_sum(float v) {
#pragma unroll
    for (int o = 1; o < 64; o <<= 1) v += __shfl_xor(v, o);
    return v;
}
__device__ __forceinline__ int in_src_col(int n) {
    if (n < C_VA) { const int hb = n >> 7, p = n & 127; return hb * 128 + 4 * (p >> 3) + (p & 3) + 64 * ((p >> 2) & 1); }
    if (n < C_G) return n;
    if (n < C_F) return n + 12;
    if (n < C_F + 12) return n - C_F + 12288;
    return -1;
}
__device__ __forceinline__ unsigned q8(float v) { return (unsigned)__float2int_rn(v) & 0xffu; }
__device__ __forceinline__ unsigned pack4q(float a, float b, float c, float d) { return q8(a) | (q8(b) << 8) | (q8(c) << 16) | (q8(d) << 24); }
__device__ __forceinline__ float wave_max(float v) {
#pragma unroll
    for (int o = 1; o < 64; o <<= 1) v = fmaxf(v, __shfl_xor(v, o));
    return v;
}
__device__ __forceinline__ void quant_row(const f32x4 (&v)[8], unsigned char* qrow, float* scale, int lane) {
    float amax = 0.f;
#pragma unroll
    for (int j = 0; j < 8; ++j) amax = fmaxf(amax, fmaxf(fmaxf(fabsf(v[j][0]), fabsf(v[j][1])), fmaxf(fabsf(v[j][2]), fabsf(v[j][3]))));
    amax = wave_max(amax); const float inv = amax > 0.f ? 127.f / amax : 0.f;
#pragma unroll
    for (int j = 0; j < 8; ++j) *(unsigned*)(qrow + 4 * lane + 256 * j) = pack4q(v[j][0] * inv, v[j][1] * inv, v[j][2] * inv, v[j][3] * inv);
    if (lane == 0) *scale = amax > 0.f ? amax * (1.f / 127.f) : 1.f;
}

__device__ __forceinline__ float quant_row_q(const f32x4 (&v)[8], unsigned char* qrow, float* scale, int lane, unsigned (&q)[8]) {
    float amax = 0.f;
#pragma unroll
    for (int j = 0; j < 8; ++j) amax = fmaxf(amax, fmaxf(fmaxf(fabsf(v[j][0]), fabsf(v[j][1])), fmaxf(fabsf(v[j][2]), fabsf(v[j][3]))));
    amax = wave_max(amax); const float inv = amax > 0.f ? 127.f / amax : 0.f, sc = amax > 0.f ? amax * (1.f / 127.f) : 1.f;
#pragma unroll
    for (int j = 0; j < 8; ++j) { q[j] = pack4q(v[j][0] * inv, v[j][1] * inv, v[j][2] * inv, v[j][3] * inv); *(unsigned*)(qrow + 4 * lane + 256 * j) = q[j]; }
    if (lane == 0) *scale = sc;
    return sc;
}

template <bool MAP>
__device__ __forceinline__ void quant_tile(const float* W, int K, int N, const float* cs, unsigned char* WT, float* swout, unsigned* t, int item, int nblk, int lane) {
    const int kb = item / nblk, nb = item - kb * nblk, k0 = 64 * kb, nn = 64 * nb + lane, src = MAP ? in_src_col(nn) : nn;
    const float sc = src >= 0 ? cs[src] : 1.f, inv = src >= 0 ? 1.f / sc : 0.f;
    if (swout && kb == 0) swout[nn] = sc;
    const float* wp = W + (size_t)k0 * N + (src >= 0 ? src : 0);
#pragma unroll 4
    for (int s = 0; s < 16; ++s) { const float v0 = wp[(size_t)(4 * s) * N], v1 = wp[(size_t)(4 * s + 1) * N], v2 = wp[(size_t)(4 * s + 2) * N], v3 = wp[(size_t)(4 * s + 3) * N];
        t[lane * 17 + s] = pack4q(v0 * inv, v1 * inv, v2 * inv, v3 * inv); }
    asm volatile("s_waitcnt lgkmcnt(0)" ::: "memory");
#pragma unroll
    for (int j = 0; j < 4; ++j) { const int idx = lane + 64 * j, n = idx >> 2, c = idx & 3; const unsigned* s = t + n * 17 + 4 * c;
        u32x4 o; o.x = s[0]; o.y = s[1]; o.z = s[2]; o.w = s[3];
        *(u32x4*)(WT + (size_t)(64 * nb + n) * K + k0 + 16 * c) = o; }
    asm volatile("s_waitcnt lgkmcnt(0)" ::: "memory");
}

struct Args { const float* in[9]; float* out; unsigned char* ws; int ph_lo, ph_hi; };

__global__ void __launch_bounds__(512, 2) mega_fwd(Args args) {
    extern __shared__ __attribute__((aligned(16))) unsigned char lds[];
    cg::grid_group grid = cg::this_grid();
    const int G = gridDim.x, bx = blockIdx.x, NGW = G * 8;
    const int vcu = (G % 8 == 0) ? (bx % 8) * (G / 8) + bx / 8 : bx;
#define PH_IDS int tid = threadIdx.x; asm volatile("" : "+v"(tid)); const int lane = tid & 63, wave = __builtin_amdgcn_readfirstlane(tid >> 6), gw = bx * 8 + wave; (void)lane; (void)gw; PH_PTRS
#define PH_PTRS     unsigned long long wz_ = 0; asm volatile("" : "+s"(wz_)); unsigned char* ws = args.ws + wz_;     \
    const float* x_in = args.in[0]; const float* w_in = args.in[1]; const float* b_forget = args.in[2]; const float* b_gate = args.in[3]; \
    const float* w_up_a = args.in[4]; const float* w_up_b = args.in[5]; const float* w_out = args.in[6]; const float* ln_g = args.in[7]; const float* ln_b = args.in[8]; \
    float* out = args.out; \
    bf16* XB = (bf16*)(ws + WS_XB); bf16* WIN = (bf16*)(ws + WS_WIN); bf16* WUA = (bf16*)(ws + WS_WUA); bf16* WUB = (bf16*)(ws + WS_WUB); bf16* WOUT = (bf16*)(ws + WS_WOUT); \
    bf16* H = (bf16*)(ws + WS_H); bf16* OA = (bf16*)(ws + WS_OA); bf16* MF = (bf16*)(ws + WS_MF); \
    float* LSE = (float*)(ws + WS_LSE); float* LOGF = (float*)(ws + WS_LOGF); float* CUM = (float*)(ws + WS_CUM); float* COS = (float*)(ws + WS_COS); float* SIN = (float*)(ws + WS_SIN); float* NRM = (float*)(ws + WS_NRM); float* SC = (float*)(ws + WS_SC); \
    unsigned char* XQ = ws + WS_XB; unsigned char* WINQ = ws + WS_WIN; unsigned char* WUAQ = ws + WS_WUA; unsigned char* WUBQ = ws + WS_WUB; \
    (void)x_in; (void)w_in; (void)b_forget; (void)b_gate; (void)w_up_a; (void)w_up_b; (void)w_out; (void)ln_g; (void)ln_b; (void)out; (void)XB; (void)WIN; (void)WUA; (void)WUB; (void)WOUT; (void)H; (void)OA; (void)MF; (void)LSE; (void)LOGF; (void)CUM; (void)COS; (void)SIN; (void)NRM; (void)SC; (void)XQ; (void)WINQ; (void)WUAQ; (void)WUBQ
    const int lo = args.ph_lo, hi = args.ph_hi;
#define IN(k) (lo <= (k) && (k) < hi)
#ifndef XCDBAR
#define XCDBAR 1
#endif
    volatile LAS unsigned* bst = (volatile LAS unsigned*)((LAS unsigned char*)lds + LDS_BARST_OFF);
    if (threadIdx.x < 2) bst[threadIdx.x] = 0u;
    __syncthreads();
    XcdBarrier xbar = xcd_barrier_post((unsigned*)(args.ws + WS_BAR), bst);
#define SEAM(k) do { if ((k) + 1 < hi) { if (!XCDBAR || (k) == 0) grid.sync(); else xcd_barrier(xbar); } } while (0)

    if (IN(0)) { PH_IDS;
        {   float* red = (float*)lds; constexpr int CG_IN = (NIN + 255) / 256, CG_UP = DM / 256, CG_L = CG_IN + 3 * CG_UP;
            for (int it = bx; it < DEPTH * CG_L; it += G) {
                const int l = it / CG_L; int r = it - l * CG_L; const float* W; int K, N; float* cs;
                if (r < CG_IN) { W = w_in + (size_t)l * DM * NIN; K = DM; N = NIN; cs = SC + SC_CSIN + l * NPAD; }
                else if (r < CG_IN + CG_UP) { r -= CG_IN; W = w_up_a + (size_t)l * WA * DM; K = WA; N = DM; cs = SC + SC_SWUA + l * DM; }
                else if (r < CG_IN + 2 * CG_UP) { r -= CG_IN + CG_UP; W = w_up_b + (size_t)l * WA * DM; K = WA; N = DM; cs = SC + SC_SWUB + l * DM; }
                else { r -= CG_IN + 2 * CG_UP; W = w_out + (size_t)l * DM * DM; K = DM; N = DM; cs = SC + SC_SWOUT + l * DM; }
                const int col = 256 * r + 4 * lane; f32x4 mx = {0.f, 0.f, 0.f, 0.f};
                if (col < N) { const float* wp = W + col;
#pragma unroll 8
                    for (int k = wave; k < K; k += 8) { const f32x4 v = *(const f32x4*)(wp + (size_t)k * N);
                        mx[0] = fmaxf(mx[0], fabsf(v[0])); mx[1] = fmaxf(mx[1], fabsf(v[1])); mx[2] = fmaxf(mx[2], fabsf(v[2])); mx[3] = fmaxf(mx[3], fabsf(v[3])); } }
                *(f32x4*)(red + wave * 256 + 4 * lane) = mx;
                __syncthreads();
                if (tid < 256 && 256 * r + tid < N) { float m = 0.f; for (int w = 0; w < 8; ++w) m = fmaxf(m, red[w * 256 + tid]); cs[256 * r + tid] = m > 0.f ? m * (1.f / 127.f) : 1.f; }
                __syncthreads();
            }
        }
        for (int idx = bx * 512 + tid; idx < SEQ * 64; idx += G * 512) {
            const int pos = idx >> 6, i = idx & 63;
            const float inv_freq = exp2f(-(float)i * (1.f / 64.f) * 13.287712379549449f);
            const float ang = (float)pos * inv_freq;
            const double rev = (double)ang * 0.15915494309189535; const float fr = (float)(rev - floor(rev));
            COS[idx] = __builtin_amdgcn_cosf(fr); SIN[idx] = __builtin_amdgcn_sinf(fr);
        }
        for (int m = gw; m < M; m += NGW) { f32x4 v[8];
#pragma unroll
            for (int j = 0; j < 8; ++j) v[j] = *(const f32x4*)(x_in + (size_t)m * DM + 4 * lane + 256 * j);
            quant_row(v, XQ + (size_t)m * DM, SC + SC_SX + m, lane); }
        SEAM(0);
    }
    if (IN(1)) { PH_IDS;
        unsigned* t = (unsigned*)(lds + wave * 16384);
        constexpr int T_IN = (DM / 64) * (NPAD / 64), T_UP = (WA / 64) * (DM / 64), T_OUT = (DM / 64) * (DM / 64), T_L = T_IN + 2 * T_UP + T_OUT;
        for (int it = gw; it < DEPTH * T_L; it += NGW) {
            const int l = it / T_L; int r = it - l * T_L;
            if (r < T_IN) { quant_tile<true>(w_in + (size_t)l * DM * NIN, DM, NIN, SC + SC_CSIN + l * NPAD, WINQ + (size_t)l * NPAD * DM, SC + SC_SWIN + l * NPAD, t, r, NPAD / 64, lane); continue; } r -= T_IN;
            if (r < T_UP) { quant_tile<false>(w_up_a + (size_t)l * WA * DM, WA, DM, SC + SC_SWUA + l * DM, WUAQ + (size_t)l * DM * WA, nullptr, t, r, DM / 64, lane); continue; } r -= T_UP;
            if (r < T_UP) { quant_tile<false>(w_up_b + (size_t)l * WA * DM, WA, DM, SC + SC_SWUB + l * DM, WUBQ + (size_t)l * DM * WA, nullptr, t, r, DM / 64, lane); continue; } r -= T_UP;
            quant_tile<false>(w_out + (size_t)l * DM * DM, DM, DM, SC + SC_SWOUT + l * DM, ws + WS_WOUT + (size_t)l * DM * DM, nullptr, t, r, DM / 64, lane);
        }
        SEAM(1);
    }

    for (int l = 0; l < DEPTH; ++l) {
        const int pb = 2 + 7 * l;
        if (IN(pb + 0)) { PH_IDS;
            if (bx == 0 && tid < 96) NRM[tid] = 0.f;
            const int NP1 = l == 0 ? NPAD : C_F;
            pg8::Gemm g{(const bf16*)XQ, (const bf16*)(WINQ + (size_t)l * NPAD * DM), M, NP1, DM / 2, DM / 2};   pg8::StaticOrder S; S.init(M, NP1, G, bx);
            pg8::EpiIn E{H, NPAD, COS, SIN, LOGF, b_forget + l * NH, SC + SC_SX, SC + SC_SWIN + l * NPAD, (float*)(ws + WS_PN2)};
            pg8::gemm_phase<pg8::EpiIn, pg8::StaticOrder, true, true, true>((PG8_LAS unsigned char*)lds, g, S, E);
            SEAM(pb + 0);
        }
        if (IN(pb + 1)) { PH_IDS;
            {
                float* red = (float*)lds;
                for (int b = 0; b < BATCH; ++b) {
                    float mx = 0.f;
                    for (int s = gw; s < SEQ; s += NGW) { if (lane < 24) { const f32x4 p = *(const f32x4*)((const float*)(ws + WS_PN2) + (((size_t)b * SEQ + s) * 24 + lane) * 4); mx = fmaxf(mx, (p[0] + p[1]) + (p[2] + p[3])); } }
                    if (lane < 24) red[wave * 24 + lane] = mx;
                    __syncthreads();
                    if (tid < 24) { float v = 0.f; for (int w = 0; w < 8; ++w) v = fmaxf(v, red[w * 24 + tid]); atomicMax((unsigned*)NRM + (tid < 12 ? 0 : 48) + b * NH + (tid % 12), __float_as_uint(v)); }
                    __syncthreads();
                }
            }
            if (bx < BATCH * NH) {
                const int b = bx / NH, h = bx - b * NH; float* red = (float*)lds;
                float v[16]; float run = 0.f;
#pragma unroll
                for (int j = 0; j < 16; j += 4) { const f32x4 lf = *(const f32x4*)(LOGF + (size_t)bx * SEQ + 16 * tid + j);
                    run += lf[0]; v[j] = run; run += lf[1]; v[j + 1] = run; run += lf[2]; v[j + 2] = run; run += lf[3]; v[j + 3] = run; }
                float inc = run;
#pragma unroll
                for (int o = 1; o < 64; o <<= 1) { const float t = __shfl_up(inc, o); if (lane >= o) inc += t; }
                if (lane == 63) red[wave] = inc;
                __syncthreads();
                float off = inc - run;
                for (int w = 0; w < wave; ++w) off += red[w];
                float* cp = CUM + (size_t)bx * SEQ + 16 * tid;
#pragma unroll
                for (int j = 0; j < 16; j += 4) *(f32x4*)(cp + j) = (f32x4){v[j] + off, v[j + 1] + off, v[j + 2] + off, v[j + 3] + off};
                __syncthreads();
            }
            constexpr int NIT = 3 * 1536;
            const int cnt = vcu < NIT ? (NIT - vcu + G - 1) / G : 0;
#define DIL_REF(R, n) do { const int L_ = vcu + (n) * G;   \
            const int bh_ = L_ / 96, rb_ = L_ - bh_ * 96, b_ = bh_ / NH, h_ = bh_ - b_ * NH, g_ = rb_ >> 5, r_ = rb_ & 31, dsh = 2 * g_, d_ = 1 << dsh; \
            const int qb = r_ & ((32 >> dsh) - 1), res = r_ >> (5 - dsh); \
            const size_t tok0 = (size_t)b_ * SEQ + res, rq = (size_t)qb * 256 * d_; \
            R.Q = H + (tok0 + rq) * NPAD + C_QA + h_ * HD; R.K = H + tok0 * NPAD + C_KA + h_ * HD; R.V = H + tok0 * NPAD + C_VA + h_ * HD; \
            R.O = OA + (size_t)g_ * OA_STRIDE + (tok0 + rq) * WA + h_ * HD; R.LSE = LSE + (size_t)g_ * LSE_STRIDE + (tok0 + rq) * NH + h_; R.CUM = nullptr; \
            R.P0 = qb * 256; R.pq = d_ * NPAD; R.po = d_ * WA; R.pl = d_ * NH; R.skv = SEQ >> dsh; R.thr = 0.f; } while (0)
            if (cnt > 0) {
                at::BlkRef cur, nxt; at::Seam S{};     DIL_REF(cur, 0);
                at::attn_prime<false>(cur, 129, (char*)lds, S);
                for (int n = 0; n < cnt; ++n) {
                    if (n + 1 < cnt) DIL_REF(nxt, n + 1); else nxt = cur;
                    at::attn_block<false, true, 129>(cur, nxt, (char*)lds, S);
                    cur = nxt;
                }
            }
#undef DIL_REF
            SEAM(pb + 1);
        }
        if (IN(pb + 2)) { PH_IDS;
            constexpr int NIT = BATCH * NH * 32;
            const int cnt = vcu < NIT ? (NIT - vcu + G - 1) / G : 0;
#define FOX_REF(R, n) do { const int L_ = vcu + (n) * G; const int bh = L_ >> 5, qb = (L_ + ((G & 31) == 0 ? 5 * (n) : 0)) & 31  , b_ = bh / NH, h_ = bh - b_ * NH; \
            R.Q = H + ((size_t)b_ * SEQ + (size_t)qb * 256) * NPAD + C_QB + h_ * HD; R.K = H + (size_t)b_ * SEQ * NPAD + C_KB + h_ * HD; R.V = H + (size_t)b_ * SEQ * NPAD + C_VB + h_ * HD; \
            R.O = (bf16*)R.Q; R.LSE = nullptr; R.CUM = CUM + (size_t)bh * SEQ; R.P0 = qb * 256; R.pq = NPAD; R.po = NPAD; R.pl = 0; R.skv = SEQ; R.thr = 30.f + 2.f * 1.02f * sqrtf(NRM[bh] * NRM[48 + bh]) * 0.08838834764831845f;     } while (0)
            if (cnt > 0) {
                at::BlkRef cur, nxt; at::Seam S{};     FOX_REF(cur, 0);
                at::attn_prime<true>(cur, SEQ, (char*)lds, S);
                for (int n = 0; n < cnt; ++n) {
                    if (n + 1 < cnt) FOX_REF(nxt, n + 1); else nxt = cur;
                    at::attn_block<true, false, SEQ>(cur, nxt, (char*)lds, S);
                    cur = nxt;
                }
            }
#undef FOX_REF
            SEAM(pb + 2);
        }

        if (IN(pb + 3)) { PH_IDS;
            for (int m = gw; m < M; m += NGW) {
                bf16* hr = H + (size_t)m * NPAD; float va[3][8], vb[3][8]; float ama = 0.f, amb = 0.f;
                u32x4 A0[3], A1[3], A2[3], ZA[3], OB[3], ZB[3]; float L0[3], L1[3], L2[3];
#pragma unroll
                for (int j = 0; j < 3; ++j) {
                    const int col = 8 * (lane + 64 * j), hh = col >> 7; const bf16* oa = OA + (size_t)m * WA + col;
                    A0[j] = *(const u32x4*)oa; A1[j] = *(const u32x4*)(oa + OA_STRIDE); A2[j] = *(const u32x4*)(oa + 2 * OA_STRIDE); ZA[j] = *(const u32x4*)(hr + C_ZA + col);
                    OB[j] = *(const u32x4*)(hr + C_QB + col); ZB[j] = *(const u32x4*)(hr + C_ZB + col);
                    L0[j] = LSE[(size_t)m * NH + hh]; L1[j] = LSE[LSE_STRIDE + (size_t)m * NH + hh]; L2[j] = LSE[2 * LSE_STRIDE + (size_t)m * NH + hh]; }
                asm volatile("" ::: "memory");
#pragma unroll
                for (int j = 0; j < 3; ++j) {
                    const float l0 = L0[j], l1 = L1[j], l2 = L2[j];
                    const float mx = fmaxf(l0, fmaxf(l1, l2)); float e0 = __expf(l0 - mx), e1 = __expf(l1 - mx), e2 = __expf(l2 - mx);
                    const float inv = __builtin_amdgcn_rcpf(e0 + e1 + e2); e0 *= inv; e1 *= inv; e2 *= inv;
                    const u32x4 a0 = A0[j], a1 = A1[j], a2 = A2[j], za = ZA[j], ob = OB[j], zb = ZB[j];
#pragma unroll
                    for (int k = 0; k < 4; ++k) { const float zl = bflo(za[k]), zh = bfhi(za[k]), yl = bflo(zb[k]), yh = bfhi(zb[k]);
                        va[j][2 * k] = (e0 * bflo(a0[k]) + e1 * bflo(a1[k]) + e2 * bflo(a2[k])) * zl * __builtin_amdgcn_rcpf(1.f + __expf(-zl));
                        va[j][2 * k + 1] = (e0 * bfhi(a0[k]) + e1 * bfhi(a1[k]) + e2 * bfhi(a2[k])) * zh * __builtin_amdgcn_rcpf(1.f + __expf(-zh));
                        vb[j][2 * k] = bflo(ob[k]) * yl * __builtin_amdgcn_rcpf(1.f + __expf(-yl)); vb[j][2 * k + 1] = bfhi(ob[k]) * yh * __builtin_amdgcn_rcpf(1.f + __expf(-yh));
                        ama = fmaxf(ama, fmaxf(fabsf(va[j][2 * k]), fabsf(va[j][2 * k + 1]))); amb = fmaxf(amb, fmaxf(fabsf(vb[j][2 * k]), fabsf(vb[j][2 * k + 1]))); }
                }
                ama = wave_max(ama); amb = wave_max(amb);
                const float ia = ama > 0.f ? 127.f / ama : 0.f, ib = amb > 0.f ? 127.f / amb : 0.f;
                unsigned char* qa = (unsigned char*)OA + (size_t)m * (2 * WA); unsigned char* qb = (unsigned char*)(hr + C_QB);
#pragma unroll
                for (int j = 0; j < 3; ++j) { const int col = 8 * (lane + 64 * j);
                    unsigned long long pa = (unsigned long long)pack4q(va[j][0] * ia, va[j][1] * ia, va[j][2] * ia, va[j][3] * ia) | ((unsigned long long)pack4q(va[j][4] * ia, va[j][5] * ia, va[j][6] * ia, va[j][7] * ia) << 32);
                    unsigned long long pb = (unsigned long long)pack4q(vb[j][0] * ib, vb[j][1] * ib, vb[j][2] * ib, vb[j][3] * ib) | ((unsigned long long)pack4q(vb[j][4] * ib, vb[j][5] * ib, vb[j][6] * ib, vb[j][7] * ib) << 32);
                    *(unsigned long long*)(qa + col) = pa; *(unsigned long long*)(qb + col) = pb; }
                if (lane == 0) { SC[SC_SAA + m] = ama > 0.f ? ama * (1.f / 127.f) : 1.f; SC[SC_SAB + m] = amb > 0.f ? amb * (1.f / 127.f) : 1.f; }
            }
            SEAM(pb + 3);
        }

        if (IN(pb + 4)) { PH_IDS;
            { pg8::Gemm g{OA, (const bf16*)(WUAQ + (size_t)l * DM * WA), M, DM, WA / 2, WA}; pg8::StaticOrder S; S.init(M, DM, G, bx);
              pg8::EpiGate<false> E{H + C_G, NPAD, b_gate + (size_t)l * 2 * DM, nullptr, MF, DM, SC + SC_SAA, SC + SC_SWUA + l * DM};
              pg8::gemm_phase<pg8::EpiGate<false>, pg8::StaticOrder, true, true, true>((PG8_LAS unsigned char*)lds, g, S, E); }
            { pg8::Gemm g{H + C_QB, (const bf16*)(WUBQ + (size_t)l * DM * WA), M, DM, WA / 2, NPAD}; pg8::StaticOrder S; S.init(M, DM, G, bx);
              pg8::EpiGate<true> E{H + C_G + DM, NPAD, b_gate + (size_t)l * 2 * DM + DM, MF, XB, DM, SC + SC_SAB, SC + SC_SWUB + l * DM};
              pg8::gemm_phase<pg8::EpiGate<true>, pg8::StaticOrder, true, true, true>((PG8_LAS unsigned char*)lds, g, S, E); }
            SEAM(pb + 4);
        }
        if (IN(pb + 5)) { PH_IDS;
            {
                unsigned char* MQ = ws + WS_MF; float* SM = (float*)(ws + WS_SM);
                for (int m = gw; m < M; m += NGW) { u32x4 r4[4]; float amax = 0.f;
#pragma unroll
                    for (int j = 0; j < 4; ++j) { r4[j] = *(const u32x4*)(XB + (size_t)m * DM + 8 * (lane + 64 * j));
#pragma unroll
                        for (int k = 0; k < 4; ++k) amax = fmaxf(amax, fmaxf(fabsf(bflo(r4[j][k])), fabsf(bfhi(r4[j][k])))); }
                    amax = wave_max(amax); const float inv = amax > 0.f ? 127.f / amax : 0.f;
#pragma unroll
                    for (int j = 0; j < 4; ++j) { const unsigned long long p = (unsigned long long)pack4q(bflo(r4[j][0]) * inv, bfhi(r4[j][0]) * inv, bflo(r4[j][1]) * inv, bfhi(r4[j][1]) * inv) |
                            ((unsigned long long)pack4q(bflo(r4[j][2]) * inv, bfhi(r4[j][2]) * inv, bflo(r4[j][3]) * inv, bfhi(r4[j][3]) * inv) << 32);
                        *(unsigned long long*)(MQ + (size_t)m * DM + 8 * (lane + 64 * j)) = p; }
                    if (lane == 0) SM[m] = amax > 0.f ? amax * (1.f / 127.f) : 1.f; }
                if (hi - lo > 1) xcd_barrier(xbar);
            }
            pg8::Gemm g{(const bf16*)(ws + WS_MF), (const bf16*)(ws + WS_WOUT + (size_t)l * DM * DM), M, DM, DM / 2, DM / 2}; pg8::StaticOrder S; S.init(M, DM, G, bx);
            pg8::EpiOut E{l == 0 ? x_in : out, out, DM, ALPHA, l == 0 ? nullptr : (const float*)(ws + WS_STATS), ln_g + (size_t)(l > 0 ? l - 1 : 0) * DM, ln_b + (size_t)(l > 0 ? l - 1 : 0) * DM, (const float*)(ws + WS_SM), SC + SC_SWOUT + l * DM};
            pg8::gemm_phase<pg8::EpiOut, pg8::StaticOrder, true, true, true>((PG8_LAS unsigned char*)lds, g, S, E);
            SEAM(pb + 5);
        }

        if (IN(pb + 6)) { PH_IDS;
            const float* gg = ln_g + (size_t)l * DM; const float* bb = ln_b + (size_t)l * DM;
            const int ln_ = l + 1 < DEPTH ? l + 1 : l; float swf = 1.f, bff = 0.f;
            { const unsigned char* wf = WINQ + (size_t)ln_ * NPAD * DM + (size_t)C_F * DM; (void)wf;
              if (lane < 12) { swf = SC[SC_SWIN + (size_t)ln_ * NPAD + C_F + lane]; bff = b_forget[ln_ * NH + lane]; } }
            for (int m = gw; m < M; m += NGW) {
                float* row = out + (size_t)m * DM; f32x4 v[8]; float s = 0.f;
#pragma unroll
                for (int j = 0; j < 8; ++j) { v[j] = *(const f32x4*)(row + 4 * lane + 256 * j); s += (v[j][0] + v[j][1]) + (v[j][2] + v[j][3]); }
                const float mean = wave_sum(s) * (1.f / DM); float s2 = 0.f;
#pragma unroll
                for (int j = 0; j < 8; ++j) { v[j] = v[j] - mean; s2 += (v[j][0] * v[j][0] + v[j][1] * v[j][1]) + (v[j][2] * v[j][2] + v[j][3] * v[j][3]); }
                const float rstd = 1.f / sqrtf(wave_sum(s2) * (1.f / DM) + LN_EPS);
                const bool lastl = l == DEPTH - 1;
#pragma unroll
                for (int j = 0; j < 8; ++j) { const int c = 4 * lane + 256 * j; const f32x4 gv = *(const f32x4*)(gg + c), bv = *(const f32x4*)(bb + c);
                    v[j] = v[j] * rstd * gv + bv; if (lastl) *(f32x4*)(row + c) = v[j]; }
                if (!lastl) { if (lane == 0) { float* st = (float*)(ws + WS_STATS) + 2 * (size_t)m; st[0] = mean; st[1] = rstd; }
                    unsigned q[8]; const float sxr = quant_row_q(v, XQ + (size_t)m * DM, SC + SC_SX + m, lane, q);
                    float zsel = 0.f;
#define lsig_(z_) ([](float z) { return fminf(z, 0.f) - __logf(1.f + __expf(-fabsf(z))); }(z_))
#pragma unroll
                    for (int h = 0; h < 12; ++h) { int a = 0; const unsigned char* wfh = WINQ + (size_t)ln_ * NPAD * DM + (size_t)(C_F + h) * DM + 4 * lane;
#pragma unroll
                        for (int j = 0; j < 8; ++j) a = __builtin_amdgcn_sdot4((int)q[j], *(const int*)(wfh + 256 * j), a, false);
#pragma unroll
                        for (int o = 1; o < 64; o <<= 1) a += __shfl_xor(a, o);
                        if (lane == h) zsel = (float)a; }
                    if (lane < 12) LOGF[((size_t)(m >> 13) * NH + lane) * SEQ + (m & 8191)] = lsig_(zsel * sxr * swf + bff); }
            }
            SEAM(pb + 6);
        }
    }
#undef IN
#undef SEAM
}

extern "C" void kernel_launch(void* const* d_in, const int* in_sizes, int n_in, void* d_out, int out_size, void* d_ws, size_t ws_size, hipStream_t stream) {
    static int grid = 0;
    if (grid == 0) {
        if (n_in != 9 || in_sizes[0] != M * DM || out_size != M * DM || ws_size < WS_END) { fprintf(stderr, "kernel_launch: unexpected shapes / workspace (n_in %d, ws %zu)\n", n_in, ws_size); grid = -1; return; }
        int dev = 0, cus = 0, per_cu = 0;
        (void)hipGetDevice(&dev); (void)hipDeviceGetAttribute(&cus, hipDeviceAttributeMultiprocessorCount, dev);
        if (hipFuncSetAttribute((const void*)mega_fwd, hipFuncAttributeMaxDynamicSharedMemorySize, LDS_BYTES) != hipSuccess) { fprintf(stderr, "kernel_launch: hipFuncSetAttribute failed\n"); grid = -1; return; }
        if (hipOccupancyMaxActiveBlocksPerMultiprocessor(&per_cu, (const void*)mega_fwd, 512, LDS_BYTES) != hipSuccess || per_cu < 1) { fprintf(stderr, "kernel_launch: occupancy query says %d\n", per_cu); per_cu = 1; }
        (void)hipGetLastError();
        if (cus <= 0) cus = 256;
        grid = cus * per_cu;
    }
    if (grid < 0) return;
    if (hipMemsetAsync((char*)d_ws + WS_BAR, 0, XCD_BAR_WORDS * 4, stream) != hipSuccess) { fprintf(stderr, "kernel_launch: hipMemsetAsync of the barrier words failed\n"); return; }
    Args a{};
    for (int i = 0; i < 9; ++i) a.in[i] = (const float*)d_in[i];
    a.out = (float*)d_out; a.ws = (unsigned char*)d_ws;
    a.ph_lo = 0; a.ph_hi = NPH;
    void* kargs[] = {&a};
    hipError_t e = hipLaunchCooperativeKernel((const void*)mega_fwd, dim3(grid), dim3(512), kargs, LDS_BYTES, stream);
    if (e != hipSuccess) fprintf(stderr, "kernel_launch: cooperative launch failed: %s (grid %d)\n", hipGetErrorString(e), grid);
}
```

```cpp
#include <hip/hip_runtime.h>
#include <hip/hip_cooperative_groups.h>
#include <cstdio>
#include <cstdint>
namespace cg = cooperative_groups;
namespace pg8 {
#define PG8_LAS __attribute__((address_space(3)))
typedef unsigned short bf16_t;
typedef short bf16x8 __attribute__((ext_vector_type(8)));
typedef float f32x4 __attribute__((ext_vector_type(4)));
typedef unsigned u32x4 __attribute__((ext_vector_type(4)));
constexpr int BM = 256, BK = 64, HALF = 128, HTB = HALF * BK * 2  , STAGE_BYTES = 8 * HTB, NXCD = 8, WGM = 4;

__host__ __device__ __forceinline__ int lds_byte(int r, int c) { const int st = (r >> 4) * 2 + (c >> 5), rr = r & 15, cc = c & 31, ob = rr * 64 + cc * 2; return st * 1024 + (ob ^ (((ob >> 9) & 1) << 5)); }
__host__ __device__ __forceinline__ void stage_rc(int b, int& R, int& C) { const int st = b / 1024, sb = b % 1024, swz = sb ^ (((sb >> 9) & 1) << 5); R = (st >> 1) * 16 + swz / 64; C = (st & 1) * 32 + (swz % 64) / 2; }
__host__ __device__ __forceinline__ int perm32(int rho) { const int n = rho >> 4, i = rho & 15; return 8 * (i >> 2) + 4 * n + (i & 3); }

struct Unit { int pm, pn; };
struct Gemm { const bf16_t* A; const bf16_t* Bt; int M, N, K, lda; };

struct StaticOrder {
    int nM, nN, nwg, G, c;
    __host__ __device__ void init(int M, int N, int G_, int c_) { nM = M / BM; nN = N / BM; nwg = nM * nN; G = G_; c = c_; }
    __host__ __device__ bool next(int i, Unit& u) const {
        const long L = (long)i * G + c; if (L >= nwg) return false;
        int wgid = (int)L; { const int q = nwg / NXCD, r = nwg % NXCD, xcd = wgid % NXCD, off = wgid / NXCD; wgid = (xcd < r ? xcd * (q + 1) : r * (q + 1) + (xcd - r) * q) + off; }
        const int nig = WGM * nN, gid = wgid / nig, fm = gid * WGM, gsz = (nM - fm) < WGM ? (nM - fm) : WGM;
        u.pm = fm + ((wgid % nig) % gsz); u.pn = (wgid % nig) / gsz; return true;
    }
    __device__ __forceinline__ void a_ready(const Unit&) const {}
    __device__ __forceinline__ void done(const Unit&) const {}
};

__device__ __forceinline__ unsigned cvt_pk_bf16(float lo, float hi) { unsigned r; asm volatile("v_cvt_pk_bf16_f32 %0, %1, %2" : "=v"(r) : "v"(lo), "v"(hi)); return r; }
typedef float f32x2 __attribute__((ext_vector_type(2)));
typedef unsigned u32x2 __attribute__((ext_vector_type(2)));
typedef int i32x4 __attribute__((ext_vector_type(4)));
template <bool I8> struct AccSel { typedef f32x4 type; };
template <> struct AccSel<true> { typedef i32x4 type; };
__device__ __forceinline__ f32x4 cvt4(i32x4 a, float s) { return (f32x4){(float)a[0] * s, (float)a[1] * s, (float)a[2] * s, (float)a[3] * s}; }
__device__ __forceinline__ float bf_lo(unsigned w) { return __uint_as_float(w << 16); }
__device__ __forceinline__ float bf_hi(unsigned w) { return __uint_as_float(w & 0xffff0000u); }
__device__ __forceinline__ float sigm(float z) { return __builtin_amdgcn_rcpf(1.f + __builtin_amdgcn_exp2f(-1.4426950408889634f * z)); }
__device__ __forceinline__ float logsig(float z) { return fminf(z, 0.f) - log1pf(expf(-fabsf(z))); }

struct EpiIn {
    static constexpr bool PERM = true, AFTER_DRAIN = false;
    bf16_t* H; int ldh; const float* cosT; const float* sinT; float* logf; const float* bfg; const float* sx; const float* sw; float* pn2;
    __device__ __forceinline__ void operator()(const i32x4 (&acc)[2][2][4][2], const Unit& u, int wr, int wc, int fr, int fq) const {
        asm volatile("" : "+v"(fr), "+v"(fq));
        const int row0 = u.pm * BM + wr * 64 + fr;
        if (u.pn == 64) {
            if (wc == 0 && fq < 2) {
                const f32x4 b0 = *(const f32x4*)(bfg + 8 * fq); const f32x4 b1 = fq == 0 ? *(const f32x4*)(bfg + 4) : (f32x4){0.f, 0.f, 0.f, 0.f};
                const f32x4 w0 = *(const f32x4*)(sw + u.pn * BM + 8 * fq), w1 = *(const f32x4*)(sw + u.pn * BM + 8 * fq + 4);
#pragma unroll
                for (int ai = 0; ai < 2; ++ai)
#pragma unroll
                    for (int m = 0; m < 4; ++m) { const int row = row0 + ai * HALF + m * 16; const float sr = sx[row];
                        float* o = logf + ((size_t)(row >> 13) * 12 + 8 * fq) * 8192 + (row & 8191);
                        const f32x4 v0 = cvt4(acc[ai][0][m][0], sr) * w0 + b0; o[0] = logsig(v0[0]); o[8192] = logsig(v0[1]); o[2 * 8192] = logsig(v0[2]); o[3 * 8192] = logsig(v0[3]);
                        if (fq == 0) { const f32x4 v1 = cvt4(acc[ai][0][m][1], sr) * w1 + b1; o[4 * 8192] = logsig(v1[0]); o[5 * 8192] = logsig(v1[1]); o[6 * 8192] = logsig(v1[2]); o[7 * 8192] = logsig(v1[3]); } }
            }
            return;
        }
        const bool rope = u.pn < 12, nrm = u.pn >= 24 && u.pn < 36;
        const int i0 = 16 * wc + 4 * fq;
#pragma unroll
        for (int bj = 0; bj < 2; ++bj) { const int col0 = u.pn * BM + bj * HALF + wc * 32 + 8 * fq;
            const f32x4 w0 = *(const f32x4*)(sw + col0), w1 = *(const f32x4*)(sw + col0 + 4);
#pragma unroll
            for (int ai = 0; ai < 2; ++ai)
#pragma unroll
                for (int m = 0; m < 4; ++m) { const int row = row0 + ai * HALF + m * 16; const float sr = sx[row];
                    f32x4 v0 = cvt4(acc[ai][bj][m][0], sr) * w0, v1 = cvt4(acc[ai][bj][m][1], sr) * w1;
                    if (rope) { const int pos = row & 8191; const f32x4 c = *(const f32x4*)(cosT + pos * 64 + i0), s = *(const f32x4*)(sinT + pos * 64 + i0);
                        const f32x4 o0 = v0 * c - v1 * s, o1 = v0 * s + v1 * c; v0 = o0; v1 = o1; }
                    if (nrm) { float s2 = (v0[0] * v0[0] + v0[1] * v0[1]) + (v0[2] * v0[2] + v0[3] * v0[3]) + (v1[0] * v1[0] + v1[1] * v1[1]) + (v1[2] * v1[2] + v1[3] * v1[3]);
                        s2 += __shfl_xor(s2, 16); s2 += __shfl_xor(s2, 32);
                        if (fq == 0) pn2[((size_t)row * 24 + (u.pn - 24) * 2 + bj) * 4 + wc] = s2; }
                    u32x4 w; w.x = cvt_pk_bf16(v0[0], v0[1]); w.y = cvt_pk_bf16(v0[2], v0[3]); w.z = cvt_pk_bf16(v1[0], v1[1]); w.w = cvt_pk_bf16(v1[2], v1[3]);
                    *(u32x4*)(H + (size_t)row * ldh + col0) = w; } }
    }
};
template <bool ADD> struct EpiGate {
    static constexpr bool PERM = true, AFTER_DRAIN = false; static constexpr int NB = 2;
    const bf16_t* Hg; int ldh; const float* bg; const bf16_t* Mf; bf16_t* O; int ldo; const float* sa; const float* sb;
    __device__ __forceinline__ void operator()(const i32x4 (&acc)[2][2][4][2], const Unit& u, int wr, int wc, int fr, int fq) const {
        asm volatile("" : "+v"(fr), "+v"(fq));
        const int row0 = u.pm * BM + wr * 64 + fr;
#pragma unroll
        for (int bj = 0; bj < 2; ++bj) { const int col0 = u.pn * BM + bj * HALF + wc * 32 + 8 * fq;
            const f32x4 g0 = *(const f32x4*)(bg + col0), g1 = *(const f32x4*)(bg + col0 + 4), w0 = *(const f32x4*)(sb + col0), w1 = *(const f32x4*)(sb + col0 + 4);
#pragma unroll
            for (int ai = 0; ai < 2; ++ai)
#pragma unroll
              for (int mb = 0; mb < 4; mb += NB) {
                u32x4 gl[NB], pm[NB]; float sr[NB];
#pragma unroll
                for (int q = 0; q < NB; ++q) { const int row = row0 + ai * HALF + (mb + q) * 16;
                    gl[q] = *(const u32x4*)(Hg + (size_t)row * ldh + col0); if (ADD) pm[q] = *(const u32x4*)(Mf + (size_t)row * ldo + col0); sr[q] = sa[row]; }
                asm volatile("" ::: "memory");
#pragma unroll
                for (int q = 0; q < NB; ++q) { const int m = mb + q; const int row = row0 + ai * HALF + m * 16;
                    f32x4 v0 = cvt4(acc[ai][bj][m][0], sr[q]) * w0, v1 = cvt4(acc[ai][bj][m][1], sr[q]) * w1;
                    v0[0] *= sigm(bf_lo(gl[q].x) + g0[0]); v0[1] *= sigm(bf_hi(gl[q].x) + g0[1]); v0[2] *= sigm(bf_lo(gl[q].y) + g0[2]); v0[3] *= sigm(bf_hi(gl[q].y) + g0[3]);
                    v1[0] *= sigm(bf_lo(gl[q].z) + g1[0]); v1[1] *= sigm(bf_hi(gl[q].z) + g1[1]); v1[2] *= sigm(bf_lo(gl[q].w) + g1[2]); v1[3] *= sigm(bf_hi(gl[q].w) + g1[3]);
                    if (ADD) { v0[0] += bf_lo(pm[q].x); v0[1] += bf_hi(pm[q].x); v0[2] += bf_lo(pm[q].y); v0[3] += bf_hi(pm[q].y); v1[0] += bf_lo(pm[q].z); v1[1] += bf_hi(pm[q].z); v1[2] += bf_lo(pm[q].w); v1[3] += bf_hi(pm[q].w); }
                    u32x4 w; w.x = cvt_pk_bf16(v0[0], v0[1]); w.y = cvt_pk_bf16(v0[2], v0[3]); w.z = cvt_pk_bf16(v1[0], v1[1]); w.w = cvt_pk_bf16(v1[2], v1[3]);
                    *(u32x4*)(O + (size_t)row * ldo + col0) = w; }
                asm volatile("" ::: "memory"); } }
    }
};
struct EpiOut {
    static constexpr bool PERM = false, AFTER_DRAIN = false;
    const float* X; float* T; int ldc; float alpha; const float* stats; const float* lg; const float* lb; const float* sa; const float* sb;
    __device__ __forceinline__ void operator()(const i32x4 (&acc)[2][2][4][2], const Unit& u, int wr, int wc, int fr, int fq) const {
        asm volatile("" : "+v"(fr), "+v"(fq));
        const int row0 = u.pm * BM + wr * 64 + fr, col0 = u.pn * BM + wc * 32 + 4 * fq;
#pragma unroll
        for (int ai = 0; ai < 2; ++ai)
#pragma unroll
            for (int mp = 0; mp < 4; mp += 2) { f32x4 xv0[2][2], xv1[2][2]; float mu0 = 0.f, mu1 = 0.f, rs0 = 1.f, rs1 = 1.f;
                const int rowa = row0 + ai * HALF + mp * 16, rowb = rowa + 16; const size_t offa = (size_t)rowa * ldc + col0, offb = (size_t)rowb * ldc + col0;
                if (stats) { mu0 = stats[2 * rowa]; rs0 = stats[2 * rowa + 1]; mu1 = stats[2 * rowb]; rs1 = stats[2 * rowb + 1]; }
                const float sra = sa[rowa], srb = sa[rowb];
#pragma unroll
                for (int bj = 0; bj < 2; ++bj)
#pragma unroll
                    for (int n = 0; n < 2; ++n) { xv0[bj][n] = *(const f32x4*)(X + offa + bj * HALF + n * 16); xv1[bj][n] = *(const f32x4*)(X + offb + bj * HALF + n * 16); }
                asm volatile("" ::: "memory");
#pragma unroll
                for (int bj = 0; bj < 2; ++bj)
#pragma unroll
                    for (int n = 0; n < 2; ++n) { f32x4 xa = xv0[bj][n], xb = xv1[bj][n];
                        if (stats) { const f32x4 gv = *(const f32x4*)(lg + col0 + bj * HALF + n * 16), bv = *(const f32x4*)(lb + col0 + bj * HALF + n * 16);
                            xa = (xa - mu0) * rs0 * gv + bv; xb = (xb - mu1) * rs1 * gv + bv; }
                        const f32x4 wv = *(const f32x4*)(sb + col0 + bj * HALF + n * 16);
                        *(f32x4*)(T + offa + bj * HALF + n * 16) = xa * alpha + cvt4(acc[ai][bj][mp][n], sra) * wv;
                        *(f32x4*)(T + offb + bj * HALF + n * 16) = xb * alpha + cvt4(acc[ai][bj][mp + 1][n], srb) * wv; }
                asm volatile("" ::: "memory"); }
    }
};
template <class Epi, class Sched, bool ALIGN_EPI = false, bool SP2 = false, bool I8 = false>
__device__ __forceinline__ void gemm_phase(PG8_LAS unsigned char* lds, const Gemm g, const Sched& S, const Epi& E) {
    int tid = threadIdx.x; asm volatile("" : "+v"(tid));
    const int wid = __builtin_amdgcn_readfirstlane(tid >> 6), lane = tid & 63, wr = wid >> 2, wc = wid & 3, fr = lane & 15, fq = lane >> 4;
    const int K = g.K, nt = K / BK;
    unsigned voffA[2], voffB[2];
#pragma unroll
    for (int i = 0; i < 2; ++i) { int R, C; stage_rc(tid * 16 + i * 8192, R, C); const int Rb = Epi::PERM ? ((R & ~31) + perm32(R & 31)) : R;
        voffA[i] = (unsigned)(R * g.lda + C) * 2u; voffB[i] = (unsigned)(Rb * K + C) * 2u; }
    const size_t kstep = (size_t)(BK * 2);
    const size_t hstepA = (size_t)HALF * g.lda * 2, hstepB = (size_t)HALF * K * 2;
    const size_t tstepA = 2 * hstepA, tstepB = 2 * hstepB;
    const unsigned ldsw = (unsigned)wid * 1024u;
    const int aoff = lds_byte(wr * 64 + fr, fq * 8), boff = lds_byte(wc * 32 + fr, fq * 8);
#define PG8_SA(b, h) (((b) * 2 + (h)) * HTB)
#define PG8_SB(b, h) ((4 + (b) * 2 + (h)) * HTB)
#define PG8_STAGE(bufoff, gbase, voff) do { _Pragma("unroll") for (int _i = 0; _i < 2; ++_i) \
        __builtin_amdgcn_global_load_lds((const unsigned*)((const char*)(gbase) + (voff)[_i]), (PG8_LAS unsigned*)(lds + (bufoff) + ldsw + _i * 8192), 16, 0, 0); } while (0)
#define PG8_LDA(dst, b, h) do { _Pragma("unroll") for (int m = 0; m < 4; ++m) _Pragma("unroll") for (int k = 0; k < 2; ++k) dst[m][k] = *(const PG8_LAS bf16x8*)(lds + PG8_SA(b, h) + aoff + m * 2048 + k * 1024); } while (0)
#define PG8_LDB(dst, b, h) do { _Pragma("unroll") for (int n = 0; n < 2; ++n) _Pragma("unroll") for (int k = 0; k < 2; ++k) dst[n][k] = *(const PG8_LAS bf16x8*)(lds + PG8_SB(b, h) + boff + n * 2048 + k * 1024); } while (0)
#define PG8_MMA(ai, bj, At, Bt) do { __builtin_amdgcn_s_setprio(1); _Pragma("unroll") for (int m = 0; m < 4; ++m) _Pragma("unroll") for (int n = 0; n < 2; ++n) _Pragma("unroll") for (int k = 0; k < 2; ++k) \
        { if constexpr (I8) acc[ai][bj][m][n] = __builtin_amdgcn_mfma_i32_16x16x64_i8(__builtin_bit_cast(i32x4, Bt[n][k]), __builtin_bit_cast(i32x4, At[m][k]), acc[ai][bj][m][n], 0, 0, 0); \
          else acc[ai][bj][m][n] = __builtin_amdgcn_mfma_f32_16x16x32_bf16(Bt[n][k], At[m][k], acc[ai][bj][m][n], 0, 0, 0); } __builtin_amdgcn_s_setprio(0); } while (0)
#define PG8_WAIT_V(n) asm volatile("s_waitcnt vmcnt(" #n ")" ::: "memory")
#define PG8_WAIT_L(n) asm volatile("s_waitcnt lgkmcnt(" #n ")" ::: "memory")
#define PG8_BAR __builtin_amdgcn_s_barrier()
#define PG8_SCHED __builtin_amdgcn_sched_barrier(0)
    Unit cur, nxt; int ui = 0;
    if (!S.next(0, cur)) return;
    typedef typename AccSel<I8>::type AccT; AccT acc[2][2][4][2];
#pragma unroll
    for (int a = 0; a < 2; ++a)
#pragma unroll
        for (int b = 0; b < 2; ++b)
#pragma unroll
            for (int m = 0; m < 4; ++m)
#pragma unroll
                for (int n = 0; n < 2; ++n) acc[a][b][m][n] = AccT{};
    bf16x8 At[4][2], B0[2][2], B1[2][2];
    const char* cA = (const char*)g.A + (size_t)cur.pm * tstepA; const char* cB = (const char*)g.Bt + (size_t)cur.pn * tstepB;
    S.a_ready(cur);
    if constexpr (SP2) {
        PG8_STAGE(PG8_SB(0, 0), cB, voffB); PG8_STAGE(PG8_SB(0, 1), cB + hstepB, voffB); PG8_STAGE(PG8_SA(0, 0), cA, voffA); PG8_STAGE(PG8_SA(0, 1), cA + hstepA, voffA);
        if (wr == 1) PG8_BAR;
        PG8_WAIT_V(2); PG8_BAR;
        PG8_STAGE(PG8_SB(1, 0), cB + kstep, voffB); PG8_STAGE(PG8_SA(1, 0), cA + kstep, voffA); PG8_STAGE(PG8_SB(1, 1), cB + hstepB + kstep, voffB);
        PG8_WAIT_V(6); PG8_BAR;
    } else {
        PG8_STAGE(PG8_SB(0, 0), cB, voffB); PG8_STAGE(PG8_SA(0, 0), cA, voffA); PG8_STAGE(PG8_SB(0, 1), cB + hstepB, voffB); PG8_STAGE(PG8_SA(0, 1), cA + hstepA, voffA);
        if (wr == 1) PG8_BAR;
        PG8_WAIT_V(4); PG8_BAR;
        PG8_STAGE(PG8_SB(1, 0), cB + kstep, voffB); PG8_STAGE(PG8_SA(1, 0), cA + kstep, voffA); PG8_STAGE(PG8_SB(1, 1), cB + hstepB + kstep, voffB);
        PG8_WAIT_V(6); PG8_BAR;
    }
    for (;;) {
        const bool has_next = S.next(ui + 1, nxt);
        const char* nA = has_next ? (const char*)g.A + (size_t)nxt.pm * tstepA : cA; const char* nB = has_next ? (const char*)g.Bt + (size_t)nxt.pn * tstepB : cB;
        for (int t = 0; t < nt; t += 2) {
            const bool last = (t == nt - 2);
            const char* a1 = cA + (size_t)(t + 1) * kstep;
            const char* a2 = last ? nA : cA + (size_t)(t + 2) * kstep; const char* b2 = last ? nB : cB + (size_t)(t + 2) * kstep;
            const char* a3 = a2 + kstep; const char* b3 = b2 + kstep;
            if (last && has_next) S.a_ready(nxt);
            if constexpr (SP2) {
            PG8_LDB(B0, 0, 0); PG8_LDB(B1, 0, 1); PG8_SCHED; PG8_LDA(At, 0, 0); PG8_STAGE(PG8_SA(1, 1), a1 + hstepA, voffA);
            PG8_WAIT_V(8); PG8_WAIT_L(0); PG8_BAR; PG8_MMA(0, 0, At, B0); PG8_MMA(0, 1, At, B1); PG8_BAR; PG8_SCHED;
            PG8_LDA(At, 0, 1); PG8_STAGE(PG8_SB(0, 0), b2, voffB); PG8_STAGE(PG8_SB(0, 1), b2 + hstepB, voffB); PG8_STAGE(PG8_SA(0, 0), a2, voffA);
            PG8_WAIT_V(8); PG8_WAIT_L(0); PG8_BAR; PG8_MMA(1, 0, At, B0); PG8_MMA(1, 1, At, B1); PG8_BAR; PG8_SCHED;
            PG8_LDB(B0, 1, 0); PG8_LDB(B1, 1, 1); PG8_SCHED; PG8_LDA(At, 1, 0); PG8_STAGE(PG8_SA(0, 1), a2 + hstepA, voffA);
            PG8_WAIT_V(8); PG8_WAIT_L(0); PG8_BAR; PG8_MMA(0, 0, At, B0); PG8_MMA(0, 1, At, B1); PG8_BAR; PG8_SCHED;
            PG8_LDA(At, 1, 1); PG8_STAGE(PG8_SB(1, 0), b3, voffB); PG8_STAGE(PG8_SB(1, 1), b3 + hstepB, voffB); PG8_STAGE(PG8_SA(1, 0), a3, voffA);
            PG8_WAIT_V(8); PG8_WAIT_L(0); PG8_BAR; PG8_MMA(1, 0, At, B0); PG8_MMA(1, 1, At, B1); PG8_BAR; PG8_SCHED;
            } else {
            PG8_LDB(B0, 0, 0); PG8_SCHED; PG8_LDA(At, 0, 0); PG8_STAGE(PG8_SA(1, 1), a1 + hstepA, voffA);
            PG8_WAIT_L(8); PG8_BAR; PG8_WAIT_L(0); PG8_MMA(0, 0, At, B0); PG8_BAR; PG8_SCHED;
            PG8_LDB(B1, 0, 1); PG8_STAGE(PG8_SB(0, 0), b2, voffB);
            PG8_BAR; PG8_WAIT_L(0); PG8_MMA(0, 1, At, B1); PG8_BAR;
            PG8_LDA(At, 0, 1); PG8_STAGE(PG8_SA(0, 0), a2, voffA);
            PG8_BAR; PG8_WAIT_L(0); PG8_MMA(1, 0, At, B0); PG8_BAR; PG8_SCHED;
            PG8_STAGE(PG8_SB(0, 1), b2 + hstepB, voffB);
            PG8_WAIT_V(6); PG8_BAR; PG8_MMA(1, 1, At, B1); PG8_BAR;
            PG8_LDB(B0, 1, 0); PG8_SCHED; PG8_LDA(At, 1, 0); PG8_STAGE(PG8_SA(0, 1), a2 + hstepA, voffA);
            PG8_WAIT_L(8); PG8_BAR; PG8_WAIT_L(0); PG8_MMA(0, 0, At, B0); PG8_BAR; PG8_SCHED;
            PG8_LDB(B1, 1, 1); PG8_STAGE(PG8_SB(1, 0), b3, voffB);
            PG8_BAR; PG8_WAIT_L(0); PG8_MMA(0, 1, At, B1); PG8_BAR;
            PG8_LDA(At, 1, 1); PG8_STAGE(PG8_SA(1, 0), a3, voffA);
            PG8_BAR; PG8_WAIT_L(0); PG8_MMA(1, 0, At, B0); PG8_BAR; PG8_SCHED;
            PG8_STAGE(PG8_SB(1, 1), b3 + hstepB, voffB);
            PG8_WAIT_V(6); PG8_BAR; PG8_MMA(1, 1, At, B1); PG8_BAR;
            }
        }
        if constexpr (ALIGN_EPI) { if (wr == 0) PG8_BAR; }
        if constexpr (!Epi::AFTER_DRAIN) { E(acc, cur, wr, wc, fr, fq); S.done(cur); }
        if (!has_next) break;
#pragma unroll
        for (int a = 0; a < 2; ++a)
#pragma unroll
            for (int b = 0; b < 2; ++b)
#pragma unroll
                for (int m = 0; m < 4; ++m)
#pragma unroll
                    for (int n = 0; n < 2; ++n) acc[a][b][m][n] = AccT{};
        cur = nxt; cA = nA; cB = nB; ++ui;
        if constexpr (ALIGN_EPI) { if (wr == 1) PG8_BAR; }
    }
    PG8_WAIT_V(0);
    if constexpr (!ALIGN_EPI) { if (wr == 0) PG8_BAR; }
    PG8_BAR;
    if constexpr (Epi::AFTER_DRAIN) { E.fused(acc, cur, wr, wc, fr, fq, lds, wid, lane); S.done(cur); }
#undef PG8_SA
#undef PG8_SB
#undef PG8_STAGE
#undef PG8_LDA
#undef PG8_LDB
#undef PG8_MMA
#undef PG8_WAIT_V
#undef PG8_WAIT_L
#undef PG8_BAR
#undef PG8_SCHED
}
}
namespace at {
typedef unsigned short bf16;
typedef short bf16x8 __attribute__((ext_vector_type(8)));
typedef short s16x4 __attribute__((ext_vector_type(4)));
typedef float f32x16 __attribute__((ext_vector_type(16)));
typedef float f32x4 __attribute__((ext_vector_type(4)));
typedef unsigned u32x4 __attribute__((ext_vector_type(4)));
constexpr int D = 128;
constexpr float SCALE = 0.08838834764831845f, INV_SCALE = 11.313708498984761f, THR = 8.f;
constexpr int NW = 8, QBLK = 32, KVBLK = 64, QB = NW * QBLK;
constexpr int SHM_V = KVBLK * D * 2, SHM_K = KVBLK * D * 2;
constexpr int LDS_ATT = 2 * SHM_V + 2 * SHM_K + NW * 64 * 4;
constexpr int BIAS_OFF = LDS_ATT, JLW_OFF = BIAS_OFF + 8192 * 4, LDS_TOTAL = JLW_OFF + 16;

#define KSWZ(row, colB) ((row) * 256 + ((colB) ^ (((row) & 7) << 4)))
#define SBAR() __builtin_amdgcn_sched_barrier(0)
#define LBAR() do { asm volatile("s_waitcnt lgkmcnt(0)" ::: "memory"); __builtin_amdgcn_s_barrier(); asm volatile("" ::: "memory"); } while (0)
__device__ __forceinline__ int v_st(int k, int c) { const int kk = (k & ~0xC) | ((k & 4) << 1) | ((k & 8) >> 1); return ((kk >> 3) * 4 + (c >> 5)) * 512 + ((kk & 7) * 32 + (c & 31)) * 2; }
__device__ __forceinline__ int v_rd_base(int lane) { return ((lane & 3) << 3) | (((lane >> 2) & 3) << 6) | (((lane >> 4) & 1) << 5) | (((lane >> 5) & 1) << 8); }
constexpr int v_rd_off(int d0, int ks, int half) { return d0 * 512 + ks * 4096 + half * 2048; }
__device__ __forceinline__ int crow(int r, int hi) { return (r & 3) + 8 * (r >> 2) + 4 * hi; }
__device__ __forceinline__ unsigned cvtpk(float lo, float hi) { unsigned r; asm volatile("v_cvt_pk_bf16_f32 %0, %1, %2" : "=v"(r) : "v"(lo), "v"(hi)); return r; }
__device__ __forceinline__ bf16x8 load8(const bf16* p) { return *reinterpret_cast<const bf16x8*>(p); }
__device__ __forceinline__ void mask_tile(f32x16& p0, f32x16& p1, int dq, unsigned W) {
    const float NEG = -__builtin_inff();
#pragma unroll
    for (int r = 0; r < 16; ++r) {
        const int c = (r & 3) + 8 * (r >> 2);
        if ((unsigned)(dq - c) >= W) p0[r] = NEG;
        if ((unsigned)(dq - c - 32) >= W) p1[r] = NEG;
    }
}
__device__ __forceinline__ void partialSM(f32x16& p0, f32x16& p1, float& m_reg, float& mn, float& alpha) {
    float pmax = p0[0]; for (int r = 1; r < 16; ++r) pmax = fmaxf(pmax, p0[r]); for (int r = 0; r < 16; ++r) pmax = fmaxf(pmax, p1[r]);
    { auto rr = __builtin_amdgcn_permlane32_swap(__float_as_uint(pmax), __float_as_uint(pmax), false, false);
      pmax = fmaxf(__uint_as_float(rr[0]), __uint_as_float(rr[1])); }
    constexpr float C2 = 1.4426950408889634f * SCALE;
    if (__builtin_expect(__all((pmax - m_reg) * SCALE <= THR), 1)) { mn = m_reg; alpha = 1.f; }
    else { mn = fmaxf(m_reg, pmax); alpha = __builtin_amdgcn_exp2f((m_reg - mn) * C2); m_reg = mn; }
    const float mnL = -mn * C2;
    for (int r = 0; r < 16; ++r) p0[r] = fmaf(p0[r], C2, mnL); for (int r = 0; r < 16; ++r) p1[r] = fmaf(p1[r], C2, mnL);
    for (int r = 0; r < 16; ++r) p0[r] = __builtin_amdgcn_exp2f(p0[r]);
}
__device__ __forceinline__ void finishSM(f32x16& p0, f32x16& p1, float alpha, float& l_reg, bf16x8& pa0, bf16x8& pa1, bf16x8& pa2, bf16x8& pa3) {
    for (int r = 0; r < 16; ++r) p1[r] = __builtin_amdgcn_exp2f(p1[r]);
    float ps = 0; for (int r = 0; r < 16; ++r) ps += p0[r]; for (int r = 0; r < 16; ++r) ps += p1[r];
    { auto rr = __builtin_amdgcn_permlane32_swap(__float_as_uint(ps), __float_as_uint(ps), false, false);
      ps = __uint_as_float(rr[0]) + __uint_as_float(rr[1]); }
    l_reg = l_reg * alpha + ps;
#define PK4(P, B_, OUT) do { unsigned a0 = cvtpk(P[B_+0], P[B_+1]), a1 = cvtpk(P[B_+2], P[B_+3]);                          \
        unsigned b0 = cvtpk(P[B_+4], P[B_+5]), b1 = cvtpk(P[B_+6], P[B_+7]);                                             \
        auto r0 = __builtin_amdgcn_permlane32_swap(a0, b0, false, false); auto r1 = __builtin_amdgcn_permlane32_swap(a1, b1, false, false); \
        u32x4 w = {r0[0], r1[0], r0[1], r1[1]}; OUT = *reinterpret_cast<bf16x8*>(&w); } while (0)
    PK4(p0, 0, pa0); PK4(p0, 8, pa1); PK4(p1, 0, pa2); PK4(p1, 8, pa3);
#undef PK4
}
template <int KB, bool SK>
__device__ __forceinline__ void qkt(f32x16& p0, f32x16& p1, const char* K_lds, int r32, int hi, const bf16x8* qr, bool act) {
    if (SK && !act) { const float NEG = -__builtin_inff();
#pragma unroll
        for (int r = 0; r < 16; ++r) { p0[r] = NEG; p1[r] = NEG; } return; }
    p0 = f32x16{}; p1 = f32x16{};
    const char* kb[4];
#pragma unroll
    for (int dd = 0; dd < 4; ++dd) kb[dd] = K_lds + KB * SHM_K + KSWZ(r32, (dd * 16 + hi * 8) * 2);
#pragma unroll
    for (int d0 = 0; d0 < 8; ++d0) { const char* a = kb[d0 & 3] + (d0 >> 2) * 128;
        bf16x8 b0 = *reinterpret_cast<const bf16x8*>(a);
        bf16x8 b1 = *reinterpret_cast<const bf16x8*>(a + 32 * 256);
        p0 = __builtin_amdgcn_mfma_f32_32x32x16_bf16(b0, qr[d0], p0, 0, 0, 0);
        p1 = __builtin_amdgcn_mfma_f32_32x32x16_bf16(b1, qr[d0], p1, 0, 0, 0); }
}
template <int VB, bool SK>
__device__ __forceinline__ void pv_tile(f32x16* o, int vb0, bf16x8 pa0, bf16x8 pa1, bf16x8 pa2, bf16x8 pa3, bool act) {
    if (SK && !act) return;
#define TRRD(dst, off) asm volatile("ds_read_b64_tr_b16 %0, %1 offset:%2" : "=&v"(dst) : "v"(vb0), "i"(off) : "memory")
#define PV_D0(d0) do { s16x4 l0, l1, l2, l3, h0, h1, h2, h3; constexpr int b_ = VB * SHM_V + v_rd_off(d0, 0, 0); \
        TRRD(l0, b_); TRRD(h0, b_ + 2048); TRRD(l1, b_ + 4096); TRRD(h1, b_ + 6144); TRRD(l2, b_ + 8192); TRRD(h2, b_ + 10240); TRRD(l3, b_ + 12288); TRRD(h3, b_ + 14336); \
        asm volatile("s_waitcnt lgkmcnt(0)" ::: "memory"); SBAR();   \
        o[d0] = __builtin_amdgcn_mfma_f32_32x32x16_bf16(pa0, (bf16x8){l0[0], l0[1], l0[2], l0[3], h0[0], h0[1], h0[2], h0[3]}, o[d0], 0, 0, 0);   \
        o[d0] = __builtin_amdgcn_mfma_f32_32x32x16_bf16(pa1, (bf16x8){l1[0], l1[1], l1[2], l1[3], h1[0], h1[1], h1[2], h1[3]}, o[d0], 0, 0, 0);   \
        o[d0] = __builtin_amdgcn_mfma_f32_32x32x16_bf16(pa2, (bf16x8){l2[0], l2[1], l2[2], l2[3], h2[0], h2[1], h2[2], h2[3]}, o[d0], 0, 0, 0);   \
        o[d0] = __builtin_amdgcn_mfma_f32_32x32x16_bf16(pa3, (bf16x8){l3[0], l3[1], l3[2], l3[3], h3[0], h3[1], h3[2], h3[3]}, o[d0], 0, 0, 0); } while (0)
    PV_D0(0); PV_D0(1); PV_D0(2); PV_D0(3);
#undef PV_D0
#undef TRRD
}
struct BlkRef { const bf16* Q; const bf16* K; const bf16* V; bf16* O; float* LSE; const float* CUM; int P0, pq, po, pl, skv; float thr; };
struct Seam { bf16x8 qr[8]; bf16x8 st_v0[1], st_v1[1], st_k0[1], st_k1[1]; int jlo; };
__device__ __forceinline__ int swa_jlo(int P0, int W) { const int lowk = P0 - W + 1; return lowk > 0 ? lowk / KVBLK : 0; }
#define ROW(p, k0, rr, pit) ((p) + (size_t)((k0) + (rr)) * (pit) + sc)
#define VMW() asm volatile("s_waitcnt vmcnt(0)" ::: "memory")
#define VMWN(n) asm volatile("s_waitcnt vmcnt(%0)" :: "i"(n) : "memory")
#define SLOAD_H(Z, Kp, Vp, k0, pit) do { S.st_v0[Z] = load8(ROW(Vp, k0, sr, pit)); S.st_v1[Z] = load8(ROW(Vp, k0, 32 + sr, pit));              \
                         S.st_k0[Z] = load8(ROW(Kp, k0, sr, pit)); S.st_k1[Z] = load8(ROW(Kp, k0, 32 + sr, pit)); } while (0)
#define SWRITE_HK(Z, bf) do { *(bf16x8*)(K_lds + (bf) * SHM_K + kws) = S.st_k0[Z]; *(bf16x8*)(K_lds + (bf) * SHM_K + kws + 32 * 256) = S.st_k1[Z]; } while (0)
#define SWRITE_HV(Z, bf) do { *(bf16x8*)(V_lds + (bf) * SHM_V + vst0) = S.st_v0[Z]; *(bf16x8*)(V_lds + (bf) * SHM_V + vst1) = S.st_v1[Z]; } while (0)
#define SWRITE_H(Z, bf) do { SWRITE_HV(Z, bf); SWRITE_HK(Z, bf); } while (0)
__device__ __forceinline__ int fox_jlo(const BlkRef& R, char* lds) {
    int tid = threadIdx.x; asm volatile("" : "+v"(tid));
    int* jlw = (int*)(lds + JLW_OFF); int nt0 = R.P0 / KVBLK; asm volatile("" : "+s"(nt0));
    if (tid == 0) *jlw = nt0;
    __syncthreads();
    if (tid < nt0) { if (R.CUM[R.P0] - R.CUM[KVBLK * tid + KVBLK - 1] >= -R.thr) atomicMin(jlw, tid); }
    __syncthreads();
    return *jlw;
}
template <bool FOX>
__device__ __forceinline__ void attn_prime(const BlkRef& cur, int W, char* lds, Seam& S) {
    int tid = threadIdx.x; asm volatile("" : "+v"(tid));
    const int wid = __builtin_amdgcn_readfirstlane(tid >> 6), lane = tid & 63, r32 = lane & 31, hi = lane >> 5;
    const int sr = tid >> 4, sc = (tid & 15) * 8, kws = KSWZ(sr, sc * 2); char* K_lds = lds + 2 * SHM_V;
    S.jlo = FOX ? fox_jlo(cur, lds) : swa_jlo(cur.P0, W);
    const int kb0 = S.jlo * KVBLK;
    for (int d0 = 0; d0 < 8; ++d0) S.qr[d0] = load8(cur.Q + (size_t)(wid * QBLK + r32) * cur.pq + d0 * 16 + hi * 8);
    SLOAD_H(0, cur.K, cur.V, kb0, cur.pq); VMW(); SWRITE_HK(0, 0);
    __syncthreads();
}
template <bool FOX, bool SK, int W>
__device__ __forceinline__ void attn_block(const BlkRef& cur, const BlkRef& nxt, char* lds, Seam& S) {
    int tid = threadIdx.x; asm volatile("" : "+v"(tid));
    const int wid = __builtin_amdgcn_readfirstlane(tid >> 6), lane = tid & 63, r32 = lane & 31, hi = lane >> 5;
    const int j_lo = S.jlo;
    int j_hi = (cur.P0 + QB - 1) / KVBLK + 1; if (j_hi > cur.skv / KVBLK) j_hi = cur.skv / KVBLK;
    const int NT = j_hi - j_lo;
    const int qlo = cur.P0 + wid * QBLK, qm = qlo + r32 - 4 * hi;
    char* V_lds = lds; char* K_lds = lds + 2 * SHM_V;
    float* ws = (float*)(lds + 2 * SHM_V + 2 * SHM_K) + wid * 64; float* li_l = ws, * al_l = ws + 32;
    float* bias = (float*)(lds + BIAS_OFF);
    const int sr = tid >> 4, sc = (tid & 15) * 8, vst0 = v_st(sr, sc), vst1 = vst0 + 8192  , kws = KSWZ(sr, sc * 2);
    const int vb0 = (int)(uintptr_t)V_lds + v_rd_base(lane);
    const bf16* Kh = cur.K; const bf16* Vh = cur.V; const int pq = cur.pq;
    if (FOX) {
        const float cref = cur.CUM[cur.P0]; const int nb_ = cur.P0 + QB;
        for (int j = j_lo * KVBLK + tid; j < nb_; j += NW * 64) bias[j] = (cref - cur.CUM[j]) * INV_SCALE;
    }
    if (FOX) __syncthreads();
    float m_reg = -1e30f, l_reg = 0; f32x16 o[4] = {};
#define RESC(a) do { if (__any((a) < 1.f)) { if (hi == 0) al_l[r32] = (a); asm volatile("s_waitcnt lgkmcnt(0)" ::: "memory");              \
                     for (int d_ = 0; d_ < 4; ++d_) for (int r = 0; r < 16; ++r) o[d_][r] *= al_l[crow(r, hi)]; } } while (0)
#define KBASE(t) ((j_lo + (t)) * KVBLK)
#define ACT(t) (KBASE(t) <= qlo + QBLK - 1 && KBASE(t) + KVBLK - 1 >= qlo - W + 1)
#define MASKT(P0_, P1_, t) do { const int kb_ = KBASE(t); \
        if (FOX) { const float* bp_ = bias + kb_ + 4 * hi; _Pragma("unroll") for (int g_ = 0; g_ < 4; ++g_) { const f32x4 b0_ = *(const f32x4*)(bp_ + 8 * g_), b1_ = *(const f32x4*)(bp_ + 32 + 8 * g_); \
            _Pragma("unroll") for (int e_ = 0; e_ < 4; ++e_) { P0_[4 * g_ + e_] += b0_[e_]; P1_[4 * g_ + e_] += b1_[e_]; } } } \
        if ((!SK || ACT(t)) && (kb_ + KVBLK - 1 > qlo || kb_ <= qlo + QBLK - 1 - W)) mask_tile(P0_, P1_, qm - kb_, (unsigned)W); } while (0)
    f32x16 pA0, pA1, pB0, pB1; float mnA, mnB, alA, alB; bf16x8 pa0, pa1, pa2, pa3;
    SWRITE_HV(0, 0); SBAR();
    if (NT > 1) { SLOAD_H(0, Kh, Vh, KBASE(1), pq); }
    SBAR(); qkt<0, SK>(pA0, pA1, K_lds, r32, hi, S.qr, ACT(0));
    MASKT(pA0, pA1, 0); partialSM(pA0, pA1, m_reg, mnA, alA);
    if (NT > 1) { VMW(); SWRITE_H(0, 1); }
    __syncthreads();
#define HALF_STEP(PX0, PX1, mnX, alX, PY0, PY1, alY, t, KB, VB, SB) do {                                                      \
        SBAR(); qkt<KB, SK>(PX0, PX1, K_lds, r32, hi, S.qr, ACT(t));                                             \
        finishSM(PY0, PY1, alY, l_reg, pa0, pa1, pa2, pa3); SBAR();                                                           \
        if ((t) + 1 < NT) { SLOAD_H(0, Kh, Vh, KBASE((t) + 1), pq); SBAR(); }                                               \
        pv_tile<VB, SK>(o, vb0, pa0, pa1, pa2, pa3, ACT((t) - 1)); MASKT(PX0, PX1, (t)); partialSM(PX0, PX1, m_reg, mnX, alX);                                        \
        __syncthreads();                                                                                                      \
        if ((t) + 1 < NT) { VMW(); SWRITE_H(0, SB); }                                                                          \
        RESC(alX); __syncthreads(); } while (0)
    for (int t = 1; t + 1 < NT; t += 2) {
        HALF_STEP(pB0, pB1, mnB, alB, pA0, pA1, alA, t, 1, 0, 0);
        HALF_STEP(pA0, pA1, mnA, alA, pB0, pB1, alB, t + 1, 0, 1, 1);
    }
    const bool even = (NT & 1) == 0;
    if (even) { SBAR(); qkt<1, SK>(pB0, pB1, K_lds, r32, hi, S.qr, ACT(NT - 1)); SBAR(); }
    const int jln = FOX ? fox_jlo(nxt, lds) : swa_jlo(nxt.P0, W); const int kbn = jln * KVBLK; S.jlo = jln;
    SLOAD_H(0, nxt.K, nxt.V, kbn, nxt.pq); SBAR();
#pragma unroll
    for (int d0 = 0; d0 < 8; ++d0) S.qr[d0] = load8(nxt.Q + (size_t)(wid * QBLK + r32) * nxt.pq + d0 * 16 + hi * 8);
    SBAR();
    finishSM(pA0, pA1, alA, l_reg, pa0, pa1, pa2, pa3); SBAR();
    pv_tile<0, SK>(o, vb0, pa0, pa1, pa2, pa3, ACT(even ? NT - 2 : NT - 1));
    if (even) { MASKT(pB0, pB1, NT - 1); partialSM(pB0, pB1, m_reg, mnB, alB); __syncthreads(); RESC(alB);
        finishSM(pB0, pB1, alB, l_reg, pa0, pa1, pa2, pa3); SBAR(); pv_tile<1, SK>(o, vb0, pa0, pa1, pa2, pa3, ACT(NT - 1)); }
    SBAR(); VMWN(8); SWRITE_HK(0, 0); SBAR();
    if (hi == 0) li_l[r32] = l_reg; asm volatile("s_waitcnt lgkmcnt(0)" ::: "memory");
    if (!FOX) { if (hi == 0) cur.LSE[(size_t)(wid * QBLK + r32) * cur.pl] = m_reg * SCALE + __logf(l_reg); }
    float rli[16];
#pragma unroll
    for (int r = 0; r < 16; ++r) rli[r] = __builtin_amdgcn_rcpf(li_l[crow(r, hi)]);
    bf16* Ow = cur.O + (size_t)(wid * QBLK) * cur.po;
#pragma unroll
    for (int r = 0; r < 16; ++r) { const int orow = crow(r, hi);
#pragma unroll
        for (int d0 = 0; d0 < 4; ++d0) { const float v = o[d0][r] * rli[r];
            const float vn = __shfl_xor(v, 1);
            if ((r32 & 1) == 0) *(unsigned*)(Ow + (size_t)orow * cur.po + d0 * 32 + r32) = cvtpk(v, vn); } }
    __syncthreads();
#undef RESC
#undef KBASE
#undef ACT
#undef MASKT
#undef HALF_STEP
}
#undef ROW
#undef VMW
#undef VMWN
#undef SLOAD_H
#undef SWRITE_HK
#undef SWRITE_HV
#undef SWRITE_H
}
#define LAS __attribute__((address_space(3)))
#define XB_TMO      128
#define XB_XCNT(j)  (256  + 64 * (j))
#define XB_XSUB(j)  (1280 + 64 * (j))
#define XB_XGEN(j)  (2304 + 64 * (j))
#define XB_TOP      3328
#define XB_TOPGEN   3392
#define XCD_BAR_WORDS 3456
#define XB_SPIN_CAP (1u << 18)

__device__ __forceinline__ unsigned xb_ld(unsigned* p)              { return __hip_atomic_load(p, __ATOMIC_RELAXED, __HIP_MEMORY_SCOPE_AGENT); }
__device__ __forceinline__ unsigned xb_add(unsigned* p, unsigned v) { return __hip_atomic_fetch_add(p, v, __ATOMIC_RELAXED, __HIP_MEMORY_SCOPE_AGENT); }
__device__ __forceinline__ unsigned xb_xcc_id() { return (unsigned)__builtin_amdgcn_s_getreg((3 << 11) | 20) & 0xFu; }
#define XB_SPIN(cond, bar) do { unsigned _sp = 0; while (cond) { __builtin_amdgcn_s_sleep(1); \
    if ((++_sp & 255u) == 0u) { if (xb_ld(&(bar)[XB_TMO])) break; if (_sp > XB_SPIN_CAP) { atomicAdd(&(bar)[XB_TMO], 1u); break; } } } } while (0)

struct XcdBarrier {
    unsigned* bar; unsigned x;
    volatile LAS unsigned* st;
};

__device__ __forceinline__ XcdBarrier xcd_barrier_post(unsigned* bar, volatile LAS unsigned* st) {
    XcdBarrier b; b.bar = bar; b.x = xb_xcc_id(); b.st = st;
    if (threadIdx.x == 0) (void)xb_add(&bar[XB_XCNT(b.x)], 1u);
    return b;
}
__device__ __forceinline__ void xcd_barrier_complete(unsigned* bar, unsigned x, unsigned& nloc, unsigned& nx) {
    const unsigned G = gridDim.x * gridDim.y * gridDim.z;
    unsigned sum, cnt, mine, sp = 0u;
    for (;;) {
        sum = 0u; cnt = 0u; mine = 0u;
#pragma unroll
        for (unsigned j = 0; j < 16; ++j) { const unsigned c = xb_ld(&bar[XB_XCNT(j)]); sum += c; cnt += (c > 0u) ? 1u : 0u; mine = (j == x) ? c : mine; }
        if (sum == G) break;
        __builtin_amdgcn_s_sleep(1);
        if ((++sp & 255u) == 0u) { if (xb_ld(&bar[XB_TMO])) break; if (sp > XB_SPIN_CAP) { atomicAdd(&bar[XB_TMO], 1u); break; } }
    }
    nloc = mine > 0u ? mine : 1u; nx = cnt > 0u ? cnt : 1u;
}

__device__ __forceinline__ void xcd_barrier(const XcdBarrier& b) {
    asm volatile("s_waitcnt vmcnt(0)" ::: "memory");
    __syncthreads();
    if (threadIdx.x == 0) {
        unsigned* bar = b.bar;
        __builtin_amdgcn_s_waitcnt(0);
        unsigned nloc = b.st[0], nx = b.st[1];
        if (nloc == 0u) { xcd_barrier_complete(bar, b.x, nloc, nx); b.st[0] = nloc; b.st[1] = nx; }
        const unsigned old = xb_add(&bar[XB_XSUB(b.x)], 1u);
        const unsigned gen = old / nloc;
        if (old + 1u == (gen + 1u) * nloc) {
            __builtin_amdgcn_fence(__ATOMIC_RELEASE, "agent");
            asm volatile("s_waitcnt vmcnt(0)" ::: "memory");
            const unsigned og = xb_add(&bar[XB_TOP], 1u);
            const unsigned tg = og / nx;
            if (og + 1u == (tg + 1u) * nx) xb_add(&bar[XB_TOPGEN], 1u);
            else XB_SPIN(xb_ld(&bar[XB_TOPGEN]) == tg, bar);
            __builtin_amdgcn_fence(__ATOMIC_ACQUIRE, "agent");
            xb_add(&bar[XB_XGEN(b.x)], 1u);
            asm volatile("s_waitcnt vmcnt(0)" ::: "memory");
        } else {
            XB_SPIN(xb_ld(&bar[XB_XGEN(b.x)]) == gen, bar);
            __builtin_amdgcn_fence(__ATOMIC_ACQUIRE, "agent");
            asm volatile("s_waitcnt vmcnt(0)" ::: "memory");
        }
    }
    __syncthreads();
}
constexpr int BATCH = 4, SEQ = 8192, DM = 2048, M = BATCH * SEQ, NH = 12, HD = 128, WA = 1536, DEPTH = 4;
constexpr int NIN = 16396, NPAD = 16640;
constexpr int C_QA = 0, C_KA = 1536, C_VA = 3072, C_ZA = 4608, C_QB = 6144, C_KB = 7680, C_VB = 9216, C_ZB = 10752, C_G = 12288, C_F = 16384;
constexpr float LN_EPS = 1e-5f, ALPHA = 1.6817928305074290f;
constexpr size_t MiB = 1u << 20;
constexpr size_t WS_XB = 0, WS_WIN = 128 * MiB, WS_WUA = 388 * MiB, WS_WUB = 412 * MiB, WS_WOUT = 436 * MiB, WS_H = 468 * MiB, WS_OA = 1508 * MiB,
                 WS_LSE = 1796 * MiB, WS_LOGF = 1802 * MiB, WS_CUM = 1804 * MiB, WS_COS = 1806 * MiB, WS_SIN = 1808 * MiB, WS_NRM = 1810 * MiB, WS_SC = 1811 * MiB, WS_BAR = 1812 * MiB, WS_PN2 = 1813 * MiB, WS_END = 1826 * MiB;
constexpr size_t SC_SX = 0, SC_SAA = 32768, SC_SAB = 65536, SC_SWIN = 98304, SC_SWUA = SC_SWIN + 4 * 16640, SC_SWUB = SC_SWUA + 4 * 2048, SC_CSIN = SC_SWUB + 4 * 2048, SC_SWOUT = SC_CSIN + 4 * 16640;
constexpr size_t WS_STATS = WS_BAR + 65536;
constexpr size_t WS_SM = WS_BAR + 393216;
constexpr size_t WS_MF = WS_OA + 96 * MiB;
constexpr size_t OA_STRIDE = (size_t)M * WA, LSE_STRIDE = (size_t)M * NH;
constexpr int LDS_BYTES = 147456, LDS_BARST_OFF = 139264;
constexpr int NPH = 2 + 7 * DEPTH;
typedef unsigned short bf16;
typedef float f32x4 __attribute__((ext_vector_type(4)));
typedef unsigned u32x4 __attribute__((ext_vector_type(4)));

__device__ __forceinline__ unsigned f2bf(float f) { unsigned u = __builtin_bit_cast(unsigned, f); return (u + 0x7fffu + ((u >> 16) & 1u)) >> 16; }
__device__ __forceinline__ unsigned pk2(float lo, float hi) { return f2bf(lo) | (f2bf(hi) << 16); }
__device__ __forceinline__ float bflo(unsigned w) { return __uint_as_float(w << 16); }
__device__ __forceinline__ float bfhi(unsigned w) { return __uint_as_float(w & 0xffff0000u); }
__device__ __forceinline__ float wave_sum(float v) {
#pragma unroll
    for (int o = 1; o < 64; o <<= 1) v += __shfl_xor(v, o);
    return v;
}
__device__ __forceinline__ int in_src_col(int n) {
    if (n < C_VA) { const int hb = n >> 7, p = n & 127; return hb * 128 + 4 * (p >> 3) + (p & 3) + 64 * ((p >> 2) & 1); }
    if (n < C_G) return n;
    if (n < C_F) return n + 12;
    if (n < C_F + 12) return n - C_F + 12288;
    return -1;
}
__device__ __forceinline__ unsigned q8(float v) { return (unsigned)__float2int_rn(v) & 0xffu; }
__device__ __forceinline__ unsigned pack4q(float a, float b, float c, float d) { return q8(a) | (q8(b) << 8) | (q8(c) << 16) | (q8(d) << 24); }
__device__ __forceinline__ float wave_max(float v) {
#pragma unroll
    for (int o = 1; o < 64; o <<= 1) v = fmaxf(v, __shfl_xor(v, o));
    return v;
}
__device__ __forceinline__ void quant_row(const f32x4 (&v)[8], unsigned char* qrow, float* scale, int lane) {
    float amax = 0.f;
#pragma unroll
    for (int j = 0; j < 8; ++j) amax = fmaxf(amax, fmaxf(fmaxf(fabsf(v[j][0]), fabsf(v[j][1])), fmaxf(fabsf(v[j][2]), fabsf(v[j][3]))));
    amax = wave_max(amax); const float inv = amax > 0.f ? 127.f / amax : 0.f;
#pragma unroll
    for (int j = 0; j < 8; ++j) *(unsigned*)(qrow + 4 * lane + 256 * j) = pack4q(v[j][0] * inv, v[j][1] * inv, v[j][2] * inv, v[j][3] * inv);
    if (lane == 0) *scale = amax > 0.f ? amax * (1.f / 127.f) : 1.f;
}

__device__ __forceinline__ float quant_row_q(const f32x4 (&v)[8], unsigned char* qrow, float* scale, int lane, unsigned (&q)[8]) {
    float amax = 0.f;
#pragma unroll
    for (int j = 0; j < 8; ++j) amax = fmaxf(amax, fmaxf(fmaxf(fabsf(v[j][0]), fabsf(v[j][1])), fmaxf(fabsf(v[j][2]), fabsf(v[j][3]))));
    amax = wave_max(amax); const float inv = amax > 0.f ? 127.f / amax : 0.f, sc = amax > 0.f ? amax * (1.f / 127.f) : 1.f;
#pragma unroll
    for (int j = 0; j < 8; ++j) { q[j] = pack4q(v[j][0] * inv, v[j][1] * inv, v[j][2] * inv, v[j][3] * inv); *(unsigned*)(qrow + 4 * lane + 256 * j) = q[j]; }
    if (lane == 0) *scale = sc;
    return sc;
}

template <bool MAP>
__device__ __forceinline__ void quant_tile(const float* W, int K, int N, const float* cs, unsigned char* WT, float* swout, unsigned* t, int item, int nblk, int lane) {
    const int kb = item / nblk, nb = item - kb * nblk, k0 = 64 * kb, nn = 64 * nb + lane, src = MAP ? in_src_col(nn) : nn;
    const float sc = src >= 0 ? cs[src] : 1.f, inv = src >= 0 ? 1.f / sc : 0.f;
    if (swout && kb == 0) swout[nn] = sc;
    const float* wp = W + (size_t)k0 * N + (src >= 0 ? src : 0);
#pragma unroll 4
    for (int s = 0; s < 16; ++s) { const float v0 = wp[(size_t)(4 * s) * N], v1 = wp[(size_t)(4 * s + 1) * N], v2 = wp[(size_t)(4 * s + 2) * N], v3 = wp[(size_t)(4 * s + 3) * N];
        t[lane * 17 + s] = pack4q(v0 * inv, v1 * inv, v2 * inv, v3 * inv); }
    asm volatile("s_waitcnt lgkmcnt(0)" ::: "memory");
#pragma unroll
    for (int j = 0; j < 4; ++j) { const int idx = lane + 64 * j, n = idx >> 2, c = idx & 3; const unsigned* s = t + n * 17 + 4 * c;
        u32x4 o; o.x = s[0]; o.y = s[1]; o.z = s[2]; o.w = s[3];
        *(u32x4*)(WT + (size_t)(64 * nb + n) * K + k0 + 16 * c) = o; }
    asm volatile("s_waitcnt lgkmcnt(0)" ::: "memory");
}

struct Args { const float* in[9]; float* out; unsigned char* ws; int ph_lo, ph_hi; };

__global__ void __launch_bounds__(512, 2) mega_fwd(Args args) {
    extern __shared__ __attribute__((aligned(16))) unsigned char lds[];
    cg::grid_group grid = cg::this_grid();
    const int G = gridDim.x, bx = blockIdx.x, NGW = G * 8;
    const int vcu = (G % 8 == 0) ? (bx % 8) * (G / 8) + bx / 8 : bx;
#define PH_IDS int tid = threadIdx.x; asm volatile("" : "+v"(tid)); const int lane = tid & 63, wave = __builtin_amdgcn_readfirstlane(tid >> 6), gw = bx * 8 + wave; (void)lane; (void)gw; PH_PTRS
#define PH_PTRS     unsigned long long wz_ = 0; asm volatile("" : "+s"(wz_)); unsigned char* ws = args.ws + wz_;     \
    const float* x_in = args.in[0]; const float* w_in = args.in[1]; const float* b_forget = args.in[2]; const float* b_gate = args.in[3]; \
    const float* w_up_a = args.in[4]; const float* w_up_b = args.in[5]; const float* w_out = args.in[6]; const float* ln_g = args.in[7]; const float* ln_b = args.in[8]; \
    float* out = args.out; \
    bf16* XB = (bf16*)(ws + WS_XB); bf16* WIN = (bf16*)(ws + WS_WIN); bf16* WUA = (bf16*)(ws + WS_WUA); bf16* WUB = (bf16*)(ws + WS_WUB); bf16* WOUT = (bf16*)(ws + WS_WOUT); \
    bf16* H = (bf16*)(ws + WS_H); bf16* OA = (bf16*)(ws + WS_OA); bf16* MF = (bf16*)(ws + WS_MF); \
    float* LSE = (float*)(ws + WS_LSE); float* LOGF = (float*)(ws + WS_LOGF); float* CUM = (float*)(ws + WS_CUM); float* COS = (float*)(ws + WS_COS); float* SIN = (float*)(ws + WS_SIN); float* NRM = (float*)(ws + WS_NRM); float* SC = (float*)(ws + WS_SC); \
    unsigned char* XQ = ws + WS_XB; unsigned char* WINQ = ws + WS_WIN; unsigned char* WUAQ = ws + WS_WUA; unsigned char* WUBQ = ws + WS_WUB; \
    (void)x_in; (void)w_in; (void)b_forget; (void)b_gate; (void)w_up_a; (void)w_up_b; (void)w_out; (void)ln_g; (void)ln_b; (void)out; (void)XB; (void)WIN; (void)WUA; (void)WUB; (void)WOUT; (void)H; (void)OA; (void)MF; (void)LSE; (void)LOGF; (void)CUM; (void)COS; (void)SIN; (void)NRM; (void)SC; (void)XQ; (void)WINQ; (void)WUAQ; (void)WUBQ
    const int lo = args.ph_lo, hi = args.ph_hi;
#define IN(k) (lo <= (k) && (k) < hi)
#ifndef XCDBAR
#define XCDBAR 1
#endif
    volatile LAS unsigned* bst = (volatile LAS unsigned*)((LAS unsigned char*)lds + LDS_BARST_OFF);
    if (threadIdx.x < 2) bst[threadIdx.x] = 0u;
    __syncthreads();
    XcdBarrier xbar = xcd_barrier_post((unsigned*)(args.ws + WS_BAR), bst);
#define SEAM(k) do { if ((k) + 1 < hi) { if (!XCDBAR || (k) == 0) grid.sync(); else xcd_barrier(xbar); } } while (0)

    if (IN(0)) { PH_IDS;
        {   float* red = (float*)lds; constexpr int CG_IN = (NIN + 255) / 256, CG_UP = DM / 256, CG_L = CG_IN + 3 * CG_UP;
            for (int it = bx; it < DEPTH * CG_L; it += G) {
                const int l = it / CG_L; int r = it - l * CG_L; const float* W; int K, N; float* cs;
                if (r < CG_IN) { W = w_in + (size_t)l * DM * NIN; K = DM; N = NIN; cs = SC + SC_CSIN + l * NPAD; }
                else if (r < CG_IN + CG_UP) { r -= CG_IN; W = w_up_a + (size_t)l * WA * DM; K = WA; N = DM; cs = SC + SC_SWUA + l * DM; }
                else if (r < CG_IN + 2 * CG_UP) { r -= CG_IN + CG_UP; W = w_up_b + (size_t)l * WA * DM; K = WA; N = DM; cs = SC + SC_SWUB + l * DM; }
                else { r -= CG_IN + 2 * CG_UP; W = w_out + (size_t)l * DM * DM; K = DM; N = DM; cs = SC + SC_SWOUT + l * DM; }
                const int col = 256 * r + 4 * lane; f32x4 mx = {0.f, 0.f, 0.f, 0.f};
                if (col < N) { const float* wp = W + col;
#pragma unroll 8
                    for (int k = wave; k < K; k += 8) { const f32x4 v = *(const f32x4*)(wp + (size_t)k * N);
                        mx[0] = fmaxf(mx[0], fabsf(v[0])); mx[1] = fmaxf(mx[1], fabsf(v[1])); mx[2] = fmaxf(mx[2], fabsf(v[2])); mx[3] = fmaxf(mx[3], fabsf(v[3])); } }
                *(f32x4*)(red + wave * 256 + 4 * lane) = mx;
                __syncthreads();
                if (tid < 256 && 256 * r + tid < N) { float m = 0.f; for (int w = 0; w < 8; ++w) m = fmaxf(m, red[w * 256 + tid]); cs[256 * r + tid] = m > 0.f ? m * (1.f / 127.f) : 1.f; }
                __syncthreads();
            }
        }
        for (int idx = bx * 512 + tid; idx < SEQ * 64; idx += G * 512) {
            const int pos = idx >> 6, i = idx & 63;
            const float inv_freq = exp2f(-(float)i * (1.f / 64.f) * 13.287712379549449f);
            const float ang = (float)pos * inv_freq;
            const double rev = (double)ang * 0.15915494309189535; const float fr = (float)(rev - floor(rev));
            COS[idx] = __builtin_amdgcn_cosf(fr); SIN[idx] = __builtin_amdgcn_sinf(fr);
        }
        for (int m = gw; m < M; m += NGW) { f32x4 v[8];
#pragma unroll
            for (int j = 0; j < 8; ++j) v[j] = *(const f32x4*)(x_in + (size_t)m * DM + 4 * lane + 256 * j);
            quant_row(v, XQ + (size_t)m * DM, SC + SC_SX + m, lane); }
        SEAM(0);
    }
    if (IN(1)) { PH_IDS;
        unsigned* t = (unsigned*)(lds + wave * 16384);
        constexpr int T_IN = (DM / 64) * (NPAD / 64), T_UP = (WA / 64) * (DM / 64), T_OUT = (DM / 64) * (DM / 64), T_L = T_IN + 2 * T_UP + T_OUT;
        for (int it = gw; it < DEPTH * T_L; it += NGW) {
            const int l = it / T_L; int r = it - l * T_L;
            if (r < T_IN) { quant_tile<true>(w_in + (size_t)l * DM * NIN, DM, NIN, SC + SC_CSIN + l * NPAD, WINQ + (size_t)l * NPAD * DM, SC + SC_SWIN + l * NPAD, t, r, NPAD / 64, lane); continue; } r -= T_IN;
            if (r < T_UP) { quant_tile<false>(w_up_a + (size_t)l * WA * DM, WA, DM, SC + SC_SWUA + l * DM, WUAQ + (size_t)l * DM * WA, nullptr, t, r, DM / 64, lane); continue; } r -= T_UP;
            if (r < T_UP) { quant_tile<false>(w_up_b + (size_t)l * WA * DM, WA, DM, SC + SC_SWUB + l * DM, WUBQ + (size_t)l * DM * WA, nullptr, t, r, DM / 64, lane); continue; } r -= T_UP;
            quant_tile<false>(w_out + (size_t)l * DM * DM, DM, DM, SC + SC_SWOUT + l * DM, ws + WS_WOUT + (size_t)l * DM * DM, nullptr, t, r, DM / 64, lane);
        }
        SEAM(1);
    }

    for (int l = 0; l < DEPTH; ++l) {
        const int pb = 2 + 7 * l;
        if (IN(pb + 0)) { PH_IDS;
            if (bx == 0 && tid < 96) NRM[tid] = 0.f;
            const int NP1 = l == 0 ? NPAD : C_F;
            pg8::Gemm g{(const bf16*)XQ, (const bf16*)(WINQ + (size_t)l * NPAD * DM), M, NP1, DM / 2, DM / 2};   pg8::StaticOrder S; S.init(M, NP1, G, bx);
            pg8::EpiIn E{H, NPAD, COS, SIN, LOGF, b_forget + l * NH, SC + SC_SX, SC + SC_SWIN + l * NPAD, (float*)(ws + WS_PN2)};
            pg8::gemm_phase<pg8::EpiIn, pg8::StaticOrder, true, true, true>((PG8_LAS unsigned char*)lds, g, S, E);
            SEAM(pb + 0);
        }
        if (IN(pb + 1)) { PH_IDS;
            {
                float* red = (float*)lds;
                for (int b = 0; b < BATCH; ++b) {
                    float mx = 0.f;
                    for (int s = gw; s < SEQ; s += NGW) { if (lane < 24) { const f32x4 p = *(const f32x4*)((const float*)(ws + WS_PN2) + (((size_t)b * SEQ + s) * 24 + lane) * 4); mx = fmaxf(mx, (p[0] + p[1]) + (p[2] + p[3])); } }
                    if (lane < 24) red[wave * 24 + lane] = mx;
                    __syncthreads();
                    if (tid < 24) { float v = 0.f; for (int w = 0; w < 8; ++w) v = fmaxf(v, red[w * 24 + tid]); atomicMax((unsigned*)NRM + (tid < 12 ? 0 : 48) + b * NH + (tid % 12), __float_as_uint(v)); }
                    __syncthreads();
                }
            }
            if (bx < BATCH * NH) {
                const int b = bx / NH, h = bx - b * NH; float* red = (float*)lds;
                float v[16]; float run = 0.f;
#pragma unroll
                for (int j = 0; j < 16; j += 4) { const f32x4 lf = *(const f32x4*)(LOGF + (size_t)bx * SEQ + 16 * tid + j);
                    run += lf[0]; v[j] = run; run += lf[1]; v[j + 1] = run; run += lf[2]; v[j + 2] = run; run += lf[3]; v[j + 3] = run; }
                float inc = run;
#pragma unroll
                for (int o = 1; o < 64; o <<= 1) { const float t = __shfl_up(inc, o); if (lane >= o) inc += t; }
                if (lane == 63) red[wave] = inc;
                __syncthreads();
                float off = inc - run;
                for (int w = 0; w < wave; ++w) off += red[w];
                float* cp = CUM + (size_t)bx * SEQ + 16 * tid;
#pragma unroll
                for (int j = 0; j < 16; j += 4) *(f32x4*)(cp + j) = (f32x4){v[j] + off, v[j + 1] + off, v[j + 2] + off, v[j + 3] + off};
                __syncthreads();
            }
            constexpr int NIT = 3 * 1536;
            const int cnt = vcu < NIT ? (NIT - vcu + G - 1) / G : 0;
#define DIL_REF(R, n) do { const int L_ = vcu + (n) * G;   \
            const int bh_ = L_ / 96, rb_ = L_ - bh_ * 96, b_ = bh_ / NH, h_ = bh_ - b_ * NH, g_ = rb_ >> 5, r_ = rb_ & 31, dsh = 2 * g_, d_ = 1 << dsh; \
            const int qb = r_ & ((32 >> dsh) - 1), res = r_ >> (5 - dsh); \
            const size_t tok0 = (size_t)b_ * SEQ + res, rq = (size_t)qb * 256 * d_; \
            R.Q = H + (tok0 + rq) * NPAD + C_QA + h_ * HD; R.K = H + tok0 * NPAD + C_KA + h_ * HD; R.V = H + tok0 * NPAD + C_VA + h_ * HD; \
            R.O = OA + (size_t)g_ * OA_STRIDE + (tok0 + rq) * WA + h_ * HD; R.LSE = LSE + (size_t)g_ * LSE_STRIDE + (tok0 + rq) * NH + h_; R.CUM = nullptr; \
            R.P0 = qb * 256; R.pq = d_ * NPAD; R.po = d_ * WA; R.pl = d_ * NH; R.skv = SEQ >> dsh; R.thr = 0.f; } while (0)
            if (cnt > 0) {
                at::BlkRef cur, nxt; at::Seam S{};     DIL_REF(cur, 0);
                at::attn_prime<false>(cur, 129, (char*)lds, S);
                for (int n = 0; n < cnt; ++n) {
                    if (n + 1 < cnt) DIL_REF(nxt, n + 1); else nxt = cur;
                    at::attn_block<false, true, 129>(cur, nxt, (char*)lds, S);
                    cur = nxt;
                }
            }
#undef DIL_REF
            SEAM(pb + 1);
        }
        if (IN(pb + 2)) { PH_IDS;
            constexpr int NIT = BATCH * NH * 32;
            const int cnt = vcu < NIT ? (NIT - vcu + G - 1) / G : 0;
#define FOX_REF(R, n) do { const int L_ = vcu + (n) * G; const int bh = L_ >> 5, qb = (L_ + ((G & 31) == 0 ? 5 * (n) : 0)) & 31  , b_ = bh / NH, h_ = bh - b_ * NH; \
            R.Q = H + ((size_t)b_ * SEQ + (size_t)qb * 256) * NPAD + C_QB + h_ * HD; R.K = H + (size_t)b_ * SEQ * NPAD + C_KB + h_ * HD; R.V = H + (size_t)b_ * SEQ * NPAD + C_VB + h_ * HD; \
            R.O = (bf16*)R.Q; R.LSE = nullptr; R.CUM = CUM + (size_t)bh * SEQ; R.P0 = qb * 256; R.pq = NPAD; R.po = NPAD; R.pl = 0; R.skv = SEQ; R.thr = 30.f + 2.f * 1.02f * sqrtf(NRM[bh] * NRM[48 + bh]) * 0.08838834764831845f;     } while (0)
            if (cnt > 0) {
                at::BlkRef cur, nxt; at::Seam S{};     FOX_REF(cur, 0);
                at::attn_prime<true>(cur, SEQ, (char*)lds, S);
                for (int n = 0; n < cnt; ++n) {
                    if (n + 1 < cnt) FOX_REF(nxt, n + 1); else nxt = cur;
                    at::attn_block<true, false, SEQ>(cur, nxt, (char*)lds, S);
                    cur = nxt;
                }
            }
#undef FOX_REF
            SEAM(pb + 2);
        }

        if (IN(pb + 3)) { PH_IDS;
            for (int m = gw; m < M; m += NGW) {
                bf16* hr = H + (size_t)m * NPAD; float va[3][8], vb[3][8]; float ama = 0.f, amb = 0.f;
                u32x4 A0[3], A1[3], A2[3], ZA[3], OB[3], ZB[3]; float L0[3], L1[3], L2[3];
#pragma unroll
                for (int j = 0; j < 3; ++j) {
                    const int col = 8 * (lane + 64 * j), hh = col >> 7; const bf16* oa = OA + (size_t)m * WA + col;
                    A0[j] = *(const u32x4*)oa; A1[j] = *(const u32x4*)(oa + OA_STRIDE); A2[j] = *(const u32x4*)(oa + 2 * OA_STRIDE); ZA[j] = *(const u32x4*)(hr + C_ZA + col);
                    OB[j] = *(const u32x4*)(hr + C_QB + col); ZB[j] = *(const u32x4*)(hr + C_ZB + col);
                    L0[j] = LSE[(size_t)m * NH + hh]; L1[j] = LSE[LSE_STRIDE + (size_t)m * NH + hh]; L2[j] = LSE[2 * LSE_STRIDE + (size_t)m * NH + hh]; }
                asm volatile("" ::: "memory");
#pragma unroll
                for (int j = 0; j < 3; ++j) {
                    const float l0 = L0[j], l1 = L1[j], l2 = L2[j];
                    const float mx = fmaxf(l0, fmaxf(l1, l2)); float e0 = __expf(l0 - mx), e1 = __expf(l1 - mx), e2 = __expf(l2 - mx);
                    const float inv = __builtin_amdgcn_rcpf(e0 + e1 + e2); e0 *= inv; e1 *= inv; e2 *= inv;
                    const u32x4 a0 = A0[j], a1 = A1[j], a2 = A2[j], za = ZA[j], ob = OB[j], zb = ZB[j];
#pragma unroll
                    for (int k = 0; k < 4; ++k) { const float zl = bflo(za[k]), zh = bfhi(za[k]), yl = bflo(zb[k]), yh = bfhi(zb[k]);
                        va[j][2 * k] = (e0 * bflo(a0[k]) + e1 * bflo(a1[k]) + e2 * bflo(a2[k])) * zl * __builtin_amdgcn_rcpf(1.f + __expf(-zl));
                        va[j][2 * k + 1] = (e0 * bfhi(a0[k]) + e1 * bfhi(a1[k]) + e2 * bfhi(a2[k])) * zh * __builtin_amdgcn_rcpf(1.f + __expf(-zh));
                        vb[j][2 * k] = bflo(ob[k]) * yl * __builtin_amdgcn_rcpf(1.f + __expf(-yl)); vb[j][2 * k + 1] = bfhi(ob[k]) * yh * __builtin_amdgcn_rcpf(1.f + __expf(-yh));
                        ama = fmaxf(ama, fmaxf(fabsf(va[j][2 * k]), fabsf(va[j][2 * k + 1]))); amb = fmaxf(amb, fmaxf(fabsf(vb[j][2 * k]), fabsf(vb[j][2 * k + 1]))); }
                }
                ama = wave_max(ama); amb = wave_max(amb);
                const float ia = ama > 0.f ? 127.f / ama : 0.f, ib = amb > 0.f ? 127.f / amb : 0.f;
                unsigned char* qa = (unsigned char*)OA + (size_t)m * (2 * WA); unsigned char* qb = (unsigned char*)(hr + C_QB);
#pragma unroll
                for (int j = 0; j < 3; ++j) { const int col = 8 * (lane + 64 * j);
                    unsigned long long pa = (unsigned long long)pack4q(va[j][0] * ia, va[j][1] * ia, va[j][2] * ia, va[j][3] * ia) | ((unsigned long long)pack4q(va[j][4] * ia, va[j][5] * ia, va[j][6] * ia, va[j][7] * ia) << 32);
                    unsigned long long pb = (unsigned long long)pack4q(vb[j][0] * ib, vb[j][1] * ib, vb[j][2] * ib, vb[j][3] * ib) | ((unsigned long long)pack4q(vb[j][4] * ib, vb[j][5] * ib, vb[j][6] * ib, vb[j][7] * ib) << 32);
                    *(unsigned long long*)(qa + col) = pa; *(unsigned long long*)(qb + col) = pb; }
                if (lane == 0) { SC[SC_SAA + m] = ama > 0.f ? ama * (1.f / 127.f) : 1.f; SC[SC_SAB + m] = amb > 0.f ? amb * (1.f / 127.f) : 1.f; }
            }
            SEAM(pb + 3);
        }

        if (IN(pb + 4)) { PH_IDS;
            { pg8::Gemm g{OA, (const bf16*)(WUAQ + (size_t)l * DM * WA), M, DM, WA / 2, WA}; pg8::StaticOrder S; S.init(M, DM, G, bx);
              pg8::EpiGate<false> E{H + C_G, NPAD, b_gate + (size_t)l * 2 * DM, nullptr, MF, DM, SC + SC_SAA, SC + SC_SWUA + l * DM};
              pg8::gemm_phase<pg8::EpiGate<false>, pg8::StaticOrder, true, true, true>((PG8_LAS unsigned char*)lds, g, S, E); }
            { pg8::Gemm g{H + C_QB, (const bf16*)(WUBQ + (size_t)l * DM * WA), M, DM, WA / 2, NPAD}; pg8::StaticOrder S; S.init(M, DM, G, bx);
              pg8::EpiGate<true> E{H + C_G + DM, NPAD, b_gate + (size_t)l * 2 * DM + DM, MF, XB, DM, SC + SC_SAB, SC + SC_SWUB + l * DM};
              pg8::gemm_phase<pg8::EpiGate<true>, pg8::StaticOrder, true, true, true>((PG8_LAS unsigned char*)lds, g, S, E); }
            SEAM(pb + 4);
        }
        if (IN(pb + 5)) { PH_IDS;
            {
                unsigned char* MQ = ws + WS_MF; float* SM = (float*)(ws + WS_SM);
                for (int m = gw; m < M; m += NGW) { u32x4 r4[4]; float amax = 0.f;
#pragma unroll
                    for (int j = 0; j < 4; ++j) { r4[j] = *(const u32x4*)(XB + (size_t)m * DM + 8 * (lane + 64 * j));
#pragma unroll
                        for (int k = 0; k < 4; ++k) amax = fmaxf(amax, fmaxf(fabsf(bflo(r4[j][k])), fabsf(bfhi(r4[j][k])))); }
                    amax = wave_max(amax); const float inv = amax > 0.f ? 127.f / amax : 0.f;
#pragma unroll
                    for (int j = 0; j < 4; ++j) { const unsigned long long p = (unsigned long long)pack4q(bflo(r4[j][0]) * inv, bfhi(r4[j][0]) * inv, bflo(r4[j][1]) * inv, bfhi(r4[j][1]) * inv) |
                            ((unsigned long long)pack4q(bflo(r4[j][2]) * inv, bfhi(r4[j][2]) * inv, bflo(r4[j][3]) * inv, bfhi(r4[j][3]) * inv) << 32);
                        *(unsigned long long*)(MQ + (size_t)m * DM + 8 * (lane + 64 * j)) = p; }
                    if (lane == 0) SM[m] = amax > 0.f ? amax * (1.f / 127.f) : 1.f; }
                if (hi - lo > 1) xcd_barrier(xbar);
            }
            pg8::Gemm g{(const bf16*)(ws + WS_MF), (const bf16*)(ws + WS_WOUT + (size_t)l * DM * DM), M, DM, DM / 2, DM / 2}; pg8::StaticOrder S; S.init(M, DM, G, bx);
            pg8::EpiOut E{l == 0 ? x_in : out, out, DM, ALPHA, l == 0 ? nullptr : (const float*)(ws + WS_STATS), ln_g + (size_t)(l > 0 ? l - 1 : 0) * DM, ln_b + (size_t)(l > 0 ? l - 1 : 0) * DM, (const float*)(ws + WS_SM), SC + SC_SWOUT + l * DM};
            pg8::gemm_phase<pg8::EpiOut, pg8::StaticOrder, true, true, true>((PG8_LAS unsigned char*)lds, g, S, E);
            SEAM(pb + 5);
        }

        if (IN(pb + 6)) { PH_IDS;
            const float* gg = ln_g + (size_t)l * DM; const float* bb = ln_b + (size_t)l * DM;
            const int ln_ = l + 1 < DEPTH ? l + 1 : l; float swf = 1.f, bff = 0.f;
            { const unsigned char* wf = WINQ + (size_t)ln_ * NPAD * DM + (size_t)C_F * DM; (void)wf;
              if (lane < 12) { swf = SC[SC_SWIN + (size_t)ln_ * NPAD + C_F + lane]; bff = b_forget[ln_ * NH + lane]; } }
            for (int m = gw; m < M; m += NGW) {
                float* row = out + (size_t)m * DM; f32x4 v[8]; float s = 0.f;
#pragma unroll
                for (int j = 0; j < 8; ++j) { v[j] = *(const f32x4*)(row + 4 * lane + 256 * j); s += (v[j][0] + v[j][1]) + (v[j][2] + v[j][3]); }
                const float mean = wave_sum(s) * (1.f / DM); float s2 = 0.f;
#pragma unroll
                for (int j = 0; j < 8; ++j) { v[j] = v[j] - mean; s2 += (v[j][0] * v[j][0] + v[j][1] * v[j][1]) + (v[j][2] * v[j][2] + v[j][3] * v[j][3]); }
                const float rstd = 1.f / sqrtf(wave_sum(s2) * (1.f / DM) + LN_EPS);
                const bool lastl = l == DEPTH - 1;
#pragma unroll
                for (int j = 0; j < 8; ++j) { const int c = 4 * lane + 256 * j; const f32x4 gv = *(const f32x4*)(gg + c), bv = *(const f32x4*)(bb + c);
                    v[j] = v[j] * rstd * gv + bv; if (lastl) *(f32x4*)(row + c) = v[j]; }
                if (!lastl) { if (lane == 0) { float* st = (float*)(ws + WS_STATS) + 2 * (size_t)m; st[0] = mean; st[1] = rstd; }
                    unsigned q[8]; const float sxr = quant_row_q(v, XQ + (size_t)m * DM, SC + SC_SX + m, lane, q);
                    float zsel = 0.f;
#define lsig_(z_) ([](float z) { return fminf(z, 0.f) - __logf(1.f + __expf(-fabsf(z))); }(z_))
#pragma unroll
                    for (int h = 0; h < 12; ++h) { int a = 0; const unsigned char* wfh = WINQ + (size_t)ln_ * NPAD * DM + (size_t)(C_F + h) * DM + 4 * lane;
#pragma unroll
                        for (int j = 0; j < 8; ++j) a = __builtin_amdgcn_sdot4((int)q[j], *(const int*)(wfh + 256 * j), a, false);
#pragma unroll
                        for (int o = 1; o < 64; o <<= 1) a += __shfl_xor(a, o);
                        if (lane == h) zsel = (float)a; }
                    if (lane < 12) LOGF[((size_t)(m >> 13) * NH + lane) * SEQ + (m & 8191)] = lsig_(zsel * sxr * swf + bff); }
            }
            SEAM(pb + 6);
        }
    }
#undef IN
#undef SEAM
}

extern "C" void kernel_launch(void* const* d_in, const int* in_sizes, int n_in, void* d_out, int out_size, void* d_ws, size_t ws_size, hipStream_t stream) {
    static int grid = 0;
    if (grid == 0) {
        if (n_in != 9 || in_sizes[0] != M * DM || out_size != M * DM || ws_size < WS_END) { fprintf(stderr, "kernel_launch: unexpected shapes / workspace (n_in %d, ws %zu)\n", n_in, ws_size); grid = -1; return; }
        int dev = 0, cus = 0, per_cu = 0;
        (void)hipGetDevice(&dev); (void)hipDeviceGetAttribute(&cus, hipDeviceAttributeMultiprocessorCount, dev);
        if (hipFuncSetAttribute((const void*)mega_fwd, hipFuncAttributeMaxDynamicSharedMemorySize, LDS_BYTES) != hipSuccess) { fprintf(stderr, "kernel_launch: hipFuncSetAttribute failed\n"); grid = -1; return; }
        if (hipOccupancyMaxActiveBlocksPerMultiprocessor(&per_cu, (const void*)mega_fwd, 512, LDS_BYTES) != hipSuccess || per_cu < 1) { fprintf(stderr, "kernel_launch: occupancy query says %d\n", per_cu); per_cu = 1; }
        (void)hipGetLastError();
        if (cus <= 0) cus = 256;
        grid = cus * per_cu;
    }
    if (grid < 0) return;
    if (hipMemsetAsync((char*)d_ws + WS_BAR, 0, XCD_BAR_WORDS * 4, stream) != hipSuccess) { fprintf(stderr, "kernel_launch: hipMemsetAsync of the barrier words failed\n"); return; }
    Args a{};
    for (int i = 0; i < 9; ++i) a.in[i] = (const float*)d_in[i];
    a.out = (float*)d_out; a.ws = (unsigned char*)d_ws;
    a.ph_lo = 0; a.ph_hi = NPH;
    void* kargs[] = {&a};
    hipError_t e = hipLaunchCooperativeKernel((const void*)mega_fwd, dim3(grid), dim3(512), kargs, LDS_BYTES, stream);
    if (e != hipSuccess) fprintf(stderr, "kernel_launch: cooperative launch failed: %s (grid %d)\n", hipGetErrorString(e), grid);
}
```

```cpp
#include <hip/hip_runtime.h>
#include <hip/hip_cooperative_groups.h>
#include <cstdio>
#include <cstdint>
namespace cg = cooperative_groups;
namespace pg8 {
#define PG8_LAS __attribute__((address_space(3)))
typedef unsigned short bf16_t;
typedef short bf16x8 __attribute__((ext_vector_type(8)));
typedef float f32x4 __attribute__((ext_vector_type(4)));
typedef unsigned u32x4 __attribute__((ext_vector_type(4)));
constexpr int BM = 256, BK = 64, HALF = 128, HTB = HALF * BK * 2  , STAGE_BYTES = 8 * HTB, NXCD = 8, WGM = 2;

__host__ __device__ __forceinline__ int lds_byte(int r, int c) { const int st = (r >> 4) * 2 + (c >> 5), rr = r & 15, cc = c & 31, ob = rr * 64 + cc * 2; return st * 1024 + (ob ^ (((ob >> 9) & 1) << 5)); }
__host__ __device__ __forceinline__ void stage_rc(int b, int& R, int& C) { const int st = b / 1024, sb = b % 1024, swz = sb ^ (((sb >> 9) & 1) << 5); R = (st >> 1) * 16 + swz / 64; C = (st & 1) * 32 + (swz % 64) / 2; }
__host__ __device__ __forceinline__ int perm32(int rho) { const int n = rho >> 4, i = rho & 15; return 8 * (i >> 2) + 4 * n + (i & 3); }

struct Unit { int pm, pn; };
struct Gemm { const bf16_t* A; const bf16_t* Bt; int M, N, K, lda; };

struct StaticOrder {
    int nM, nN, nwg, G, c;
    __host__ __device__ void init(int M, int N, int G_, int c_) { nM = M / BM; nN = N / BM; nwg = nM * nN; G = G_; c = c_; }
    __host__ __device__ bool next(int i, Unit& u) const {
        const long L = (long)i * G + c; if (L >= nwg) return false;
        int wgid = (int)L; { const int q = nwg / NXCD, r = nwg % NXCD, xcd = wgid % NXCD, off = wgid / NXCD; wgid = (xcd < r ? xcd * (q + 1) : r * (q + 1) + (xcd - r) * q) + off; }
        const int nig = WGM * nN, gid = wgid / nig, fm = gid * WGM, gsz = (nM - fm) < WGM ? (nM - fm) : WGM;
        u.pm = fm + ((wgid % nig) % gsz); u.pn = (wgid % nig) / gsz; return true;
    }
    __device__ __forceinline__ void a_ready(const Unit&) const {}
    __device__ __forceinline__ void done(const Unit&) const {}
};

__device__ __forceinline__ unsigned cvt_pk_bf16(float lo, float hi) { unsigned r; asm volatile("v_cvt_pk_bf16_f32 %0, %1, %2" : "=v"(r) : "v"(lo), "v"(hi)); return r; }
typedef float f32x2 __attribute__((ext_vector_type(2)));
typedef unsigned u32x2 __attribute__((ext_vector_type(2)));
typedef int i32x4 __attribute__((ext_vector_type(4)));
template <bool I8> struct AccSel { typedef f32x4 type; };
template <> struct AccSel<true> { typedef i32x4 type; };
__device__ __forceinline__ f32x4 cvt4(i32x4 a, float s) { return (f32x4){(float)a[0] * s, (float)a[1] * s, (float)a[2] * s, (float)a[3] * s}; }
__device__ __forceinline__ float bf_lo(unsigned w) { return __uint_as_float(w << 16); }
__device__ __forceinline__ float bf_hi(unsigned w) { return __uint_as_float(w & 0xffff0000u); }
__device__ __forceinline__ float sigm(float z) { return __builtin_amdgcn_rcpf(1.f + __builtin_amdgcn_exp2f(-1.4426950408889634f * z)); }
__device__ __forceinline__ float logsig(float z) { return fminf(z, 0.f) - log1pf(expf(-fabsf(z))); }

struct EpiIn {
    static constexpr bool PERM = true, AFTER_DRAIN = false;
    bf16_t* H; int ldh; const float* cosT; const float* sinT; float* logf; const float* bfg; const float* sx; const float* sw; float* pn2;
    __device__ __forceinline__ void operator()(const i32x4 (&acc)[2][2][4][2], const Unit& u, int wr, int wc, int fr, int fq) const {
        asm volatile("" : "+v"(fr), "+v"(fq));
        const int row0 = u.pm * BM + wr * 64 + fr;
        if (u.pn == 64) {
            if (wc == 0 && fq < 2) {
                const f32x4 b0 = *(const f32x4*)(bfg + 8 * fq); const f32x4 b1 = fq == 0 ? *(const f32x4*)(bfg + 4) : (f32x4){0.f, 0.f, 0.f, 0.f};
                const f32x4 w0 = *(const f32x4*)(sw + u.pn * BM + 8 * fq), w1 = *(const f32x4*)(sw + u.pn * BM + 8 * fq + 4);
#pragma unroll
                for (int ai = 0; ai < 2; ++ai)
#pragma unroll
                    for (int m = 0; m < 4; ++m) { const int row = row0 + ai * HALF + m * 16; const float sr = sx[row];
                        float* o = logf + ((size_t)(row >> 13) * 12 + 8 * fq) * 8192 + (row & 8191);
                        const f32x4 v0 = cvt4(acc[ai][0][m][0], sr) * w0 + b0; o[0] = logsig(v0[0]); o[8192] = logsig(v0[1]); o[2 * 8192] = logsig(v0[2]); o[3 * 8192] = logsig(v0[3]);
                        if (fq == 0) { const f32x4 v1 = cvt4(acc[ai][0][m][1], sr) * w1 + b1; o[4 * 8192] = logsig(v1[0]); o[5 * 8192] = logsig(v1[1]); o[6 * 8192] = logsig(v1[2]); o[7 * 8192] = logsig(v1[3]); } }
            }
            return;
        }
        const bool rope = u.pn < 12, nrm = u.pn >= 24 && u.pn < 36;
        const int i0 = 16 * wc + 4 * fq;
#pragma unroll
        for (int bj = 0; bj < 2; ++bj) { const int col0 = u.pn * BM + bj * HALF + wc * 32 + 8 * fq;
            const f32x4 w0 = *(const f32x4*)(sw + col0), w1 = *(const f32x4*)(sw + col0 + 4);
#pragma unroll
            for (int ai = 0; ai < 2; ++ai)
#pragma unroll
                for (int m = 0; m < 4; ++m) { const int row = row0 + ai * HALF + m * 16; const float sr = sx[row];
                    f32x4 v0 = cvt4(acc[ai][bj][m][0], sr) * w0, v1 = cvt4(acc[ai][bj][m][1], sr) * w1;
                    if (rope) { const int pos = row & 8191; const f32x4 c = *(const f32x4*)(cosT + pos * 64 + i0), s = *(const f32x4*)(sinT + pos * 64 + i0);
                        const f32x4 o0 = v0 * c - v1 * s, o1 = v0 * s + v1 * c; v0 = o0; v1 = o1; }
                    if (nrm) { float s2 = (v0[0] * v0[0] + v0[1] * v0[1]) + (v0[2] * v0[2] + v0[3] * v0[3]) + (v1[0] * v1[0] + v1[1] * v1[1]) + (v1[2] * v1[2] + v1[3] * v1[3]);
                        s2 += __shfl_xor(s2, 16); s2 += __shfl_xor(s2, 32);
                        if (fq == 0) pn2[((size_t)row * 24 + (u.pn - 24) * 2 + bj) * 4 + wc] = s2; }
                    u32x4 w; w.x = cvt_pk_bf16(v0[0], v0[1]); w.y = cvt_pk_bf16(v0[2], v0[3]); w.z = cvt_pk_bf16(v1[0], v1[1]); w.w = cvt_pk_bf16(v1[2], v1[3]);
                    *(u32x4*)(H + (size_t)row * ldh + col0) = w; } }
    }
};
template <bool ADD> struct EpiGate {
    static constexpr bool PERM = true, AFTER_DRAIN = false; static constexpr int NB = 2;
    const bf16_t* Hg; int ldh; const float* bg; const bf16_t* Mf; bf16_t* O; int ldo; const float* sa; const float* sb;
    __device__ __forceinline__ void operator()(const i32x4 (&acc)[2][2][4][2], const Unit& u, int wr, int wc, int fr, int fq) const {
        asm volatile("" : "+v"(fr), "+v"(fq));
        const int row0 = u.pm * BM + wr * 64 + fr;
#pragma unroll
        for (int bj = 0; bj < 2; ++bj) { const int col0 = u.pn * BM + bj * HALF + wc * 32 + 8 * fq;
            const f32x4 g0 = *(const f32x4*)(bg + col0), g1 = *(const f32x4*)(bg + col0 + 4), w0 = *(const f32x4*)(sb + col0), w1 = *(const f32x4*)(sb + col0 + 4);
#pragma unroll
            for (int ai = 0; ai < 2; ++ai)
#pragma unroll
              for (int mb = 0; mb < 4; mb += NB) {
                u32x4 gl[NB], pm[NB]; float sr[NB];
#pragma unroll
                for (int q = 0; q < NB; ++q) { const int row = row0 + ai * HALF + (mb + q) * 16;
                    gl[q] = *(const u32x4*)(Hg + (size_t)row * ldh + col0); if (ADD) pm[q] = *(const u32x4*)(Mf + (size_t)row * ldo + col0); sr[q] = sa[row]; }
                asm volatile("" ::: "memory");
#pragma unroll
                for (int q = 0; q < NB; ++q) { const int m = mb + q; const int row = row0 + ai * HALF + m * 16;
                    f32x4 v0 = cvt4(acc[ai][bj][m][0], sr[q]) * w0, v1 = cvt4(acc[ai][bj][m][1], sr[q]) * w1;
                    v0[0] *= sigm(bf_lo(gl[q].x) + g0[0]); v0[1] *= sigm(bf_hi(gl[q].x) + g0[1]); v0[2] *= sigm(bf_lo(gl[q].y) + g0[2]); v0[3] *= sigm(bf_hi(gl[q].y) + g0[3]);
                    v1[0] *= sigm(bf_lo(gl[q].z) + g1[0]); v1[1] *= sigm(bf_hi(gl[q].z) + g1[1]); v1[2] *= sigm(bf_lo(gl[q].w) + g1[2]); v1[3] *= sigm(bf_hi(gl[q].w) + g1[3]);
                    if (ADD) { v0[0] += bf_lo(pm[q].x); v0[1] += bf_hi(pm[q].x); v0[2] += bf_lo(pm[q].y); v0[3] += bf_hi(pm[q].y); v1[0] += bf_lo(pm[q].z); v1[1] += bf_hi(pm[q].z); v1[2] += bf_lo(pm[q].w); v1[3] += bf_hi(pm[q].w); }
                    u32x4 w; w.x = cvt_pk_bf16(v0[0], v0[1]); w.y = cvt_pk_bf16(v0[2], v0[3]); w.z = cvt_pk_bf16(v1[0], v1[1]); w.w = cvt_pk_bf16(v1[2], v1[3]);
                    *(u32x4*)(O + (size_t)row * ldo + col0) = w; }
                asm volatile("" ::: "memory"); } }
    }
};
struct EpiOut {
    static constexpr bool PERM = false, AFTER_DRAIN = false;
    const float* X; float* T; int ldc; float alpha; const float* stats; const float* lg; const float* lb; const float* sa; const float* sb;
    __device__ __forceinline__ void operator()(const i32x4 (&acc)[2][2][4][2], const Unit& u, int wr, int wc, int fr, int fq) const {
        asm volatile("" : "+v"(fr), "+v"(fq));
        const int row0 = u.pm * BM + wr * 64 + fr, col0 = u.pn * BM + wc * 32 + 4 * fq;
#pragma unroll
        for (int ai = 0; ai < 2; ++ai)
#pragma unroll
            for (int mp = 0; mp < 4; mp += 2) { f32x4 xv0[2][2], xv1[2][2]; float mu0 = 0.f, mu1 = 0.f, rs0 = 1.f, rs1 = 1.f;
                const int rowa = row0 + ai * HALF + mp * 16, rowb = rowa + 16; const size_t offa = (size_t)rowa * ldc + col0, offb = (size_t)rowb * ldc + col0;
                if (stats) { mu0 = stats[2 * rowa]; rs0 = stats[2 * rowa + 1]; mu1 = stats[2 * rowb]; rs1 = stats[2 * rowb + 1]; }
                const float sra = sa[rowa], srb = sa[rowb];
#pragma unroll
                for (int bj = 0; bj < 2; ++bj)
#pragma unroll
                    for (int n = 0; n < 2; ++n) { xv0[bj][n] = *(const f32x4*)(X + offa + bj * HALF + n * 16); xv1[bj][n] = *(const f32x4*)(X + offb + bj * HALF + n * 16); }
                asm volatile("" ::: "memory");
#pragma unroll
                for (int bj = 0; bj < 2; ++bj)
#pragma unroll
                    for (int n = 0; n < 2; ++n) { f32x4 xa = xv0[bj][n], xb = xv1[bj][n];
                        if (stats) { const f32x4 gv = *(const f32x4*)(lg + col0 + bj * HALF + n * 16), bv = *(const f32x4*)(lb + col0 + bj * HALF + n * 16);
                            xa = (xa - mu0) * rs0 * gv + bv; xb = (xb - mu1) * rs1 * gv + bv; }
                        const f32x4 wv = *(const f32x4*)(sb + col0 + bj * HALF + n * 16);
                        *(f32x4*)(T + offa + bj * HALF + n * 16) = xa * alpha + cvt4(acc[ai][bj][mp][n], sra) * wv;
                        *(f32x4*)(T + offb + bj * HALF + n * 16) = xb * alpha + cvt4(acc[ai][bj][mp + 1][n], srb) * wv; }
                asm volatile("" ::: "memory"); }
    }
};
template <class Epi, class Sched, bool ALIGN_EPI = false, bool SP2 = false, bool I8 = false>
__device__ __forceinline__ void gemm_phase(PG8_LAS unsigned char* lds, const Gemm g, const Sched& S, const Epi& E) {
    int tid = threadIdx.x; asm volatile("" : "+v"(tid));
    const int wid = __builtin_amdgcn_readfirstlane(tid >> 6), lane = tid & 63, wr = wid >> 2, wc = wid & 3, fr = lane & 15, fq = lane >> 4;
    const int K = g.K, nt = K / BK;
    unsigned voffA[2], voffB[2];
#pragma unroll
    for (int i = 0; i < 2; ++i) { int R, C; stage_rc(tid * 16 + i * 8192, R, C); const int Rb = Epi::PERM ? ((R & ~31) + perm32(R & 31)) : R;
        voffA[i] = (unsigned)(R * g.lda + C) * 2u; voffB[i] = (unsigned)(Rb * K + C) * 2u; }
    const size_t kstep = (size_t)(BK * 2);
    const size_t hstepA = (size_t)HALF * g.lda * 2, hstepB = (size_t)HALF * K * 2;
    const size_t tstepA = 2 * hstepA, tstepB = 2 * hstepB;
    const unsigned ldsw = (unsigned)wid * 1024u;
    const int aoff = lds_byte(wr * 64 + fr, fq * 8), boff = lds_byte(wc * 32 + fr, fq * 8);
#define PG8_SA(b, h) (((b) * 2 + (h)) * HTB)
#define PG8_SB(b, h) ((4 + (b) * 2 + (h)) * HTB)
#define PG8_STAGE(bufoff, gbase, voff) do { _Pragma("unroll") for (int _i = 0; _i < 2; ++_i) \
        __builtin_amdgcn_global_load_lds((const unsigned*)((const char*)(gbase) + (voff)[_i]), (PG8_LAS unsigned*)(lds + (bufoff) + ldsw + _i * 8192), 16, 0, 0); } while (0)
#define PG8_LDA(dst, b, h) do { _Pragma("unroll") for (int m = 0; m < 4; ++m) _Pragma("unroll") for (int k = 0; k < 2; ++k) dst[m][k] = *(const PG8_LAS bf16x8*)(lds + PG8_SA(b, h) + aoff + m * 2048 + k * 1024); } while (0)
#define PG8_LDB(dst, b, h) do { _Pragma("unroll") for (int n = 0; n < 2; ++n) _Pragma("unroll") for (int k = 0; k < 2; ++k) dst[n][k] = *(const PG8_LAS bf16x8*)(lds + PG8_SB(b, h) + boff + n * 2048 + k * 1024); } while (0)
#define PG8_MMA(ai, bj, At, Bt) do { __builtin_amdgcn_s_setprio(1); _Pragma("unroll") for (int m = 0; m < 4; ++m) _Pragma("unroll") for (int n = 0; n < 2; ++n) _Pragma("unroll") for (int k = 0; k < 2; ++k) \
        { if constexpr (I8) acc[ai][bj][m][n] = __builtin_amdgcn_mfma_i32_16x16x64_i8(__builtin_bit_cast(i32x4, Bt[n][k]), __builtin_bit_cast(i32x4, At[m][k]), acc[ai][bj][m][n], 0, 0, 0); \
          else acc[ai][bj][m][n] = __builtin_amdgcn_mfma_f32_16x16x32_bf16(Bt[n][k], At[m][k], acc[ai][bj][m][n], 0, 0, 0); } __builtin_amdgcn_s_setprio(0); } while (0)
#define PG8_WAIT_V(n) asm volatile("s_waitcnt vmcnt(" #n ")" ::: "memory")
#define PG8_WAIT_L(n) asm volatile("s_waitcnt lgkmcnt(" #n ")" ::: "memory")
#define PG8_BAR __builtin_amdgcn_s_barrier()
#define PG8_SCHED __builtin_amdgcn_sched_barrier(0)
    Unit cur, nxt; int ui = 0;
    if (!S.next(0, cur)) return;
    typedef typename AccSel<I8>::type AccT; AccT acc[2][2][4][2];
#pragma unroll
    for (int a = 0; a < 2; ++a)
#pragma unroll
        for (int b = 0; b < 2; ++b)
#pragma unroll
            for (int m = 0; m < 4; ++m)
#pragma unroll
                for (int n = 0; n < 2; ++n) acc[a][b][m][n] = AccT{};
    bf16x8 At[4][2], B0[2][2], B1[2][2];
    const char* cA = (const char*)g.A + (size_t)cur.pm * tstepA; const char* cB = (const char*)g.Bt + (size_t)cur.pn * tstepB;
    S.a_ready(cur);
    if constexpr (SP2) {
        PG8_STAGE(PG8_SB(0, 0), cB, voffB); PG8_STAGE(PG8_SB(0, 1), cB + hstepB, voffB); PG8_STAGE(PG8_SA(0, 0), cA, voffA); PG8_STAGE(PG8_SA(0, 1), cA + hstepA, voffA);
        if (wr == 1) PG8_BAR;
        PG8_WAIT_V(2); PG8_BAR;
        PG8_STAGE(PG8_SB(1, 0), cB + kstep, voffB); PG8_STAGE(PG8_SA(1, 0), cA + kstep, voffA); PG8_STAGE(PG8_SB(1, 1), cB + hstepB + kstep, voffB);
        PG8_WAIT_V(6); PG8_BAR;
    } else {
        PG8_STAGE(PG8_SB(0, 0), cB, voffB); PG8_STAGE(PG8_SA(0, 0), cA, voffA); PG8_STAGE(PG8_SB(0, 1), cB + hstepB, voffB); PG8_STAGE(PG8_SA(0, 1), cA + hstepA, voffA);
        if (wr == 1) PG8_BAR;
        PG8_WAIT_V(4); PG8_BAR;
        PG8_STAGE(PG8_SB(1, 0), cB + kstep, voffB); PG8_STAGE(PG8_SA(1, 0), cA + kstep, voffA); PG8_STAGE(PG8_SB(1, 1), cB + hstepB + kstep, voffB);
        PG8_WAIT_V(6); PG8_BAR;
    }
    for (;;) {
        const bool has_next = S.next(ui + 1, nxt);
        const char* nA = has_next ? (const char*)g.A + (size_t)nxt.pm * tstepA : cA; const char* nB = has_next ? (const char*)g.Bt + (size_t)nxt.pn * tstepB : cB;
        for (int t = 0; t < nt; t += 2) {
            const bool last = (t == nt - 2);
            const char* a1 = cA + (size_t)(t + 1) * kstep;
            const char* a2 = last ? nA : cA + (size_t)(t + 2) * kstep; const char* b2 = last ? nB : cB + (size_t)(t + 2) * kstep;
            const char* a3 = a2 + kstep; const char* b3 = b2 + kstep;
            if (last && has_next) S.a_ready(nxt);
            if constexpr (SP2) {
            PG8_LDB(B0, 0, 0); PG8_LDB(B1, 0, 1); PG8_SCHED; PG8_LDA(At, 0, 0); PG8_STAGE(PG8_SA(1, 1), a1 + hstepA, voffA);
            PG8_WAIT_V(8); PG8_WAIT_L(0); PG8_BAR; PG8_MMA(0, 0, At, B0); PG8_MMA(0, 1, At, B1); PG8_BAR; PG8_SCHED;
            PG8_LDA(At, 0, 1); PG8_STAGE(PG8_SB(0, 0), b2, voffB); PG8_STAGE(PG8_SB(0, 1), b2 + hstepB, voffB); PG8_STAGE(PG8_SA(0, 0), a2, voffA);
            PG8_WAIT_V(8); PG8_WAIT_L(0); PG8_BAR; PG8_MMA(1, 0, At, B0); PG8_MMA(1, 1, At, B1); PG8_BAR; PG8_SCHED;
            PG8_LDB(B0, 1, 0); PG8_LDB(B1, 1, 1); PG8_SCHED; PG8_LDA(At, 1, 0); PG8_STAGE(PG8_SA(0, 1), a2 + hstepA, voffA);
            PG8_WAIT_V(8); PG8_WAIT_L(0); PG8_BAR; PG8_MMA(0, 0, At, B0); PG8_MMA(0, 1, At, B1); PG8_BAR; PG8_SCHED;
            PG8_LDA(At, 1, 1); PG8_STAGE(PG8_SB(1, 0), b3, voffB); PG8_STAGE(PG8_SB(1, 1), b3 + hstepB, voffB); PG8_STAGE(PG8_SA(1, 0), a3, voffA);
            PG8_WAIT_V(8); PG8_WAIT_L(0); PG8_BAR; PG8_MMA(1, 0, At, B0); PG8_MMA(1, 1, At, B1); PG8_BAR; PG8_SCHED;
            } else {
            PG8_LDB(B0, 0, 0); PG8_SCHED; PG8_LDA(At, 0, 0); PG8_STAGE(PG8_SA(1, 1), a1 + hstepA, voffA);
            PG8_WAIT_L(8); PG8_BAR; PG8_WAIT_L(0); PG8_MMA(0, 0, At, B0); PG8_BAR; PG8_SCHED;
            PG8_LDB(B1, 0, 1); PG8_STAGE(PG8_SB(0, 0), b2, voffB);
            PG8_BAR; PG8_WAIT_L(0); PG8_MMA(0, 1, At, B1); PG8_BAR;
            PG8_LDA(At, 0, 1); PG8_STAGE(PG8_SA(0, 0), a2, voffA);
            PG8_BAR; PG8_WAIT_L(0); PG8_MMA(1, 0, At, B0); PG8_BAR; PG8_SCHED;
            PG8_STAGE(PG8_SB(0, 1), b2 + hstepB, voffB);
            PG8_WAIT_V(6); PG8_BAR; PG8_MMA(1, 1, At, B1); PG8_BAR;
            PG8_LDB(B0, 1, 0); PG8_SCHED; PG8_LDA(At, 1, 0); PG8_STAGE(PG8_SA(0, 1), a2 + hstepA, voffA);
            PG8_WAIT_L(8); PG8_BAR; PG8_WAIT_L(0); PG8_MMA(0, 0, At, B0); PG8_BAR; PG8_SCHED;
            PG8_LDB(B1, 1, 1); PG8_STAGE(PG8_SB(1, 0), b3, voffB);
            PG8_BAR; PG8_WAIT_L(0); PG8_MMA(0, 1, At, B1); PG8_BAR;
            PG8_LDA(At, 1, 1); PG8_STAGE(PG8_SA(1, 0), a3, voffA);
            PG8_BAR; PG8_WAIT_L(0); PG8_MMA(1, 0, At, B0); PG8_BAR; PG8_SCHED;
            PG8_STAGE(PG8_SB(1, 1), b3 + hstepB, voffB);
            PG8_WAIT_V(6); PG8_BAR; PG8_MMA(1, 1, At, B1); PG8_BAR;
            }
        }
        if constexpr (ALIGN_EPI) { if (wr == 0) PG8_BAR; }
        if constexpr (!Epi::AFTER_DRAIN) { E(acc, cur, wr, wc, fr, fq); S.done(cur); }
        if (!has_next) break;
#pragma unroll
        for (int a = 0; a < 2; ++a)
#pragma unroll
            for (int b = 0; b < 2; ++b)
#pragma unroll
                for (int m = 0; m < 4; ++m)
#pragma unroll
                    for (int n = 0; n < 2; ++n) acc[a][b][m][n] = AccT{};
        cur = nxt; cA = nA; cB = nB; ++ui;
        if constexpr (ALIGN_EPI) { if (wr == 1) PG8_BAR; }
    }
    PG8_WAIT_V(0);
    if constexpr (!ALIGN_EPI) { if (wr == 0) PG8_BAR; }
    PG8_BAR;
    if constexpr (Epi::AFTER_DRAIN) { E.fused(acc, cur, wr, wc, fr, fq, lds, wid, lane); S.done(cur); }
#undef PG8_SA
#undef PG8_SB
#undef PG8_STAGE
#undef PG8_LDA
#undef PG8_LDB
#undef PG8_MMA
#undef PG8_WAIT_V
#undef PG8_WAIT_L
#undef PG8_BAR
#undef PG8_SCHED
}
}
namespace at {
typedef unsigned short bf16;
typedef short bf16x8 __attribute__((ext_vector_type(8)));
typedef short s16x4 __attribute__((ext_vector_type(4)));
typedef float f32x16 __attribute__((ext_vector_type(16)));
typedef float f32x4 __attribute__((ext_vector_type(4)));
typedef unsigned u32x4 __attribute__((ext_vector_type(4)));
constexpr int D = 128;
constexpr float SCALE = 0.08838834764831845f, INV_SCALE = 11.313708498984761f, THR = 8.f;
constexpr int NW = 8, QBLK = 32, KVBLK = 64, QB = NW * QBLK;
constexpr int SHM_V = KVBLK * D * 2, SHM_K = KVBLK * D * 2;
constexpr int LDS_ATT = 2 * SHM_V + 2 * SHM_K + NW * 64 * 4;
constexpr int BIAS_OFF = LDS_ATT, JLW_OFF = BIAS_OFF + 8192 * 4, LDS_TOTAL = JLW_OFF + 16;

#define KSWZ(row, colB) ((row) * 256 + ((colB) ^ (((row) & 7) << 4)))
#define SBAR() __builtin_amdgcn_sched_barrier(0)
#define LBAR() do { asm volatile("s_waitcnt lgkmcnt(0)" ::: "memory"); __builtin_amdgcn_s_barrier(); asm volatile("" ::: "memory"); } while (0)
__device__ __forceinline__ int v_st(int k, int c) { const int kk = (k & ~0xC) | ((k & 4) << 1) | ((k & 8) >> 1); return ((kk >> 3) * 4 + (c >> 5)) * 512 + ((kk & 7) * 32 + (c & 31)) * 2; }
__device__ __forceinline__ int v_rd_base(int lane) { return ((lane & 3) << 3) | (((lane >> 2) & 3) << 6) | (((lane >> 4) & 1) << 5) | (((lane >> 5) & 1) << 8); }
constexpr int v_rd_off(int d0, int ks, int half) { return d0 * 512 + ks * 4096 + half * 2048; }
__device__ __forceinline__ int crow(int r, int hi) { return (r & 3) + 8 * (r >> 2) + 4 * hi; }
__device__ __forceinline__ unsigned cvtpk(float lo, float hi) { unsigned r; asm volatile("v_cvt_pk_bf16_f32 %0, %1, %2" : "=v"(r) : "v"(lo), "v"(hi)); return r; }
__device__ __forceinline__ bf16x8 load8(const bf16* p) { return *reinterpret_cast<const bf16x8*>(p); }
__device__ __forceinline__ void mask_tile(f32x16& p0, f32x16& p1, int dq, unsigned W) {
    const float NEG = -__builtin_inff();
#pragma unroll
    for (int r = 0; r < 16; ++r) {
        const int c = (r & 3) + 8 * (r >> 2);
        if ((unsigned)(dq - c) >= W) p0[r] = NEG;
        if ((unsigned)(dq - c - 32) >= W) p1[r] = NEG;
    }
}
__device__ __forceinline__ void partialSM(f32x16& p0, f32x16& p1, float& m_reg, float& mn, float& alpha) {
    float pmax = p0[0]; for (int r = 1; r < 16; ++r) pmax = fmaxf(pmax, p0[r]); for (int r = 0; r < 16; ++r) pmax = fmaxf(pmax, p1[r]);
    { auto rr = __builtin_amdgcn_permlane32_swap(__float_as_uint(pmax), __float_as_uint(pmax), false, false);
      pmax = fmaxf(__uint_as_float(rr[0]), __uint_as_float(rr[1])); }
    constexpr float C2 = 1.4426950408889634f * SCALE;
    if (__builtin_expect(__all((pmax - m_reg) * SCALE <= THR), 1)) { mn = m_reg; alpha = 1.f; }
    else { mn = fmaxf(m_reg, pmax); alpha = __builtin_amdgcn_exp2f((m_reg - mn) * C2); m_reg = mn; }
    const float mnL = -mn * C2;
    for (int r = 0; r < 16; ++r) p0[r] = fmaf(p0[r], C2, mnL); for (int r = 0; r < 16; ++r) p1[r] = fmaf(p1[r], C2, mnL);
    for (int r = 0; r < 16; ++r) p0[r] = __builtin_amdgcn_exp2f(p0[r]);
}
__device__ __forceinline__ void finishSM(f32x16& p0, f32x16& p1, float alpha, float& l_reg, bf16x8& pa0, bf16x8& pa1, bf16x8& pa2, bf16x8& pa3) {
    for (int r = 0; r < 16; ++r) p1[r] = __builtin_amdgcn_exp2f(p1[r]);
    float ps = 0; for (int r = 0; r < 16; ++r) ps += p0[r]; for (int r = 0; r < 16; ++r) ps += p1[r];
    { auto rr = __builtin_amdgcn_permlane32_swap(__float_as_uint(ps), __float_as_uint(ps), false, false);
      ps = __uint_as_float(rr[0]) + __uint_as_float(rr[1]); }
    l_reg = l_reg * alpha + ps;
#define PK4(P, B_, OUT) do { unsigned a0 = cvtpk(P[B_+0], P[B_+1]), a1 = cvtpk(P[B_+2], P[B_+3]);                          \
        unsigned b0 = cvtpk(P[B_+4], P[B_+5]), b1 = cvtpk(P[B_+6], P[B_+7]);                                             \
        auto r0 = __builtin_amdgcn_permlane32_swap(a0, b0, false, false); auto r1 = __builtin_amdgcn_permlane32_swap(a1, b1, false, false); \
        u32x4 w = {r0[0], r1[0], r0[1], r1[1]}; OUT = *reinterpret_cast<bf16x8*>(&w); } while (0)
    PK4(p0, 0, pa0); PK4(p0, 8, pa1); PK4(p1, 0, pa2); PK4(p1, 8, pa3);
#undef PK4
}
template <int KB, bool SK>
__device__ __forceinline__ void qkt(f32x16& p0, f32x16& p1, const char* K_lds, int r32, int hi, const bf16x8* qr, bool act) {
    if (SK && !act) { const float NEG = -__builtin_inff();
#pragma unroll
        for (int r = 0; r < 16; ++r) { p0[r] = NEG; p1[r] = NEG; } return; }
    p0 = f32x16{}; p1 = f32x16{};
    const char* kb[4];
#pragma unroll
    for (int dd = 0; dd < 4; ++dd) kb[dd] = K_lds + KB * SHM_K + KSWZ(r32, (dd * 16 + hi * 8) * 2);
#pragma unroll
    for (int d0 = 0; d0 < 8; ++d0) { const char* a = kb[d0 & 3] + (d0 >> 2) * 128;
        bf16x8 b0 = *reinterpret_cast<const bf16x8*>(a);
        bf16x8 b1 = *reinterpret_cast<const bf16x8*>(a + 32 * 256);
        p0 = __builtin_amdgcn_mfma_f32_32x32x16_bf16(b0, qr[d0], p0, 0, 0, 0);
        p1 = __builtin_amdgcn_mfma_f32_32x32x16_bf16(b1, qr[d0], p1, 0, 0, 0); }
}
template <int VB, bool SK>
__device__ __forceinline__ void pv_tile(f32x16* o, int vb0, bf16x8 pa0, bf16x8 pa1, bf16x8 pa2, bf16x8 pa3, bool act) {
    if (SK && !act) return;
#define TRRD(dst, off) asm volatile("ds_read_b64_tr_b16 %0, %1 offset:%2" : "=&v"(dst) : "v"(vb0), "i"(off) : "memory")
#define PV_D0(d0) do { s16x4 l0, l1, l2, l3, h0, h1, h2, h3; constexpr int b_ = VB * SHM_V + v_rd_off(d0, 0, 0); \
        TRRD(l0, b_); TRRD(h0, b_ + 2048); TRRD(l1, b_ + 4096); TRRD(h1, b_ + 6144); TRRD(l2, b_ + 8192); TRRD(h2, b_ + 10240); TRRD(l3, b_ + 12288); TRRD(h3, b_ + 14336); \
        asm volatile("s_waitcnt lgkmcnt(0)" ::: "memory"); SBAR();   \
        o[d0] = __builtin_amdgcn_mfma_f32_32x32x16_bf16(pa0, (bf16x8){l0[0], l0[1], l0[2], l0[3], h0[0], h0[1], h0[2], h0[3]}, o[d0], 0, 0, 0);   \
        o[d0] = __builtin_amdgcn_mfma_f32_32x32x16_bf16(pa1, (bf16x8){l1[0], l1[1], l1[2], l1[3], h1[0], h1[1], h1[2], h1[3]}, o[d0], 0, 0, 0);   \
        o[d0] = __builtin_amdgcn_mfma_f32_32x32x16_bf16(pa2, (bf16x8){l2[0], l2[1], l2[2], l2[3], h2[0], h2[1], h2[2], h2[3]}, o[d0], 0, 0, 0);   \
        o[d0] = __builtin_amdgcn_mfma_f32_32x32x16_bf16(pa3, (bf16x8){l3[0], l3[1], l3[2], l3[3], h3[0], h3[1], h3[2], h3[3]}, o[d0], 0, 0, 0); } while (0)
    PV_D0(0); PV_D0(1); PV_D0(2); PV_D0(3);
#undef PV_D0
#undef TRRD
}
struct BlkRef { const bf16* Q; const bf16* K; const bf16* V; bf16* O; float* LSE; const float* CUM; int P0, pq, po, pl, skv; float thr; };
struct Seam { bf16x8 qr[8]; bf16x8 st_v0[1], st_v1[1], st_k0[1], st_k1[1]; int jlo; };
__device__ __forceinline__ int swa_jlo(int P0, int W) { const int lowk = P0 - W + 1; return lowk > 0 ? lowk / KVBLK : 0; }
#define ROW(p, k0, rr, pit) ((p) + (size_t)((k0) + (rr)) * (pit) + sc)
#define VMW() asm volatile("s_waitcnt vmcnt(0)" ::: "memory")
#define VMWN(n) asm volatile("s_waitcnt vmcnt(%0)" :: "i"(n) : "memory")
#define SLOAD_H(Z, Kp, Vp, k0, pit) do { S.st_v0[Z] = load8(ROW(Vp, k0, sr, pit)); S.st_v1[Z] = load8(ROW(Vp, k0, 32 + sr, pit));              \
                         S.st_k0[Z] = load8(ROW(Kp, k0, sr, pit)); S.st_k1[Z] = load8(ROW(Kp, k0, 32 + sr, pit)); } while (0)
#define SWRITE_HK(Z, bf) do { *(bf16x8*)(K_lds + (bf) * SHM_K + kws) = S.st_k0[Z]; *(bf16x8*)(K_lds + (bf) * SHM_K + kws + 32 * 256) = S.st_k1[Z]; } while (0)
#define SWRITE_HV(Z, bf) do { *(bf16x8*)(V_lds + (bf) * SHM_V + vst0) = S.st_v0[Z]; *(bf16x8*)(V_lds + (bf) * SHM_V + vst1) = S.st_v1[Z]; } while (0)
#define SWRITE_H(Z, bf) do { SWRITE_HV(Z, bf); SWRITE_HK(Z, bf); } while (0)
__device__ __forceinline__ int fox_jlo(const BlkRef& R, char* lds) {
    int tid = threadIdx.x; asm volatile("" : "+v"(tid));
    int* jlw = (int*)(lds + JLW_OFF); int nt0 = R.P0 / KVBLK; asm volatile("" : "+s"(nt0));
    if (tid == 0) *jlw = nt0;
    __syncthreads();
    if (tid < nt0) { if (R.CUM[R.P0] - R.CUM[KVBLK * tid + KVBLK - 1] >= -R.thr) atomicMin(jlw, tid); }
    __syncthreads();
    return *jlw;
}
template <bool FOX>
__device__ __forceinline__ void attn_prime(const BlkRef& cur, int W, char* lds, Seam& S) {
    int tid = threadIdx.x; asm volatile("" : "+v"(tid));
    const int wid = __builtin_amdgcn_readfirstlane(tid >> 6), lane = tid & 63, r32 = lane & 31, hi = lane >> 5;
    const int sr = tid >> 4, sc = (tid & 15) * 8, kws = KSWZ(sr, sc * 2); char* K_lds = lds + 2 * SHM_V;
    S.jlo = FOX ? fox_jlo(cur, lds) : swa_jlo(cur.P0, W);
    const int kb0 = S.jlo * KVBLK;
    for (int d0 = 0; d0 < 8; ++d0) S.qr[d0] = load8(cur.Q + (size_t)(wid * QBLK + r32) * cur.pq + d0 * 16 + hi * 8);
    SLOAD_H(0, cur.K, cur.V, kb0, cur.pq); VMW(); SWRITE_HK(0, 0);
    __syncthreads();
}
template <bool FOX, bool SK, int W>
__device__ __forceinline__ void attn_block(const BlkRef& cur, const BlkRef& nxt, char* lds, Seam& S) {
    int tid = threadIdx.x; asm volatile("" : "+v"(tid));
    const int wid = __builtin_amdgcn_readfirstlane(tid >> 6), lane = tid & 63, r32 = lane & 31, hi = lane >> 5;
    const int j_lo = S.jlo;
    int j_hi = (cur.P0 + QB - 1) / KVBLK + 1; if (j_hi > cur.skv / KVBLK) j_hi = cur.skv / KVBLK;
    const int NT = j_hi - j_lo;
    const int qlo = cur.P0 + wid * QBLK, qm = qlo + r32 - 4 * hi;
    char* V_lds = lds; char* K_lds = lds + 2 * SHM_V;
    float* ws = (float*)(lds + 2 * SHM_V + 2 * SHM_K) + wid * 64; float* li_l = ws, * al_l = ws + 32;
    float* bias = (float*)(lds + BIAS_OFF);
    const int sr = tid >> 4, sc = (tid & 15) * 8, vst0 = v_st(sr, sc), vst1 = vst0 + 8192  , kws = KSWZ(sr, sc * 2);
    const int vb0 = (int)(uintptr_t)V_lds + v_rd_base(lane);
    const bf16* Kh = cur.K; const bf16* Vh = cur.V; const int pq = cur.pq;
    if (FOX) {
        const float cref = cur.CUM[cur.P0]; const int nb_ = cur.P0 + QB;
        for (int j = j_lo * KVBLK + tid; j < nb_; j += NW * 64) bias[j] = (cref - cur.CUM[j]) * INV_SCALE;
    }
    if (FOX) __syncthreads();
    float m_reg = -1e30f, l_reg = 0; f32x16 o[4] = {};
#define RESC(a) do { if (__any((a) < 1.f)) { if (hi == 0) al_l[r32] = (a); asm volatile("s_waitcnt lgkmcnt(0)" ::: "memory");              \
                     for (int d_ = 0; d_ < 4; ++d_) for (int r = 0; r < 16; ++r) o[d_][r] *= al_l[crow(r, hi)]; } } while (0)
#define KBASE(t) ((j_lo + (t)) * KVBLK)
#define ACT(t) (KBASE(t) <= qlo + QBLK - 1 && KBASE(t) + KVBLK - 1 >= qlo - W + 1)
#define MASKT(P0_, P1_, t) do { const int kb_ = KBASE(t); \
        if (FOX) { const float* bp_ = bias + kb_ + 4 * hi; _Pragma("unroll") for (int g_ = 0; g_ < 4; ++g_) { const f32x4 b0_ = *(const f32x4*)(bp_ + 8 * g_), b1_ = *(const f32x4*)(bp_ + 32 + 8 * g_); \
            _Pragma("unroll") for (int e_ = 0; e_ < 4; ++e_) { P0_[4 * g_ + e_] += b0_[e_]; P1_[4 * g_ + e_] += b1_[e_]; } } } \
        if ((!SK || ACT(t)) && (kb_ + KVBLK - 1 > qlo || kb_ <= qlo + QBLK - 1 - W)) mask_tile(P0_, P1_, qm - kb_, (unsigned)W); } while (0)
    f32x16 pA0, pA1, pB0, pB1; float mnA, mnB, alA, alB; bf16x8 pa0, pa1, pa2, pa3;
    SWRITE_HV(0, 0); SBAR();
    if (NT > 1) { SLOAD_H(0, Kh, Vh, KBASE(1), pq); }
    SBAR(); qkt<0, SK>(pA0, pA1, K_lds, r32, hi, S.qr, ACT(0));
    MASKT(pA0, pA1, 0); partialSM(pA0, pA1, m_reg, mnA, alA);
    if (NT > 1) { VMW(); SWRITE_H(0, 1); }
    __syncthreads();
#define HALF_STEP(PX0, PX1, mnX, alX, PY0, PY1, alY, t, KB, VB, SB) do {                                                      \
        SBAR(); qkt<KB, SK>(PX0, PX1, K_lds, r32, hi, S.qr, ACT(t));                                             \
        finishSM(PY0, PY1, alY, l_reg, pa0, pa1, pa2, pa3); SBAR();                                                           \
        if ((t) + 1 < NT) { SLOAD_H(0, Kh, Vh, KBASE((t) + 1), pq); SBAR(); }                                               \
        pv_tile<VB, SK>(o, vb0, pa0, pa1, pa2, pa3, ACT((t) - 1)); MASKT(PX0, PX1, (t)); partialSM(PX0, PX1, m_reg, mnX, alX);                                        \
        __syncthreads();                                                                                                      \
        if ((t) + 1 < NT) { VMW(); SWRITE_H(0, SB); }                                                                          \
        RESC(alX); __syncthreads(); } while (0)
    for (int t = 1; t + 1 < NT; t += 2) {
        HALF_STEP(pB0, pB1, mnB, alB, pA0, pA1, alA, t, 1, 0, 0);
        HALF_STEP(pA0, pA1, mnA, alA, pB0, pB1, alB, t + 1, 0, 1, 1);
    }
    const bool even = (NT & 1) == 0;
    if (even) { SBAR(); qkt<1, SK>(pB0, pB1, K_lds, r32, hi, S.qr, ACT(NT - 1)); SBAR(); }
    const int jln = FOX ? fox_jlo(nxt, lds) : swa_jlo(nxt.P0, W); const int kbn = jln * KVBLK; S.jlo = jln;
    SLOAD_H(0, nxt.K, nxt.V, kbn, nxt.pq); SBAR();
#pragma unroll
    for (int d0 = 0; d0 < 8; ++d0) S.qr[d0] = load8(nxt.Q + (size_t)(wid * QBLK + r32) * nxt.pq + d0 * 16 + hi * 8);
    SBAR();
    finishSM(pA0, pA1, alA, l_reg, pa0, pa1, pa2, pa3); SBAR();
    pv_tile<0, SK>(o, vb0, pa0, pa1, pa2, pa3, ACT(even ? NT - 2 : NT - 1));
    if (even) { MASKT(pB0, pB1, NT - 1); partialSM(pB0, pB1, m_reg, mnB, alB); __syncthreads(); RESC(alB);
        finishSM(pB0, pB1, alB, l_reg, pa0, pa1, pa2, pa3); SBAR(); pv_tile<1, SK>(o, vb0, pa0, pa1, pa2, pa3, ACT(NT - 1)); }
    SBAR(); VMWN(8); SWRITE_HK(0, 0); SBAR();
    if (hi == 0) li_l[r32] = l_reg; asm volatile("s_waitcnt lgkmcnt(0)" ::: "memory");
    if (!FOX) { if (hi == 0) cur.LSE[(size_t)(wid * QBLK + r32) * cur.pl] = m_reg * SCALE + __logf(l_reg); }
    float rli[16];
#pragma unroll
    for (int r = 0; r < 16; ++r) rli[r] = __builtin_amdgcn_rcpf(li_l[crow(r, hi)]);
    bf16* Ow = cur.O + (size_t)(wid * QBLK) * cur.po;
#pragma unroll
    for (int r = 0; r < 16; ++r) { const int orow = crow(r, hi);
#pragma unroll
        for (int d0 = 0; d0 < 4; ++d0) { const float v = o[d0][r] * rli[r];
            const float vn = __shfl_xor(v, 1);
            if ((r32 & 1) == 0) *(unsigned*)(Ow + (size_t)orow * cur.po + d0 * 32 + r32) = cvtpk(v, vn); } }
    __syncthreads();
#undef RESC
#undef KBASE
#undef ACT
#undef MASKT
#undef HALF_STEP
}
#undef ROW
#undef VMW
#undef VMWN
#undef SLOAD_H
#undef SWRITE_HK
#undef SWRITE_HV
#undef SWRITE_H
}
#define LAS __attribute__((address_space(3)))
#define XB_TMO      128
#define XB_XCNT(j)  (256  + 64 * (j))
#define XB_XSUB(j)  (1280 + 64 * (j))
#define XB_XGEN(j)  (2304 + 64 * (j))
#define XB_TOP      3328
#define XB_TOPGEN   3392
#define XCD_BAR_WORDS 3456
#define XB_SPIN_CAP (1u << 18)

__device__ __forceinline__ unsigned xb_ld(unsigned* p)              { return __hip_atomic_load(p, __ATOMIC_RELAXED, __HIP_MEMORY_SCOPE_AGENT); }
__device__ __forceinline__ unsigned xb_add(unsigned* p, unsigned v) { return __hip_atomic_fetch_add(p, v, __ATOMIC_RELAXED, __HIP_MEMORY_SCOPE_AGENT); }
__device__ __forceinline__ unsigned xb_xcc_id() { return (unsigned)__builtin_amdgcn_s_getreg((3 << 11) | 20) & 0xFu; }
#define XB_SPIN(cond, bar) do { unsigned _sp = 0; while (cond) { __builtin_amdgcn_s_sleep(1); \
    if ((++_sp & 255u) == 0u) { if (xb_ld(&(bar)[XB_TMO])) break; if (_sp > XB_SPIN_CAP) { atomicAdd(&(bar)[XB_TMO], 1u); break; } } } } while (0)

struct XcdBarrier {
    unsigned* bar; unsigned x;
    volatile LAS unsigned* st;
};

__device__ __forceinline__ XcdBarrier xcd_barrier_post(unsigned* bar, volatile LAS unsigned* st) {
    XcdBarrier b; b.bar = bar; b.x = xb_xcc_id(); b.st = st;
    if (threadIdx.x == 0) (void)xb_add(&bar[XB_XCNT(b.x)], 1u);
    return b;
}
__device__ __forceinline__ void xcd_barrier_complete(unsigned* bar, unsigned x, unsigned& nloc, unsigned& nx) {
    const unsigned G = gridDim.x * gridDim.y * gridDim.z;
    unsigned sum, cnt, mine, sp = 0u;
    for (;;) {
        sum = 0u; cnt = 0u; mine = 0u;
#pragma unroll
        for (unsigned j = 0; j < 16; ++j) { const unsigned c = xb_ld(&bar[XB_XCNT(j)]); sum += c; cnt += (c > 0u) ? 1u : 0u; mine = (j == x) ? c : mine; }
        if (sum == G) break;
        __builtin_amdgcn_s_sleep(1);
        if ((++sp & 255u) == 0u) { if (xb_ld(&bar[XB_TMO])) break; if (sp > XB_SPIN_CAP) { atomicAdd(&bar[XB_TMO], 1u); break; } }
    }
    nloc = mine > 0u ? mine : 1u; nx = cnt > 0u ? cnt : 1u;
}

__device__ __forceinline__ void xcd_barrier(const XcdBarrier& b) {
    asm volatile("s_waitcnt vmcnt(0)" ::: "memory");
    __syncthreads();
    if (threadIdx.x == 0) {
        unsigned* bar = b.bar;
        __builtin_amdgcn_s_waitcnt(0);
        unsigned nloc = b.st[0], nx = b.st[1];
        if (nloc == 0u) { xcd_barrier_complete(bar, b.x, nloc, nx); b.st[0] = nloc; b.st[1] = nx; }
        const unsigned old = xb_add(&bar[XB_XSUB(b.x)], 1u);
        const unsigned gen = old / nloc;
        if (old + 1u == (gen + 1u) * nloc) {
            __builtin_amdgcn_fence(__ATOMIC_RELEASE, "agent");
            asm volatile("s_waitcnt vmcnt(0)" ::: "memory");
            const unsigned og = xb_add(&bar[XB_TOP], 1u);
            const unsigned tg = og / nx;
            if (og + 1u == (tg + 1u) * nx) xb_add(&bar[XB_TOPGEN], 1u);
            else XB_SPIN(xb_ld(&bar[XB_TOPGEN]) == tg, bar);
            __builtin_amdgcn_fence(__ATOMIC_ACQUIRE, "agent");
            xb_add(&bar[XB_XGEN(b.x)], 1u);
            asm volatile("s_waitcnt vmcnt(0)" ::: "memory");
        } else {
            XB_SPIN(xb_ld(&bar[XB_XGEN(b.x)]) == gen, bar);
            __builtin_amdgcn_fence(__ATOMIC_ACQUIRE, "agent");
            asm volatile("s_waitcnt vmcnt(0)" ::: "memory");
        }
    }
    __syncthreads();
}
constexpr int BATCH = 4, SEQ = 8192, DM = 2048, M = BATCH * SEQ, NH = 12, HD = 128, WA = 1536, DEPTH = 4;
constexpr int NIN = 16396, NPAD = 16640;
constexpr int C_QA = 0, C_KA = 1536, C_VA = 3072, C_ZA = 4608, C_QB = 6144, C_KB = 7680, C_VB = 9216, C_ZB = 10752, C_G = 12288, C_F = 16384;
constexpr float LN_EPS = 1e-5f, ALPHA = 1.6817928305074290f;
constexpr size_t MiB = 1u << 20;
constexpr size_t WS_XB = 0, WS_WIN = 128 * MiB, WS_WUA = 388 * MiB, WS_WUB = 412 * MiB, WS_WOUT = 436 * MiB, WS_H = 468 * MiB, WS_OA = 1508 * MiB,
                 WS_LSE = 1796 * MiB, WS_LOGF = 1802 * MiB, WS_CUM = 1804 * MiB, WS_COS = 1806 * MiB, WS_SIN = 1808 * MiB, WS_NRM = 1810 * MiB, WS_SC = 1811 * MiB, WS_BAR = 1812 * MiB, WS_PN2 = 1813 * MiB, WS_END = 1826 * MiB;
constexpr size_t SC_SX = 0, SC_SAA = 32768, SC_SAB = 65536, SC_SWIN = 98304, SC_SWUA = SC_SWIN + 4 * 16640, SC_SWUB = SC_SWUA + 4 * 2048, SC_CSIN = SC_SWUB + 4 * 2048, SC_SWOUT = SC_CSIN + 4 * 16640;
constexpr size_t WS_STATS = WS_BAR + 65536;
constexpr size_t WS_SM = WS_BAR + 393216;
constexpr size_t WS_MF = WS_OA + 96 * MiB;
constexpr size_t OA_STRIDE = (size_t)M * WA, LSE_STRIDE = (size_t)M * NH;
constexpr int LDS_BYTES = 147456, LDS_BARST_OFF = 139264;
constexpr int NPH = 2 + 7 * DEPTH;
typedef unsigned short bf16;
typedef float f32x4 __attribute__((ext_vector_type(4)));
typedef unsigned u32x4 __attribute__((ext_vector_type(4)));

__device__ __forceinline__ unsigned f2bf(float f) { unsigned u = __builtin_bit_cast(unsigned, f); return (u + 0x7fffu + ((u >> 16) & 1u)) >> 16; }
__device__ __forceinline__ unsigned pk2(float lo, float hi) { return f2bf(lo) | (f2bf(hi) << 16); }
__device__ __forceinline__ float bflo(unsigned w) { return __uint_as_float(w << 16); }
__device__ __forceinline__ float bfhi(unsigned w) { return __uint_as_float(w & 0xffff0000u); }
__device__ __forceinline__ float wave_sum(float v) {
#pragma unroll
    for (int o = 1; o < 64; o <<= 1) v += __shfl_xor(v, o);
    return v;
}
__device__ __forceinline__ int in_src_col(int n) {
    if (n < C_VA) { const int hb = n >> 7, p = n & 127; return hb * 128 + 4 * (p >> 3) + (p & 3) + 64 * ((p >> 2) & 1); }
    if (n < C_G) return n;
    if (n < C_F) return n + 12;
    if (n < C_F + 12) return n - C_F + 12288;
    return -1;
}
__device__ __forceinline__ unsigned q8(float v) { return (unsigned)__float2int_rn(v) & 0xffu; }
__device__ __forceinline__ unsigned pack4q(float a, float b, float c, float d) { return q8(a) | (q8(b) << 8) | (q8(c) << 16) | (q8(d) << 24); }
__device__ __forceinline__ float wave_max(float v) {
#pragma unroll
    for (int o = 1; o < 64; o <<= 1) v = fmaxf(v, __shfl_xor(v, o));
    return v;
}
__device__ __forceinline__ void quant_row(const f32x4 (&v)[8], unsigned char* qrow, float* scale, int lane) {
    float amax = 0.f;
#pragma unroll
    for (int j = 0; j < 8; ++j) amax = fmaxf(amax, fmaxf(fmaxf(fabsf(v[j][0]), fabsf(v[j][1])), fmaxf(fabsf(v[j][2]), fabsf(v[j][3]))));
    amax = wave_max(amax); const float inv = amax > 0.f ? 127.f / amax : 0.f;
#pragma unroll
    for (int j = 0; j < 8; ++j) *(unsigned*)(qrow + 4 * lane + 256 * j) = pack4q(v[j][0] * inv, v[j][1] * inv, v[j][2] * inv, v[j][3] * inv);
    if (lane == 0) *scale = amax > 0.f ? amax * (1.f / 127.f) : 1.f;
}

__device__ __forceinline__ float quant_row_q(const f32x4 (&v)[8], unsigned char* qrow, float* scale, int lane, unsigned (&q)[8]) {
    float amax = 0.f;
#pragma unroll
    for (int j = 0; j < 8; ++j) amax = fmaxf(amax, fmaxf(fmaxf(fabsf(v[j][0]), fabsf(v[j][1])), fmaxf(fabsf(v[j][2]), fabsf(v[j][3]))));
    amax = wave_max(amax); const float inv = amax > 0.f ? 127.f / amax : 0.f, sc = amax > 0.f ? amax * (1.f / 127.f) : 1.f;
#pragma unroll
    for (int j = 0; j < 8; ++j) { q[j] = pack4q(v[j][0] * inv, v[j][1] * inv, v[j][2] * inv, v[j][3] * inv); *(unsigned*)(qrow + 4 * lane + 256 * j) = q[j]; }
    if (lane == 0) *scale = sc;
    return sc;
}

template <bool MAP>
__device__ __forceinline__ void quant_tile(const float* W, int K, int N, const float* cs, unsigned char* WT, float* swout, unsigned* t, int item, int nblk, int lane) {
    const int kb = item / nblk, nb = item - kb * nblk, k0 = 64 * kb, nn = 64 * nb + lane, src = MAP ? in_src_col(nn) : nn;
    const float sc = src >= 0 ? cs[src] : 1.f, inv = src >= 0 ? 1.f / sc : 0.f;
    if (swout && kb == 0) swout[nn] = sc;
    const float* wp = W + (size_t)k0 * N + (src >= 0 ? src : 0);
#pragma unroll 4
    for (int s = 0; s < 16; ++s) { const float v0 = wp[(size_t)(4 * s) * N], v1 = wp[(size_t)(4 * s + 1) * N], v2 = wp[(size_t)(4 * s + 2) * N], v3 = wp[(size_t)(4 * s + 3) * N];
        t[lane * 17 + s] = pack4q(v0 * inv, v1 * inv, v2 * inv, v3 * inv); }
    asm volatile("s_waitcnt lgkmcnt(0)" ::: "memory");
#pragma unroll
    for (int j = 0; j < 4; ++j) { const int idx = lane + 64 * j, n = idx >> 2, c = idx & 3; const unsigned* s = t + n * 17 + 4 * c;
        u32x4 o; o.x = s[0]; o.y = s[1]; o.z = s[2]; o.w = s[3];
        *(u32x4*)(WT + (size_t)(64 * nb + n) * K + k0 + 16 * c) = o; }
    asm volatile("s_waitcnt lgkmcnt(0)" ::: "memory");
}

struct Args { const float* in[9]; float* out; unsigned char* ws; int ph_lo, ph_hi; };

__global__ void __launch_bounds__(512, 2) mega_fwd(Args args) {
    extern __shared__ __attribute__((aligned(16))) unsigned char lds[];
    cg::grid_group grid = cg::this_grid();
    const int G = gridDim.x, bx = blockIdx.x, NGW = G * 8;
    const int vcu = (G % 8 == 0) ? (bx % 8) * (G / 8) + bx / 8 : bx;
#define PH_IDS int tid = threadIdx.x; asm volatile("" : "+v"(tid)); const int lane = tid & 63, wave = __builtin_amdgcn_readfirstlane(tid >> 6), gw = bx * 8 + wave; (void)lane; (void)gw; PH_PTRS
#define PH_PTRS     unsigned long long wz_ = 0; asm volatile("" : "+s"(wz_)); unsigned char* ws = args.ws + wz_;     \
    const float* x_in = args.in[0]; const float* w_in = args.in[1]; const float* b_forget = args.in[2]; const float* b_gate = args.in[3]; \
    const float* w_up_a = args.in[4]; const float* w_up_b = args.in[5]; const float* w_out = args.in[6]; const float* ln_g = args.in[7]; const float* ln_b = args.in[8]; \
    float* out = args.out; \
    bf16* XB = (bf16*)(ws + WS_XB); bf16* WIN = (bf16*)(ws + WS_WIN); bf16* WUA = (bf16*)(ws + WS_WUA); bf16* WUB = (bf16*)(ws + WS_WUB); bf16* WOUT = (bf16*)(ws + WS_WOUT); \
    bf16* H = (bf16*)(ws + WS_H); bf16* OA = (bf16*)(ws + WS_OA); bf16* MF = (bf16*)(ws + WS_MF); \
    float* LSE = (float*)(ws + WS_LSE); float* LOGF = (float*)(ws + WS_LOGF); float* CUM = (float*)(ws + WS_CUM); float* COS = (float*)(ws + WS_COS); float* SIN = (float*)(ws + WS_SIN); float* NRM = (float*)(ws + WS_NRM); float* SC = (float*)(ws + WS_SC); \
    unsigned char* XQ = ws + WS_XB; unsigned char* WINQ = ws + WS_WIN; unsigned char* WUAQ = ws + WS_WUA; unsigned char* WUBQ = ws + WS_WUB; \
    (void)x_in; (void)w_in; (void)b_forget; (void)b_gate; (void)w_up_a; (void)w_up_b; (void)w_out; (void)ln_g; (void)ln_b; (void)out; (void)XB; (void)WIN; (void)WUA; (void)WUB; (void)WOUT; (void)H; (void)OA; (void)MF; (void)LSE; (void)LOGF; (void)CUM; (void)COS; (void)SIN; (void)NRM; (void)SC; (void)XQ; (void)WINQ; (void)WUAQ; (void)WUBQ
    const int lo = args.ph_lo, hi = args.ph_hi;
#define IN(k) (lo <= (k) && (k) < hi)
#ifndef XCDBAR
#define XCDBAR 1
#endif
    volatile LAS unsigned* bst = (volatile LAS unsigned*)((LAS unsigned char*)lds + LDS_BARST_OFF);
    if (threadIdx.x < 2) bst[threadIdx.x] = 0u;
    __syncthreads();
    XcdBarrier xbar = xcd_barrier_post((unsigned*)(args.ws + WS_BAR), bst);
#define SEAM(k) do { if ((k) + 1 < hi) { if (!XCDBAR || (k) == 0) grid.sync(); else xcd_barrier(xbar); } } while (0)

    if (IN(0)) { PH_IDS;
        {   float* red = (float*)lds; constexpr int CG_IN = (NIN + 255) / 256, CG_UP = DM / 256, CG_L = CG_IN + 3 * CG_UP;
            for (int it = bx; it < DEPTH * CG_L; it += G) {
                const int l = it / CG_L; int r = it - l * CG_L; const float* W; int K, N; float* cs;
                if (r < CG_IN) { W = w_in + (size_t)l * DM * NIN; K = DM; N = NIN; cs = SC + SC_CSIN + l * NPAD; }
                else if (r < CG_IN + CG_UP) { r -= CG_IN; W = w_up_a + (size_t)l * WA * DM; K = WA; N = DM; cs = SC + SC_SWUA + l * DM; }
                else if (r < CG_IN + 2 * CG_UP) { r -= CG_IN + CG_UP; W = w_up_b + (size_t)l * WA * DM; K = WA; N = DM; cs = SC + SC_SWUB + l * DM; }
                else { r -= CG_IN + 2 * CG_UP; W = w_out + (size_t)l * DM * DM; K = DM; N = DM; cs = SC + SC_SWOUT + l * DM; }
                const int col = 256 * r + 4 * lane; f32x4 mx = {0.f, 0.f, 0.f, 0.f};
                if (col < N) { const float* wp = W + col;
#pragma unroll 8
                    for (int k = wave; k < K; k += 8) { const f32x4 v = *(const f32x4*)(wp + (size_t)k * N);
                        mx[0] = fmaxf(mx[0], fabsf(v[0])); mx[1] = fmaxf(mx[1], fabsf(v[1])); mx[2] = fmaxf(mx[2], fabsf(v[2])); mx[3] = fmaxf(mx[3], fabsf(v[3])); } }
                *(f32x4*)(red + wave * 256 + 4 * lane) = mx;
                __syncthreads();
                if (tid < 256 && 256 * r + tid < N) { float m = 0.f; for (int w = 0; w < 8; ++w) m = fmaxf(m, red[w * 256 + tid]); cs[256 * r + tid] = m > 0.f ? m * (1.f / 127.f) : 1.f; }
                __syncthreads();
            }
        }
        for (int idx = bx * 512 + tid; idx < SEQ * 64; idx += G * 512) {
            const int pos = idx >> 6, i = idx & 63;
            const float inv_freq = exp2f(-(float)i * (1.f / 64.f) * 13.287712379549449f);
            const float ang = (float)pos * inv_freq;
            const double rev = (double)ang * 0.15915494309189535; const float fr = (float)(rev - floor(rev));
            COS[idx] = __builtin_amdgcn_cosf(fr); SIN[idx] = __builtin_amdgcn_sinf(fr);
        }
        for (int m = gw; m < M; m += NGW) { f32x4 v[8];
#pragma unroll
            for (int j = 0; j < 8; ++j) v[j] = *(const f32x4*)(x_in + (size_t)m * DM + 4 * lane + 256 * j);
            quant_row(v, XQ + (size_t)m * DM, SC + SC_SX + m, lane); }
        SEAM(0);
    }
    if (IN(1)) { PH_IDS;
        unsigned* t = (unsigned*)(lds + wave * 16384);
        constexpr int T_IN = (DM / 64) * (NPAD / 64), T_UP = (WA / 64) * (DM / 64), T_OUT = (DM / 64) * (DM / 64), T_L = T_IN + 2 * T_UP + T_OUT;
        for (int it = gw; it < DEPTH * T_L; it += NGW) {
            const int l = it / T_L; int r = it - l * T_L;
            if (r < T_IN) { quant_tile<true>(w_in + (size_t)l * DM * NIN, DM, NIN, SC + SC_CSIN + l * NPAD, WINQ + (size_t)l * NPAD * DM, SC + SC_SWIN + l * NPAD, t, r, NPAD / 64, lane); continue; } r -= T_IN;
            if (r < T_UP) { quant_tile<false>(w_up_a + (size_t)l * WA * DM, WA, DM, SC + SC_SWUA + l * DM, WUAQ + (size_t)l * DM * WA, nullptr, t, r, DM / 64, lane); continue; } r -= T_UP;
            if (r < T_UP) { quant_tile<false>(w_up_b + (size_t)l * WA * DM, WA, DM, SC + SC_SWUB + l * DM, WUBQ + (size_t)l * DM * WA, nullptr, t, r, DM / 64, lane); continue; } r -= T_UP;
            quant_tile<false>(w_out + (size_t)l * DM * DM, DM, DM, SC + SC_SWOUT + l * DM, ws + WS_WOUT + (size_t)l * DM * DM, nullptr, t, r, DM / 64, lane);
        }
        SEAM(1);
    }

    for (int l = 0; l < DEPTH; ++l) {
        const int pb = 2 + 7 * l;
        if (IN(pb + 0)) { PH_IDS;
            if (bx == 0 && tid < 96) NRM[tid] = 0.f;
            const int NP1 = l == 0 ? NPAD : C_F;
            pg8::Gemm g{(const bf16*)XQ, (const bf16*)(WINQ + (size_t)l * NPAD * DM), M, NP1, DM / 2, DM / 2};   pg8::StaticOrder S; S.init(M, NP1, G, bx);
            pg8::EpiIn E{H, NPAD, COS, SIN, LOGF, b_forget + l * NH, SC + SC_SX, SC + SC_SWIN + l * NPAD, (float*)(ws + WS_PN2)};
            pg8::gemm_phase<pg8::EpiIn, pg8::StaticOrder, true, true, true>((PG8_LAS unsigned char*)lds, g, S, E);
            SEAM(pb + 0);
        }
        if (IN(pb + 1)) { PH_IDS;
            {
                float* red = (float*)lds;
                for (int b = 0; b < BATCH; ++b) {
                    float mx = 0.f;
                    for (int s = gw; s < SEQ; s += NGW) { if (lane < 24) { const f32x4 p = *(const f32x4*)((const float*)(ws + WS_PN2) + (((size_t)b * SEQ + s) * 24 + lane) * 4); mx = fmaxf(mx, (p[0] + p[1]) + (p[2] + p[3])); } }
                    if (lane < 24) red[wave * 24 + lane] = mx;
                    __syncthreads();
                    if (tid < 24) { float v = 0.f; for (int w = 0; w < 8; ++w) v = fmaxf(v, red[w * 24 + tid]); atomicMax((unsigned*)NRM + (tid < 12 ? 0 : 48) + b * NH + (tid % 12), __float_as_uint(v)); }
                    __syncthreads();
                }
            }
            if (bx < BATCH * NH) {
                const int b = bx / NH, h = bx - b * NH; float* red = (float*)lds;
                float v[16]; float run = 0.f;
#pragma unroll
                for (int j = 0; j < 16; j += 4) { const f32x4 lf = *(const f32x4*)(LOGF + (size_t)bx * SEQ + 16 * tid + j);
                    run += lf[0]; v[j] = run; run += lf[1]; v[j + 1] = run; run += lf[2]; v[j + 2] = run; run += lf[3]; v[j + 3] = run; }
                float inc = run;
#pragma unroll
                for (int o = 1; o < 64; o <<= 1) { const float t = __shfl_up(inc, o); if (lane >= o) inc += t; }
                if (lane == 63) red[wave] = inc;
                __syncthreads();
                float off = inc - run;
                for (int w = 0; w < wave; ++w) off += red[w];
                float* cp = CUM + (size_t)bx * SEQ + 16 * tid;
#pragma unroll
                for (int j = 0; j < 16; j += 4) *(f32x4*)(cp + j) = (f32x4){v[j] + off, v[j + 1] + off, v[j + 2] + off, v[j + 3] + off};
                __syncthreads();
            }
            constexpr int NIT = 3 * 1536;
            const int cnt = vcu < NIT ? (NIT - vcu + G - 1) / G : 0;
#define DIL_REF(R, n) do { const int L_ = vcu + (n) * G;   \
            const int bh_ = L_ / 96, rb_ = L_ - bh_ * 96, b_ = bh_ / NH, h_ = bh_ - b_ * NH, g_ = rb_ >> 5, r_ = rb_ & 31, dsh = 2 * g_, d_ = 1 << dsh; \
            const int qb = r_ & ((32 >> dsh) - 1), res = r_ >> (5 - dsh); \
            const size_t tok0 = (size_t)b_ * SEQ + res, rq = (size_t)qb * 256 * d_; \
            R.Q = H + (tok0 + rq) * NPAD + C_QA + h_ * HD; R.K = H + tok0 * NPAD + C_KA + h_ * HD; R.V = H + tok0 * NPAD + C_VA + h_ * HD; \
            R.O = OA + (size_t)g_ * OA_STRIDE + (tok0 + rq) * WA + h_ * HD; R.LSE = LSE + (size_t)g_ * LSE_STRIDE + (tok0 + rq) * NH + h_; R.CUM = nullptr; \
            R.P0 = qb * 256; R.pq = d_ * NPAD; R.po = d_ * WA; R.pl = d_ * NH; R.skv = SEQ >> dsh; R.thr = 0.f; } while (0)
            if (cnt > 0) {
                at::BlkRef cur, nxt; at::Seam S{};     DIL_REF(cur, 0);
                at::attn_prime<false>(cur, 129, (char*)lds, S);
                for (int n = 0; n < cnt; ++n) {
                    if (n + 1 < cnt) DIL_REF(nxt, n + 1); else nxt = cur;
                    at::attn_block<false, true, 129>(cur, nxt, (char*)lds, S);
                    cur = nxt;
                }
            }
#undef DIL_REF
            SEAM(pb + 1);
        }
        if (IN(pb + 2)) { PH_IDS;
            constexpr int NIT = BATCH * NH * 32;
            const int cnt = vcu < NIT ? (NIT - vcu + G - 1) / G : 0;
#define FOX_REF(R, n) do { const int L_ = vcu + (n) * G; const int bh = L_ >> 5, qb = (L_ + ((G & 31) == 0 ? 5 * (n) : 0)) & 31  , b_ = bh / NH, h_ = bh - b_ * NH; \
            R.Q = H + ((size_t)b_ * SEQ + (size_t)qb * 256) * NPAD + C_QB + h_ * HD; R.K = H + (size_t)b_ * SEQ * NPAD + C_KB + h_ * HD; R.V = H + (size_t)b_ * SEQ * NPAD + C_VB + h_ * HD; \
            R.O = (bf16*)R.Q; R.LSE = nullptr; R.CUM = CUM + (size_t)bh * SEQ; R.P0 = qb * 256; R.pq = NPAD; R.po = NPAD; R.pl = 0; R.skv = SEQ; R.thr = 30.f + 2.f * 1.02f * sqrtf(NRM[bh] * NRM[48 + bh]) * 0.08838834764831845f;     } while (0)
            if (cnt > 0) {
                at::BlkRef cur, nxt; at::Seam S{};     FOX_REF(cur, 0);
                at::attn_prime<true>(cur, SEQ, (char*)lds, S);
                for (int n = 0; n < cnt; ++n) {
                    if (n + 1 < cnt) FOX_REF(nxt, n + 1); else nxt = cur;
                    at::attn_block<true, false, SEQ>(cur, nxt, (char*)lds, S);
                    cur = nxt;
                }
            }
#undef FOX_REF
            SEAM(pb + 2);
        }

        if (IN(pb + 3)) { PH_IDS;
            for (int m = gw; m < M; m += NGW) {
                bf16* hr = H + (size_t)m * NPAD; float va[3][8], vb[3][8]; float ama = 0.f, amb = 0.f;
                u32x4 A0[3], A1[3], A2[3], ZA[3], OB[3], ZB[3]; float L0[3], L1[3], L2[3];
#pragma unroll
                for (int j = 0; j < 3; ++j) {
                    const int col = 8 * (lane + 64 * j), hh = col >> 7; const bf16* oa = OA + (size_t)m * WA + col;
                    A0[j] = *(const u32x4*)oa; A1[j] = *(const u32x4*)(oa + OA_STRIDE); A2[j] = *(const u32x4*)(oa + 2 * OA_STRIDE); ZA[j] = *(const u32x4*)(hr + C_ZA + col);
                    OB[j] = *(const u32x4*)(hr + C_QB + col); ZB[j] = *(const u32x4*)(hr + C_ZB + col);
                    L0[j] = LSE[(size_t)m * NH + hh]; L1[j] = LSE[LSE_STRIDE + (size_t)m * NH + hh]; L2[j] = LSE[2 * LSE_STRIDE + (size_t)m * NH + hh]; }
                asm volatile("" ::: "memory");
#pragma unroll
                for (int j = 0; j < 3; ++j) {
                    const float l0 = L0[j], l1 = L1[j], l2 = L2[j];
                    const float mx = fmaxf(l0, fmaxf(l1, l2)); float e0 = __expf(l0 - mx), e1 = __expf(l1 - mx), e2 = __expf(l2 - mx);
                    const float inv = __builtin_amdgcn_rcpf(e0 + e1 + e2); e0 *= inv; e1 *= inv; e2 *= inv;
                    const u32x4 a0 = A0[j], a1 = A1[j], a2 = A2[j], za = ZA[j], ob = OB[j], zb = ZB[j];
#pragma unroll
                    for (int k = 0; k < 4; ++k) { const float zl = bflo(za[k]), zh = bfhi(za[k]), yl = bflo(zb[k]), yh = bfhi(zb[k]);
                        va[j][2 * k] = (e0 * bflo(a0[k]) + e1 * bflo(a1[k]) + e2 * bflo(a2[k])) * zl * __builtin_amdgcn_rcpf(1.f + __expf(-zl));
                        va[j][2 * k + 1] = (e0 * bfhi(a0[k]) + e1 * bfhi(a1[k]) + e2 * bfhi(a2[k])) * zh * __builtin_amdgcn_rcpf(1.f + __expf(-zh));
                        vb[j][2 * k] = bflo(ob[k]) * yl * __builtin_amdgcn_rcpf(1.f + __expf(-yl)); vb[j][2 * k + 1] = bfhi(ob[k]) * yh * __builtin_amdgcn_rcpf(1.f + __expf(-yh));
                        ama = fmaxf(ama, fmaxf(fabsf(va[j][2 * k]), fabsf(va[j][2 * k + 1]))); amb = fmaxf(amb, fmaxf(fabsf(vb[j][2 * k]), fabsf(vb[j][2 * k + 1]))); }
                }
                ama = wave_max(ama); amb = wave_max(amb);
                const float ia = ama > 0.f ? 127.f / ama : 0.f, ib = amb > 0.f ? 127.f / amb : 0.f;
                unsigned char* qa = (unsigned char*)OA + (size_t)m * (2 * WA); unsigned char* qb = (unsigned char*)(hr + C_QB);
#pragma unroll
                for (int j = 0; j < 3; ++j) { const int col = 8 * (lane + 64 * j);
                    unsigned long long pa = (unsigned long long)pack4q(va[j][0] * ia, va[j][1] * ia, va[j][2] * ia, va[j][3] * ia) | ((unsigned long long)pack4q(va[j][4] * ia, va[j][5] * ia, va[j][6] * ia, va[j][7] * ia) << 32);
                    unsigned long long pb = (unsigned long long)pack4q(vb[j][0] * ib, vb[j][1] * ib, vb[j][2] * ib, vb[j][3] * ib) | ((unsigned long long)pack4q(vb[j][4] * ib, vb[j][5] * ib, vb[j][6] * ib, vb[j][7] * ib) << 32);
                    *(unsigned long long*)(qa + col) = pa; *(unsigned long long*)(qb + col) = pb; }
                if (lane == 0) { SC[SC_SAA + m] = ama > 0.f ? ama * (1.f / 127.f) : 1.f; SC[SC_SAB + m] = amb > 0.f ? amb * (1.f / 127.f) : 1.f; }
            }
            SEAM(pb + 3);
        }

        if (IN(pb + 4)) { PH_IDS;
            { pg8::Gemm g{OA, (const bf16*)(WUAQ + (size_t)l * DM * WA), M, DM, WA / 2, WA}; pg8::StaticOrder S; S.init(M, DM, G, bx);
              pg8::EpiGate<false> E{H + C_G, NPAD, b_gate + (size_t)l * 2 * DM, nullptr, MF, DM, SC + SC_SAA, SC + SC_SWUA + l * DM};
              pg8::gemm_phase<pg8::EpiGate<false>, pg8::StaticOrder, true, true, true>((PG8_LAS unsigned char*)lds, g, S, E); }
            { pg8::Gemm g{H + C_QB, (const bf16*)(WUBQ + (size_t)l * DM * WA), M, DM, WA / 2, NPAD}; pg8::StaticOrder S; S.init(M, DM, G, bx);
              pg8::EpiGate<true> E{H + C_G + DM, NPAD, b_gate + (size_t)l * 2 * DM + DM, MF, XB, DM, SC + SC_SAB, SC + SC_SWUB + l * DM};
              pg8::gemm_phase<pg8::EpiGate<true>, pg8::StaticOrder, true, true, true>((PG8_LAS unsigned char*)lds, g, S, E); }
            SEAM(pb + 4);
        }
        if (IN(pb + 5)) { PH_IDS;
            {
                unsigned char* MQ = ws + WS_MF; float* SM = (float*)(ws + WS_SM);
                for (int m = gw; m < M; m += NGW) { u32x4 r4[4]; float amax = 0.f;
#pragma unroll
                    for (int j = 0; j < 4; ++j) { r4[j] = *(const u32x4*)(XB + (size_t)m * DM + 8 * (lane + 64 * j));
#pragma unroll
                        for (int k = 0; k < 4; ++k) amax = fmaxf(amax, fmaxf(fabsf(bflo(r4[j][k])), fabsf(bfhi(r4[j][k])))); }
                    amax = wave_max(amax); const float inv = amax > 0.f ? 127.f / amax : 0.f;
#pragma unroll
                    for (int j = 0; j < 4; ++j) { const unsigned long long p = (unsigned long long)pack4q(bflo(r4[j][0]) * inv, bfhi(r4[j][0]) * inv, bflo(r4[j][1]) * inv, bfhi(r4[j][1]) * inv) |
                            ((unsigned long long)pack4q(bflo(r4[j][2]) * inv, bfhi(r4[j][2]) * inv, bflo(r4[j][3]) * inv, bfhi(r4[j][3]) * inv) << 32);
                        *(unsigned long long*)(MQ + (size_t)m * DM + 8 * (lane + 64 * j)) = p; }
                    if (lane == 0) SM[m] = amax > 0.f ? amax * (1.f / 127.f) : 1.f; }
                if (hi - lo > 1) xcd_barrier(xbar);
            }
            pg8::Gemm g{(const bf16*)(ws + WS_MF), (const bf16*)(ws + WS_WOUT + (size_t)l * DM * DM), M, DM, DM / 2, DM / 2}; pg8::StaticOrder S; S.init(M, DM, G, bx);
            pg8::EpiOut E{l == 0 ? x_in : out, out, DM, ALPHA, l == 0 ? nullptr : (const float*)(ws + WS_STATS), ln_g + (size_t)(l > 0 ? l - 1 : 0) * DM, ln_b + (size_t)(l > 0 ? l - 1 : 0) * DM, (const float*)(ws + WS_SM), SC + SC_SWOUT + l * DM};
            pg8::gemm_phase<pg8::EpiOut, pg8::StaticOrder, true, true, true>((PG8_LAS unsigned char*)lds, g, S, E);
            SEAM(pb + 5);
        }

        if (IN(pb + 6)) { PH_IDS;
            const float* gg = ln_g + (size_t)l * DM; const float* bb = ln_b + (size_t)l * DM;
            const int ln_ = l + 1 < DEPTH ? l + 1 : l; float swf = 1.f, bff = 0.f;
            { const unsigned char* wf = WINQ + (size_t)ln_ * NPAD * DM + (size_t)C_F * DM; (void)wf;
              if (lane < 12) { swf = SC[SC_SWIN + (size_t)ln_ * NPAD + C_F + lane]; bff = b_forget[ln_ * NH + lane]; } }
            for (int m = gw; m < M; m += NGW) {
                float* row = out + (size_t)m * DM; f32x4 v[8]; float s = 0.f;
#pragma unroll
                for (int j = 0; j < 8; ++j) { v[j] = *(const f32x4*)(row + 4 * lane + 256 * j); s += (v[j][0] + v[j][1]) + (v[j][2] + v[j][3]); }
                const float mean = wave_sum(s) * (1.f / DM); float s2 = 0.f;
#pragma unroll
                for (int j = 0; j < 8; ++j) { v[j] = v[j] - mean; s2 += (v[j][0] * v[j][0] + v[j][1] * v[j][1]) + (v[j][2] * v[j][2] + v[j][3] * v[j][3]); }
                const float rstd = 1.f / sqrtf(wave_sum(s2) * (1.f / DM) + LN_EPS);
                const bool lastl = l == DEPTH - 1;
#pragma unroll
                for (int j = 0; j < 8; ++j) { const int c = 4 * lane + 256 * j; const f32x4 gv = *(const f32x4*)(gg + c), bv = *(const f32x4*)(bb + c);
                    v[j] = v[j] * rstd * gv + bv; if (lastl) *(f32x4*)(row + c) = v[j]; }
                if (!lastl) { if (lane == 0) { float* st = (float*)(ws + WS_STATS) + 2 * (size_t)m; st[0] = mean; st[1] = rstd; }
                    unsigned q[8]; const float sxr = quant_row_q(v, XQ + (size_t)m * DM, SC + SC_SX + m, lane, q);
                    float zsel = 0.f;
#define lsig_(z_) ([](float z) { return fminf(z, 0.f) - __logf(1.f + __expf(-fabsf(z))); }(z_))
#pragma unroll
                    for (int h = 0; h < 12; ++h) { int a = 0; const unsigned char* wfh = WINQ + (size_t)ln_ * NPAD * DM + (size_t)(C_F + h) * DM + 4 * lane;
#pragma unroll
                        for (int j = 0; j < 8; ++j) a = __builtin_amdgcn_sdot4((int)q[j], *(const int*)(wfh + 256 * j), a, false);
#pragma unroll
                        for (int o = 1; o < 64; o <<= 1) a += __shfl_xor(a, o);
                        if (lane == h) zsel = (float)a; }
                    if (lane < 12) LOGF[((size_t)(m >> 13) * NH + lane) * SEQ + (m & 8191)] = lsig_(zsel * sxr * swf + bff); }
            }
            SEAM(pb + 6);
        }
    }
#undef IN
#undef SEAM
}

extern "C" void kernel_launch(void* const* d_in, const int* in_sizes, int n_in, void* d_out, int out_size, void* d_ws, size_t ws_size, hipStream_t stream) {
    static int grid = 0;
    if (grid == 0) {
        if (n_in != 9 || in_sizes[0] != M * DM || out_size != M * DM || ws_size < WS_END) { fprintf(stderr, "kernel_launch: unexpected shapes / workspace (n_in %d, ws %zu)\n", n_in, ws_size); grid = -1; return; }
        int dev = 0, cus = 0, per_cu = 0;
        (void)hipGetDevice(&dev); (void)hipDeviceGetAttribute(&cus, hipDeviceAttributeMultiprocessorCount, dev);
        if (hipFuncSetAttribute((const void*)mega_fwd, hipFuncAttributeMaxDynamicSharedMemorySize, LDS_BYTES) != hipSuccess) { fprintf(stderr, "kernel_launch: hipFuncSetAttribute failed\n"); grid = -1; return; }
        if (hipOccupancyMaxActiveBlocksPerMultiprocessor(&per_cu, (const void*)mega_fwd, 512, LDS_BYTES) != hipSuccess || per_cu < 1) { fprintf(stderr, "kernel_launch: occupancy query says %d\n", per_cu); per_cu = 1; }
        (void)hipGetLastError();
        if (cus <= 0) cus = 256;
        grid = cus * per_cu;
    }
    if (grid < 0) return;
    if (hipMemsetAsync((char*)d_ws + WS_BAR, 0, XCD_BAR_WORDS * 4, stream) != hipSuccess) { fprintf(stderr, "kernel_launch: hipMemsetAsync of the barrier words failed\n"); return; }
    Args a{};
    for (int i = 0; i < 9; ++i) a.in[i] = (const float*)d_in[i];
    a.out = (float*)d_out; a.ws = (unsigned char*)d_ws;
    a.ph_lo = 0; a.ph_hi = NPH;
    void* kargs[] = {&a};
    hipError_t e = hipLaunchCooperativeKernel((const void*)mega_fwd, dim3(grid), dim3(512), kargs, LDS_BYTES, stream);
    if (e != hipSuccess) fprintf(stderr, "kernel_launch: cooperative launch failed: %s (grid %d)\n", hipGetErrorString(e), grid);
}
```

```cpp
#include <hip/hip_runtime.h>
#include <hip/hip_cooperative_groups.h>
#include <cstdio>
#include <cstdint>
namespace cg = cooperative_groups;
namespace pg8 {
#define PG8_LAS __attribute__((address_space(3)))
typedef unsigned short bf16_t;
typedef short bf16x8 __attribute__((ext_vector_type(8)));
typedef float f32x4 __attribute__((ext_vector_type(4)));
typedef unsigned u32x4 __attribute__((ext_vector_type(4)));
constexpr int BM = 256, BK = 64, HALF = 128, HTB = HALF * BK * 2  , STAGE_BYTES = 8 * HTB, NXCD = 8, WGM = 2;

__host__ __device__ __forceinline__ int lds_byte(int r, int c) { const int st = (r >> 4) * 2 + (c >> 5), rr = r & 15, cc = c & 31, ob = rr * 64 + cc * 2; return st * 1024 + (ob ^ (((ob >> 9) & 1) << 5)); }
__host__ __device__ __forceinline__ void stage_rc(int b, int& R, int& C) { const int st = b / 1024, sb = b % 1024, swz = sb ^ (((sb >> 9) & 1) << 5); R = (st >> 1) * 16 + swz / 64; C = (st & 1) * 32 + (swz % 64) / 2; }
__host__ __device__ __forceinline__ int perm32(int rho) { const int n = rho >> 4, i = rho & 15; return 8 * (i >> 2) + 4 * n + (i & 3); }

struct Unit { int pm, pn; };
struct Gemm { const bf16_t* A; const bf16_t* Bt; int M, N, K, lda; };

struct StaticOrder {
    int nM, nN, nwg, G, c;
    __host__ __device__ void init(int M, int N, int G_, int c_) { nM = M / BM; nN = N / BM; nwg = nM * nN; G = G_; c = c_; }
    __host__ __device__ bool next(int i, Unit& u) const {
        const long L = (long)i * G + c; if (L >= nwg) return false;
        int wgid = (int)L; { const int q = nwg / NXCD, r = nwg % NXCD, xcd = wgid % NXCD, off = wgid / NXCD; wgid = (xcd < r ? xcd * (q + 1) : r * (q + 1) + (xcd - r) * q) + off; }
        const int nig = WGM * nN, gid = wgid / nig, fm = gid * WGM, gsz = (nM - fm) < WGM ? (nM - fm) : WGM;
        u.pm = fm + ((wgid % nig) % gsz); u.pn = (wgid % nig) / gsz; return true;
    }
    __device__ __forceinline__ void a_ready(const Unit&) const {}
    __device__ __forceinline__ void done(const Unit&) const {}
};

__device__ __forceinline__ unsigned cvt_pk_bf16(float lo, float hi) { unsigned r; asm volatile("v_cvt_pk_bf16_f32 %0, %1, %2" : "=v"(r) : "v"(lo), "v"(hi)); return r; }
typedef float f32x2 __attribute__((ext_vector_type(2)));
typedef unsigned u32x2 __attribute__((ext_vector_type(2)));
typedef int i32x4 __attribute__((ext_vector_type(4)));
template <bool I8> struct AccSel { typedef f32x4 type; };
template <> struct AccSel<true> { typedef i32x4 type; };
__device__ __forceinline__ f32x4 cvt4(i32x4 a, float s) { return (f32x4){(float)a[0] * s, (float)a[1] * s, (float)a[2] * s, (float)a[3] * s}; }
__device__ __forceinline__ float bf_lo(unsigned w) { return __uint_as_float(w << 16); }
__device__ __forceinline__ float bf_hi(unsigned w) { return __uint_as_float(w & 0xffff0000u); }
__device__ __forceinline__ float sigm(float z) { return __builtin_amdgcn_rcpf(1.f + __builtin_amdgcn_exp2f(-1.4426950408889634f * z)); }
__device__ __forceinline__ float logsig(float z) { return fminf(z, 0.f) - log1pf(expf(-fabsf(z))); }

struct EpiIn {
    static constexpr bool PERM = true, AFTER_DRAIN = false;
    bf16_t* H; int ldh; const float* cosT; const float* sinT; float* logf; const float* bfg; const float* sx; const float* sw; float* pn2;
    __device__ __forceinline__ void operator()(const i32x4 (&acc)[2][2][4][2], const Unit& u, int wr, int wc, int fr, int fq) const {
        asm volatile("" : "+v"(fr), "+v"(fq));
        const int row0 = u.pm * BM + wr * 64 + fr;
        if (u.pn == 64) {
            if (wc == 0 && fq < 2) {
                const f32x4 b0 = *(const f32x4*)(bfg + 8 * fq); const f32x4 b1 = fq == 0 ? *(const f32x4*)(bfg + 4) : (f32x4){0.f, 0.f, 0.f, 0.f};
                const f32x4 w0 = *(const f32x4*)(sw + u.pn * BM + 8 * fq), w1 = *(const f32x4*)(sw + u.pn * BM + 8 * fq + 4);
#pragma unroll
                for (int ai = 0; ai < 2; ++ai)
#pragma unroll
                    for (int m = 0; m < 4; ++m) { const int row = row0 + ai * HALF + m * 16; const float sr = sx[row];
                        float* o = logf + ((size_t)(row >> 13) * 12 + 8 * fq) * 8192 + (row & 8191);
                        const f32x4 v0 = cvt4(acc[ai][0][m][0], sr) * w0 + b0; o[0] = logsig(v0[0]); o[8192] = logsig(v0[1]); o[2 * 8192] = logsig(v0[2]); o[3 * 8192] = logsig(v0[3]);
                        if (fq == 0) { const f32x4 v1 = cvt4(acc[ai][0][m][1], sr) * w1 + b1; o[4 * 8192] = logsig(v1[0]); o[5 * 8192] = logsig(v1[1]); o[6 * 8192] = logsig(v1[2]); o[7 * 8192] = logsig(v1[3]); } }
            }
            return;
        }
        const bool rope = u.pn < 12, nrm = u.pn >= 24 && u.pn < 36;
        const int i0 = 16 * wc + 4 * fq;
#pragma unroll
        for (int bj = 0; bj < 2; ++bj) { const int col0 = u.pn * BM + bj * HALF + wc * 32 + 8 * fq;
            const f32x4 w0 = *(const f32x4*)(sw + col0), w1 = *(const f32x4*)(sw + col0 + 4);
#pragma unroll
            for (int ai = 0; ai < 2; ++ai)
#pragma unroll
                for (int m = 0; m < 4; ++m) { const int row = row0 + ai * HALF + m * 16; const float sr = sx[row];
                    f32x4 v0 = cvt4(acc[ai][bj][m][0], sr) * w0, v1 = cvt4(acc[ai][bj][m][1], sr) * w1;
                    if (rope) { const int pos = row & 8191; const f32x4 c = *(const f32x4*)(cosT + pos * 64 + i0), s = *(const f32x4*)(sinT + pos * 64 + i0);
                        const f32x4 o0 = v0 * c - v1 * s, o1 = v0 * s + v1 * c; v0 = o0; v1 = o1; }
                    if (nrm) { float s2 = (v0[0] * v0[0] + v0[1] * v0[1]) + (v0[2] * v0[2] + v0[3] * v0[3]) + (v1[0] * v1[0] + v1[1] * v1[1]) + (v1[2] * v1[2] + v1[3] * v1[3]);
                        s2 += __shfl_xor(s2, 16); s2 += __shfl_xor(s2, 32);
                        if (fq == 0) pn2[((size_t)row * 24 + (u.pn - 24) * 2 + bj) * 4 + wc] = s2; }
                    u32x4 w; w.x = cvt_pk_bf16(v0[0], v0[1]); w.y = cvt_pk_bf16(v0[2], v0[3]); w.z = cvt_pk_bf16(v1[0], v1[1]); w.w = cvt_pk_bf16(v1[2], v1[3]);
                    *(u32x4*)(H + (size_t)row * ldh + col0) = w; } }
    }
};
template <bool ADD> struct EpiGate {
    static constexpr bool PERM = true, AFTER_DRAIN = false; static constexpr int NB = 2;
    const bf16_t* Hg; int ldh; const float* bg; const bf16_t* Mf; bf16_t* O; int ldo; const float* sa; const float* sb;
    __device__ __forceinline__ void operator()(const i32x4 (&acc)[2][2][4][2], const Unit& u, int wr, int wc, int fr, int fq) const {
        asm volatile("" : "+v"(fr), "+v"(fq));
        const int row0 = u.pm * BM + wr * 64 + fr;
#pragma unroll
        for (int bj = 0; bj < 2; ++bj) { const int col0 = u.pn * BM + bj * HALF + wc * 32 + 8 * fq;
            const f32x4 g0 = *(const f32x4*)(bg + col0), g1 = *(const f32x4*)(bg + col0 + 4), w0 = *(const f32x4*)(sb + col0), w1 = *(const f32x4*)(sb + col0 + 4);
#pragma unroll
            for (int ai = 0; ai < 2; ++ai)
#pragma unroll
              for (int mb = 0; mb < 4; mb += NB) {
                u32x4 gl[NB], pm[NB]; float sr[NB];
#pragma unroll
                for (int q = 0; q < NB; ++q) { const int row = row0 + ai * HALF + (mb + q) * 16;
                    gl[q] = *(const u32x4*)(Hg + (size_t)row * ldh + col0); if (ADD) pm[q] = *(const u32x4*)(Mf + (size_t)row * ldo + col0); sr[q] = sa[row]; }
                asm volatile("" ::: "memory");
#pragma unroll
                for (int q = 0; q < NB; ++q) { const int m = mb + q; const int row = row0 + ai * HALF + m * 16;
                    f32x4 v0 = cvt4(acc[ai][bj][m][0], sr[q]) * w0, v1 = cvt4(acc[ai][bj][m][1], sr[q]) * w1;
                    v0[0] *= sigm(bf_lo(gl[q].x) + g0[0]); v0[1] *= sigm(bf_hi(gl[q].x) + g0[1]); v0[2] *= sigm(bf_lo(gl[q].y) + g0[2]); v0[3] *= sigm(bf_hi(gl[q].y) + g0[3]);
                    v1[0] *= sigm(bf_lo(gl[q].z) + g1[0]); v1[1] *= sigm(bf_hi(gl[q].z) + g1[1]); v1[2] *= sigm(bf_lo(gl[q].w) + g1[2]); v1[3] *= sigm(bf_hi(gl[q].w) + g1[3]);
                    if (ADD) { v0[0] += bf_lo(pm[q].x); v0[1] += bf_hi(pm[q].x); v0[2] += bf_lo(pm[q].y); v0[3] += bf_hi(pm[q].y); v1[0] += bf_lo(pm[q].z); v1[1] += bf_hi(pm[q].z); v1[2] += bf_lo(pm[q].w); v1[3] += bf_hi(pm[q].w); }
                    u32x4 w; w.x = cvt_pk_bf16(v0[0], v0[1]); w.y = cvt_pk_bf16(v0[2], v0[3]); w.z = cvt_pk_bf16(v1[0], v1[1]); w.w = cvt_pk_bf16(v1[2], v1[3]);
                    *(u32x4*)(O + (size_t)row * ldo + col0) = w; }
                asm volatile("" ::: "memory"); } }
    }
};
struct EpiOut {
    static constexpr bool PERM = false, AFTER_DRAIN = false;
    const float* X; float* T; int ldc; float alpha; const float* stats; const float* lg; const float* lb; const float* sa; const float* sb;
    __device__ __forceinline__ void operator()(const i32x4 (&acc)[2][2][4][2], const Unit& u, int wr, int wc, int fr, int fq) const {
        asm volatile("" : "+v"(fr), "+v"(fq));
        const int row0 = u.pm * BM + wr * 64 + fr, col0 = u.pn * BM + wc * 32 + 4 * fq;
#pragma unroll
        for (int ai = 0; ai < 2; ++ai)
#pragma unroll
            for (int mp = 0; mp < 4; mp += 2) { f32x4 xv0[2][2], xv1[2][2]; float mu0 = 0.f, mu1 = 0.f, rs0 = 1.f, rs1 = 1.f;
                const int rowa = row0 + ai * HALF + mp * 16, rowb = rowa + 16; const size_t offa = (size_t)rowa * ldc + col0, offb = (size_t)rowb * ldc + col0;
                if (stats) { mu0 = stats[2 * rowa]; rs0 = stats[2 * rowa + 1]; mu1 = stats[2 * rowb]; rs1 = stats[2 * rowb + 1]; }
                const float sra = sa[rowa], srb = sa[rowb];
#pragma unroll
                for (int bj = 0; bj < 2; ++bj)
#pragma unroll
                    for (int n = 0; n < 2; ++n) { xv0[bj][n] = *(const f32x4*)(X + offa + bj * HALF + n * 16); xv1[bj][n] = *(const f32x4*)(X + offb + bj * HALF + n * 16); }
                asm volatile("" ::: "memory");
#pragma unroll
                for (int bj = 0; bj < 2; ++bj)
#pragma unroll
                    for (int n = 0; n < 2; ++n) { f32x4 xa = xv0[bj][n], xb = xv1[bj][n];
                        if (stats) { const f32x4 gv = *(const f32x4*)(lg + col0 + bj * HALF + n * 16), bv = *(const f32x4*)(lb + col0 + bj * HALF + n * 16);
                            xa = (xa - mu0) * rs0 * gv + bv; xb = (xb - mu1) * rs1 * gv + bv; }
                        const f32x4 wv = *(const f32x4*)(sb + col0 + bj * HALF + n * 16);
                        *(f32x4*)(T + offa + bj * HALF + n * 16) = xa * alpha + cvt4(acc[ai][bj][mp][n], sra) * wv;
                        *(f32x4*)(T + offb + bj * HALF + n * 16) = xb * alpha + cvt4(acc[ai][bj][mp + 1][n], srb) * wv; }
                asm volatile("" ::: "memory"); }
    }
};
template <class Epi, class Sched, bool ALIGN_EPI = false, bool SP2 = false, bool I8 = false>
__device__ __forceinline__ void gemm_phase(PG8_LAS unsigned char* lds, const Gemm g, const Sched& S, const Epi& E) {
    int tid = threadIdx.x; asm volatile("" : "+v"(tid));
    const int wid = __builtin_amdgcn_readfirstlane(tid >> 6), lane = tid & 63, wr = wid >> 2, wc = wid & 3, fr = lane & 15, fq = lane >> 4;
    const int K = g.K, nt = K / BK;
    unsigned voffA[2], voffB[2];
#pragma unroll
    for (int i = 0; i < 2; ++i) { int R, C; stage_rc(tid * 16 + i * 8192, R, C); const int Rb = Epi::PERM ? ((R & ~31) + perm32(R & 31)) : R;
        voffA[i] = (unsigned)(R * g.lda + C) * 2u; voffB[i] = (unsigned)(Rb * K + C) * 2u; }
    const size_t kstep = (size_t)(BK * 2);
    const size_t hstepA = (size_t)HALF * g.lda * 2, hstepB = (size_t)HALF * K * 2;
    const size_t tstepA = 2 * hstepA, tstepB = 2 * hstepB;
    const unsigned ldsw = (unsigned)wid * 1024u;
    const int aoff = lds_byte(wr * 64 + fr, fq * 8), boff = lds_byte(wc * 32 + fr, fq * 8);
#define PG8_SA(b, h) (((b) * 2 + (h)) * HTB)
#define PG8_SB(b, h) ((4 + (b) * 2 + (h)) * HTB)
#define PG8_STAGE(bufoff, gbase, voff) do { _Pragma("unroll") for (int _i = 0; _i < 2; ++_i) \
        __builtin_amdgcn_global_load_lds((const unsigned*)((const char*)(gbase) + (voff)[_i]), (PG8_LAS unsigned*)(lds + (bufoff) + ldsw + _i * 8192), 16, 0, 0); } while (0)
#define PG8_LDA(dst, b, h) do { _Pragma("unroll") for (int m = 0; m < 4; ++m) _Pragma("unroll") for (int k = 0; k < 2; ++k) dst[m][k] = *(const PG8_LAS bf16x8*)(lds + PG8_SA(b, h) + aoff + m * 2048 + k * 1024); } while (0)
#define PG8_LDB(dst, b, h) do { _Pragma("unroll") for (int n = 0; n < 2; ++n) _Pragma("unroll") for (int k = 0; k < 2; ++k) dst[n][k] = *(const PG8_LAS bf16x8*)(lds + PG8_SB(b, h) + boff + n * 2048 + k * 1024); } while (0)
#define PG8_MMA(ai, bj, At, Bt) do { __builtin_amdgcn_s_setprio(1); _Pragma("unroll") for (int m = 0; m < 4; ++m) _Pragma("unroll") for (int n = 0; n < 2; ++n) _Pragma("unroll") for (int k = 0; k < 2; ++k) \
        { if constexpr (I8) acc[ai][bj][m][n] = __builtin_amdgcn_mfma_i32_16x16x64_i8(__builtin_bit_cast(i32x4, Bt[n][k]), __builtin_bit_cast(i32x4, At[m][k]), acc[ai][bj][m][n], 0, 0, 0); \
          else acc[ai][bj][m][n] = __builtin_amdgcn_mfma_f32_16x16x32_bf16(Bt[n][k], At[m][k], acc[ai][bj][m][n], 0, 0, 0); } __builtin_amdgcn_s_setprio(0); } while (0)
#define PG8_WAIT_V(n) asm volatile("s_waitcnt vmcnt(" #n ")" ::: "memory")
#define PG8_WAIT_L(n) asm volatile("s_waitcnt lgkmcnt(" #n ")" ::: "memory")
#define PG8_BAR __builtin_amdgcn_s_barrier()
#define PG8_SCHED __builtin_amdgcn_sched_barrier(0)
    Unit cur, nxt; int ui = 0;
    if (!S.next(0, cur)) return;
    typedef typename AccSel<I8>::type AccT; AccT acc[2][2][4][2];
#pragma unroll
    for (int a = 0; a < 2; ++a)
#pragma unroll
        for (int b = 0; b < 2; ++b)
#pragma unroll
            for (int m = 0; m < 4; ++m)
#pragma unroll
                for (int n = 0; n < 2; ++n) acc[a][b][m][n] = AccT{};
    bf16x8 At[4][2], B0[2][2], B1[2][2];
    const char* cA = (const char*)g.A + (size_t)cur.pm * tstepA; const char* cB = (const char*)g.Bt + (size_t)cur.pn * tstepB;
    S.a_ready(cur);
    if constexpr (SP2) {
        PG8_STAGE(PG8_SB(0, 0), cB, voffB); PG8_STAGE(PG8_SB(0, 1), cB + hstepB, voffB); PG8_STAGE(PG8_SA(0, 0), cA, voffA); PG8_STAGE(PG8_SA(0, 1), cA + hstepA, voffA);
        if (wr == 1) PG8_BAR;
        PG8_WAIT_V(2); PG8_BAR;
        PG8_STAGE(PG8_SB(1, 0), cB + kstep, voffB); PG8_STAGE(PG8_SA(1, 0), cA + kstep, voffA); PG8_STAGE(PG8_SB(1, 1), cB + hstepB + kstep, voffB);
        PG8_WAIT_V(6); PG8_BAR;
    } else {
        PG8_STAGE(PG8_SB(0, 0), cB, voffB); PG8_STAGE(PG8_SA(0, 0), cA, voffA); PG8_STAGE(PG8_SB(0, 1), cB + hstepB, voffB); PG8_STAGE(PG8_SA(0, 1), cA + hstepA, voffA);
        if (wr == 1) PG8_BAR;
        PG8_WAIT_V(4); PG8_BAR;
        PG8_STAGE(PG8_SB(1, 0), cB + kstep, voffB); PG8_STAGE(PG8_SA(1, 0), cA + kstep, voffA); PG8_STAGE(PG8_SB(1, 1), cB + hstepB + kstep, voffB);
        PG8_WAIT_V(6); PG8_BAR;
    }
    for (;;) {
        const bool has_next = S.next(ui + 1, nxt);
        const char* nA = has_next ? (const char*)g.A + (size_t)nxt.pm * tstepA : cA; const char* nB = has_next ? (const char*)g.Bt + (size_t)nxt.pn * tstepB : cB;
        for (int t = 0; t < nt; t += 2) {
            const bool last = (t == nt - 2);
            const char* a1 = cA + (size_t)(t + 1) * kstep;
            const char* a2 = last ? nA : cA + (size_t)(t + 2) * kstep; const char* b2 = last ? nB : cB + (size_t)(t + 2) * kstep;
            const char* a3 = a2 + kstep; const char* b3 = b2 + kstep;
            if (last && has_next) S.a_ready(nxt);
            if constexpr (SP2) {
            PG8_LDB(B0, 0, 0); PG8_LDB(B1, 0, 1); PG8_SCHED; PG8_LDA(At, 0, 0); PG8_STAGE(PG8_SA(1, 1), a1 + hstepA, voffA);
            PG8_WAIT_V(8); PG8_WAIT_L(0); PG8_BAR; PG8_MMA(0, 0, At, B0); PG8_MMA(0, 1, At, B1); PG8_BAR; PG8_SCHED;
            PG8_LDA(At, 0, 1); PG8_STAGE(PG8_SB(0, 0), b2, voffB); PG8_STAGE(PG8_SB(0, 1), b2 + hstepB, voffB); PG8_STAGE(PG8_SA(0, 0), a2, voffA);
            PG8_WAIT_V(8); PG8_WAIT_L(0); PG8_BAR; PG8_MMA(1, 0, At, B0); PG8_MMA(1, 1, At, B1); PG8_BAR; PG8_SCHED;
            PG8_LDB(B0, 1, 0); PG8_LDB(B1, 1, 1); PG8_SCHED; PG8_LDA(At, 1, 0); PG8_STAGE(PG8_SA(0, 1), a2 + hstepA, voffA);
            PG8_WAIT_V(8); PG8_WAIT_L(0); PG8_BAR; PG8_MMA(0, 0, At, B0); PG8_MMA(0, 1, At, B1); PG8_BAR; PG8_SCHED;
            PG8_LDA(At, 1, 1); PG8_STAGE(PG8_SB(1, 0), b3, voffB); PG8_STAGE(PG8_SB(1, 1), b3 + hstepB, voffB); PG8_STAGE(PG8_SA(1, 0), a3, voffA);
            PG8_WAIT_V(8); PG8_WAIT_L(0); PG8_BAR; PG8_MMA(1, 0, At, B0); PG8_MMA(1, 1, At, B1); PG8_BAR; PG8_SCHED;
            } else {
            PG8_LDB(B0, 0, 0); PG8_SCHED; PG8_LDA(At, 0, 0); PG8_STAGE(PG8_SA(1, 1), a1 + hstepA, voffA);
            PG8_WAIT_L(8); PG8_BAR; PG8_WAIT_L(0); PG8_MMA(0, 0, At, B0); PG8_BAR; PG8_SCHED;
            PG8_LDB(B1, 0, 1); PG8_STAGE(PG8_SB(0, 0), b2, voffB);
            PG8_BAR; PG8_WAIT_L(0); PG8_MMA(0, 1, At, B1); PG8_BAR;
            PG8_LDA(At, 0, 1); PG8_STAGE(PG8_SA(0, 0), a2, voffA);
            PG8_BAR; PG8_WAIT_L(0); PG8_MMA(1, 0, At, B0); PG8_BAR; PG8_SCHED;
            PG8_STAGE(PG8_SB(0, 1), b2 + hstepB, voffB);
            PG8_WAIT_V(6); PG8_BAR; PG8_MMA(1, 1, At, B1); PG8_BAR;
            PG8_LDB(B0, 1, 0); PG8_SCHED; PG8_LDA(At, 1, 0); PG8_STAGE(PG8_SA(0, 1), a2 + hstepA, voffA);
            PG8_WAIT_L(8); PG8_BAR; PG8_WAIT_L(0); PG8_MMA(0, 0, At, B0); PG8_BAR; PG8_SCHED;
            PG8_LDB(B1, 1, 1); PG8_STAGE(PG8_SB(1, 0), b3, voffB);
            PG8_BAR; PG8_WAIT_L(0); PG8_MMA(0, 1, At, B1); PG8_BAR;
            PG8_LDA(At, 1, 1); PG8_STAGE(PG8_SA(1, 0), a3, voffA);
            PG8_BAR; PG8_WAIT_L(0); PG8_MMA(1, 0, At, B0); PG8_BAR; PG8_SCHED;
            PG8_STAGE(PG8_SB(1, 1), b3 + hstepB, voffB);
            PG8_WAIT_V(6); PG8_BAR; PG8_MMA(1, 1, At, B1); PG8_BAR;
            }
        }
        if constexpr (ALIGN_EPI) { if (wr == 0) PG8_BAR; }
        if constexpr (!Epi::AFTER_DRAIN) { E(acc, cur, wr, wc, fr, fq); S.done(cur); }
        if (!has_next) break;
#pragma unroll
        for (int a = 0; a < 2; ++a)
#pragma unroll
            for (int b = 0; b < 2; ++b)
#pragma unroll
                for (int m = 0; m < 4; ++m)
#pragma unroll
                    for (int n = 0; n < 2; ++n) acc[a][b][m][n] = AccT{};
        cur = nxt; cA = nA; cB = nB; ++ui;
        if constexpr (ALIGN_EPI) { if (wr == 1) PG8_BAR; }
    }
    PG8_WAIT_V(0);
    if constexpr (!ALIGN_EPI) { if (wr == 0) PG8_BAR; }
    PG8_BAR;
    if constexpr (Epi::AFTER_DRAIN) { E.fused(acc, cur, wr, wc, fr, fq, lds, wid, lane); S.done(cur); }
#undef PG8_SA
#undef PG8_SB
#undef PG8_STAGE
#undef PG8_LDA
#undef PG8_LDB
#undef PG8_MMA
#undef PG8_WAIT_V
#undef PG8_WAIT_L
#undef PG8_BAR
#undef PG8_SCHED
}
}
namespace at {
typedef unsigned short bf16;
typedef short bf16x8 __attribute__((ext_vector_type(8)));
typedef short s16x4 __attribute__((ext_vector_type(4)));
typedef float f32x16 __attribute__((ext_vector_type(16)));
typedef float f32x4 __attribute__((ext_vector_type(4)));
typedef unsigned u32x4 __attribute__((ext_vector_type(4)));
constexpr int D = 128;
constexpr float SCALE = 0.08838834764831845f, INV_SCALE = 11.313708498984761f, THR = 8.f;
constexpr int NW = 8, QBLK = 32, KVBLK = 64, QB = NW * QBLK;
constexpr int SHM_V = KVBLK * D * 2, SHM_K = KVBLK * D * 2;
constexpr int LDS_ATT = 2 * SHM_V + 2 * SHM_K + NW * 64 * 4;
constexpr int BIAS_OFF = LDS_ATT, JLW_OFF = BIAS_OFF + 8192 * 4, LDS_TOTAL = JLW_OFF + 16;

#define KSWZ(row, colB) ((row) * 256 + ((colB) ^ (((row) & 7) << 4)))
#define SBAR() __builtin_amdgcn_sched_barrier(0)
#define LBAR() do { asm volatile("s_waitcnt lgkmcnt(0)" ::: "memory"); __builtin_amdgcn_s_barrier(); asm volatile("" ::: "memory"); } while (0)
__device__ __forceinline__ int v_st(int k, int c) { const int kk = (k & ~0xC) | ((k & 4) << 1) | ((k & 8) >> 1); return ((kk >> 3) * 4 + (c >> 5)) * 512 + ((kk & 7) * 32 + (c & 31)) * 2; }
__device__ __forceinline__ int v_rd_base(int lane) { return ((lane & 3) << 3) | (((lane >> 2) & 3) << 6) | (((lane >> 4) & 1) << 5) | (((lane >> 5) & 1) << 8); }
constexpr int v_rd_off(int d0, int ks, int half) { return d0 * 512 + ks * 4096 + half * 2048; }
__device__ __forceinline__ int crow(int r, int hi) { return (r & 3) + 8 * (r >> 2) + 4 * hi; }
__device__ __forceinline__ unsigned cvtpk(float lo, float hi) { unsigned r; asm volatile("v_cvt_pk_bf16_f32 %0, %1, %2" : "=v"(r) : "v"(lo), "v"(hi)); return r; }
__device__ __forceinline__ bf16x8 load8(const bf16* p) { return *reinterpret_cast<const bf16x8*>(p); }
__device__ __forceinline__ void mask_tile(f32x16& p0, f32x16& p1, int dq, unsigned W) {
    const float NEG = -__builtin_inff();
#pragma unroll
    for (int r = 0; r < 16; ++r) {
        const int c = (r & 3) + 8 * (r >> 2);
        if ((unsigned)(dq - c) >= W) p0[r] = NEG;
        if ((unsigned)(dq - c - 32) >= W) p1[r] = NEG;
    }
}
__device__ __forceinline__ void partialSM(f32x16& p0, f32x16& p1, float& m_reg, float& mn, float& alpha) {
    float pmax = p0[0]; for (int r = 1; r < 16; ++r) pmax = fmaxf(pmax, p0[r]); for (int r = 0; r < 16; ++r) pmax = fmaxf(pmax, p1[r]);
    { auto rr = __builtin_amdgcn_permlane32_swap(__float_as_uint(pmax), __float_as_uint(pmax), false, false);
      pmax = fmaxf(__uint_as_float(rr[0]), __uint_as_float(rr[1])); }
    constexpr float C2 = 1.4426950408889634f * SCALE;
    if (__builtin_expect(__all((pmax - m_reg) * SCALE <= THR), 1)) { mn = m_reg; alpha = 1.f; }
    else { mn = fmaxf(m_reg, pmax); alpha = __builtin_amdgcn_exp2f((m_reg - mn) * C2); m_reg = mn; }
    const float mnL = -mn * C2;
    for (int r = 0; r < 16; ++r) p0[r] = fmaf(p0[r], C2, mnL); for (int r = 0; r < 16; ++r) p1[r] = fmaf(p1[r], C2, mnL);
    for (int r = 0; r < 16; ++r) p0[r] = __builtin_amdgcn_exp2f(p0[r]);
}
__device__ __forceinline__ void finishSM(f32x16& p0, f32x16& p1, float alpha, float& l_reg, bf16x8& pa0, bf16x8& pa1, bf16x8& pa2, bf16x8& pa3) {
    for (int r = 0; r < 16; ++r) p1[r] = __builtin_amdgcn_exp2f(p1[r]);
    float ps = 0; for (int r = 0; r < 16; ++r) ps += p0[r]; for (int r = 0; r < 16; ++r) ps += p1[r];
    { auto rr = __builtin_amdgcn_permlane32_swap(__float_as_uint(ps), __float_as_uint(ps), false, false);
      ps = __uint_as_float(rr[0]) + __uint_as_float(rr[1]); }
    l_reg = l_reg * alpha + ps;
#define PK4(P, B_, OUT) do { unsigned a0 = cvtpk(P[B_+0], P[B_+1]), a1 = cvtpk(P[B_+2], P[B_+3]);                          \
        unsigned b0 = cvtpk(P[B_+4], P[B_+5]), b1 = cvtpk(P[B_+6], P[B_+7]);                                             \
        auto r0 = __builtin_amdgcn_permlane32_swap(a0, b0, false, false); auto r1 = __builtin_amdgcn_permlane32_swap(a1, b1, false, false); \
        u32x4 w = {r0[0], r1[0], r0[1], r1[1]}; OUT = *reinterpret_cast<bf16x8*>(&w); } while (0)
    PK4(p0, 0, pa0); PK4(p0, 8, pa1); PK4(p1, 0, pa2); PK4(p1, 8, pa3);
#undef PK4
}
template <int KB, bool SK>
__device__ __forceinline__ void qkt(f32x16& p0, f32x16& p1, const char* K_lds, int r32, int hi, const bf16x8* qr, bool act) {
    if (SK && !act) { const float NEG = -__builtin_inff();
#pragma unroll
        for (int r = 0; r < 16; ++r) { p0[r] = NEG; p1[r] = NEG; } return; }
    p0 = f32x16{}; p1 = f32x16{};
    const char* kb[4];
#pragma unroll
    for (int dd = 0; dd < 4; ++dd) kb[dd] = K_lds + KB * SHM_K + KSWZ(r32, (dd * 16 + hi * 8) * 2);
#pragma unroll
    for (int d0 = 0; d0 < 8; ++d0) { const char* a = kb[d0 & 3] + (d0 >> 2) * 128;
        bf16x8 b0 = *reinterpret_cast<const bf16x8*>(a);
        bf16x8 b1 = *reinterpret_cast<const bf16x8*>(a + 32 * 256);
        p0 = __builtin_amdgcn_mfma_f32_32x32x16_bf16(b0, qr[d0], p0, 0, 0, 0);
        p1 = __builtin_amdgcn_mfma_f32_32x32x16_bf16(b1, qr[d0], p1, 0, 0, 0); }
}
template <int VB, bool SK>
__device__ __forceinline__ void pv_tile(f32x16* o, int vb0, bf16x8 pa0, bf16x8 pa1, bf16x8 pa2, bf16x8 pa3, bool act) {
    if (SK && !act) return;
#define TRRD(dst, off) asm volatile("ds_read_b64_tr_b16 %0, %1 offset:%2" : "=&v"(dst) : "v"(vb0), "i"(off) : "memory")
#define PV_D0(d0) do { s16x4 l0, l1, l2, l3, h0, h1, h2, h3; constexpr int b_ = VB * SHM_V + v_rd_off(d0, 0, 0); \
        TRRD(l0, b_); TRRD(h0, b_ + 2048); TRRD(l1, b_ + 4096); TRRD(h1, b_ + 6144); TRRD(l2, b_ + 8192); TRRD(h2, b_ + 10240); TRRD(l3, b_ + 12288); TRRD(h3, b_ + 14336); \
        asm volatile("s_waitcnt lgkmcnt(0)" ::: "memory"); SBAR();   \
        o[d0] = __builtin_amdgcn_mfma_f32_32x32x16_bf16(pa0, (bf16x8){l0[0], l0[1], l0[2], l0[3], h0[0], h0[1], h0[2], h0[3]}, o[d0], 0, 0, 0);   \
        o[d0] = __builtin_amdgcn_mfma_f32_32x32x16_bf16(pa1, (bf16x8){l1[0], l1[1], l1[2], l1[3], h1[0], h1[1], h1[2], h1[3]}, o[d0], 0, 0, 0);   \
        o[d0] = __builtin_amdgcn_mfma_f32_32x32x16_bf16(pa2, (bf16x8){l2[0], l2[1], l2[2], l2[3], h2[0], h2[1], h2[2], h2[3]}, o[d0], 0, 0, 0);   \
        o[d0] = __builtin_amdgcn_mfma_f32_32x32x16_bf16(pa3, (bf16x8){l3[0], l3[1], l3[2], l3[3], h3[0], h3[1], h3[2], h3[3]}, o[d0], 0, 0, 0); } while (0)
    PV_D0(0); PV_D0(1); PV_D0(2); PV_D0(3);
#undef PV_D0
#undef TRRD
}
struct BlkRef { const bf16* Q; const bf16* K; const bf16* V; bf16* O; float* LSE; const float* CUM; int P0, pq, po, pl, skv; float thr; };
struct Seam { bf16x8 qr[8]; bf16x8 st_v0[1], st_v1[1], st_k0[1], st_k1[1]; int jlo; };
__device__ __forceinline__ int swa_jlo(int P0, int W) { const int lowk = P0 - W + 1; return lowk > 0 ? lowk / KVBLK : 0; }
#define ROW(p, k0, rr, pit) ((p) + (size_t)((k0) + (rr)) * (pit) + sc)
#define VMW() asm volatile("s_waitcnt vmcnt(0)" ::: "memory")
#define VMWN(n) asm volatile("s_waitcnt vmcnt(%0)" :: "i"(n) : "memory")
#define SLOAD_H(Z, Kp, Vp, k0, pit) do { S.st_v0[Z] = load8(ROW(Vp, k0, sr, pit)); S.st_v1[Z] = load8(ROW(Vp, k0, 32 + sr, pit));              \
                         S.st_k0[Z] = load8(ROW(Kp, k0, sr, pit)); S.st_k1[Z] = load8(ROW(Kp, k0, 32 + sr, pit)); } while (0)
#define SWRITE_HK(Z, bf) do { *(bf16x8*)(K_lds + (bf) * SHM_K + kws) = S.st_k0[Z]; *(bf16x8*)(K_lds + (bf) * SHM_K + kws + 32 * 256) = S.st_k1[Z]; } while (0)
#define SWRITE_HV(Z, bf) do { *(bf16x8*)(V_lds + (bf) * SHM_V + vst0) = S.st_v0[Z]; *(bf16x8*)(V_lds + (bf) * SHM_V + vst1) = S.st_v1[Z]; } while (0)
#define SWRITE_H(Z, bf) do { SWRITE_HV(Z, bf); SWRITE_HK(Z, bf); } while (0)
__device__ __forceinline__ int fox_jlo(const BlkRef& R, char* lds) {
    int tid = threadIdx.x; asm volatile("" : "+v"(tid));
    int* jlw = (int*)(lds + JLW_OFF); int nt0 = R.P0 / KVBLK; asm volatile("" : "+s"(nt0));
    if (tid == 0) *jlw = nt0;
    __syncthreads();
    if (tid < nt0) { if (R.CUM[R.P0] - R.CUM[KVBLK * tid + KVBLK - 1] >= -R.thr) atomicMin(jlw, tid); }
    __syncthreads();
    return *jlw;
}
template <bool FOX>
__device__ __forceinline__ void attn_prime(const BlkRef& cur, int W, char* lds, Seam& S) {
    int tid = threadIdx.x; asm volatile("" : "+v"(tid));
    const int wid = __builtin_amdgcn_readfirstlane(tid >> 6), lane = tid & 63, r32 = lane & 31, hi = lane >> 5;
    const int sr = tid >> 4, sc = (tid & 15) * 8, kws = KSWZ(sr, sc * 2); char* K_lds = lds + 2 * SHM_V;
    S.jlo = FOX ? fox_jlo(cur, lds) : swa_jlo(cur.P0, W);
    const int kb0 = S.jlo * KVBLK;
    for (int d0 = 0; d0 < 8; ++d0) S.qr[d0] = load8(cur.Q + (size_t)(wid * QBLK + r32) * cur.pq + d0 * 16 + hi * 8);
    SLOAD_H(0, cur.K, cur.V, kb0, cur.pq); VMW(); SWRITE_HK(0, 0);
    __syncthreads();
}
template <bool FOX, bool SK, int W>
__device__ __forceinline__ void attn_block(const BlkRef& cur, const BlkRef& nxt, char* lds, Seam& S) {
    int tid = threadIdx.x; asm volatile("" : "+v"(tid));
    const int wid = __builtin_amdgcn_readfirstlane(tid >> 6), lane = tid & 63, r32 = lane & 31, hi = lane >> 5;
    const int j_lo = S.jlo;
    int j_hi = (cur.P0 + QB - 1) / KVBLK + 1; if (j_hi > cur.skv / KVBLK) j_hi = cur.skv / KVBLK;
    const int NT = j_hi - j_lo;
    const int qlo = cur.P0 + wid * QBLK, qm = qlo + r32 - 4 * hi;
    char* V_lds = lds; char* K_lds = lds + 2 * SHM_V;
    float* ws = (float*)(lds + 2 * SHM_V + 2 * SHM_K) + wid * 64; float* li_l = ws, * al_l = ws + 32;
    float* bias = (float*)(lds + BIAS_OFF);
    const int sr = tid >> 4, sc = (tid & 15) * 8, vst0 = v_st(sr, sc), vst1 = vst0 + 8192  , kws = KSWZ(sr, sc * 2);
    const int vb0 = (int)(uintptr_t)V_lds + v_rd_base(lane);
    const bf16* Kh = cur.K; const bf16* Vh = cur.V; const int pq = cur.pq;
    if (FOX) {
        const float cref = cur.CUM[cur.P0]; const int nb_ = cur.P0 + QB;
        for (int j = j_lo * KVBLK + tid; j < nb_; j += NW * 64) bias[j] = (cref - cur.CUM[j]) * INV_SCALE;
    }
    if (FOX) __syncthreads();
    float m_reg = -1e30f, l_reg = 0; f32x16 o[4] = {};
#define RESC(a) do { if (__any((a) < 1.f)) { if (hi == 0) al_l[r32] = (a); asm volatile("s_waitcnt lgkmcnt(0)" ::: "memory");              \
                     for (int d_ = 0; d_ < 4; ++d_) for (int r = 0; r < 16; ++r) o[d_][r] *= al_l[crow(r, hi)]; } } while (0)
#define KBASE(t) ((j_lo + (t)) * KVBLK)
#define ACT(t) (KBASE(t) <= qlo + QBLK - 1 && KBASE(t) + KVBLK - 1 >= qlo - W + 1)
#define MASKT(P0_, P1_, t) do { const int kb_ = KBASE(t); \
        if (FOX) { const float* bp_ = bias + kb_ + 4 * hi; _Pragma("unroll") for (int g_ = 0; g_ < 4; ++g_) { const f32x4 b0_ = *(const f32x4*)(bp_ + 8 * g_), b1_ = *(const f32x4*)(bp_ + 32 + 8 * g_); \
            _Pragma("unroll") for (int e_ = 0; e_ < 4; ++e_) { P0_[4 * g_ + e_] += b0_[e_]; P1_[4 * g_ + e_] += b1_[e_]; } } } \
        if ((!SK || ACT(t)) && (kb_ + KVBLK - 1 > qlo || kb_ <= qlo + QBLK - 1 - W)) mask_tile(P0_, P1_, qm - kb_, (unsigned)W); } while (0)
    f32x16 pA0, pA1, pB0, pB1; float mnA, mnB, alA, alB; bf16x8 pa0, pa1, pa2, pa3;
    SWRITE_HV(0, 0); SBAR();
    if (NT > 1) { SLOAD_H(0, Kh, Vh, KBASE(1), pq); }
    SBAR(); qkt<0, SK>(pA0, pA1, K_lds, r32, hi, S.qr, ACT(0));
    MASKT(pA0, pA1, 0); partialSM(pA0, pA1, m_reg, mnA, alA);
    if (NT > 1) { VMW(); SWRITE_H(0, 1); }
    __syncthreads();
#define HALF_STEP(PX0, PX1, mnX, alX, PY0, PY1, alY, t, KB, VB, SB) do {                                                      \
        SBAR(); qkt<KB, SK>(PX0, PX1, K_lds, r32, hi, S.qr, ACT(t));                                             \
        finishSM(PY0, PY1, alY, l_reg, pa0, pa1, pa2, pa3); SBAR();                                                           \
        if ((t) + 1 < NT) { SLOAD_H(0, Kh, Vh, KBASE((t) + 1), pq); SBAR(); }                                               \
        pv_tile<VB, SK>(o, vb0, pa0, pa1, pa2, pa3, ACT((t) - 1)); MASKT(PX0, PX1, (t)); partialSM(PX0, PX1, m_reg, mnX, alX);                                        \
        __syncthreads();                                                                                                      \
        if ((t) + 1 < NT) { VMW(); SWRITE_H(0, SB); }                                                                          \
        RESC(alX); __syncthreads(); } while (0)
    for (int t = 1; t + 1 < NT; t += 2) {
        HALF_STEP(pB0, pB1, mnB, alB, pA0, pA1, alA, t, 1, 0, 0);
        HALF_STEP(pA0, pA1, mnA, alA, pB0, pB1, alB, t + 1, 0, 1, 1);
    }
    const bool even = (NT & 1) == 0;
    if (even) { SBAR(); qkt<1, SK>(pB0, pB1, K_lds, r32, hi, S.qr, ACT(NT - 1)); SBAR(); }
    const int jln = FOX ? fox_jlo(nxt, lds) : swa_jlo(nxt.P0, W); const int kbn = jln * KVBLK; S.jlo = jln;
    SLOAD_H(0, nxt.K, nxt.V, kbn, nxt.pq); SBAR();
#pragma unroll
    for (int d0 = 0; d0 < 8; ++d0) S.qr[d0] = load8(nxt.Q + (size_t)(wid * QBLK + r32) * nxt.pq + d0 * 16 + hi * 8);
    SBAR();
    finishSM(pA0, pA1, alA, l_reg, pa0, pa1, pa2, pa3); SBAR();
    pv_tile<0, SK>(o, vb0, pa0, pa1, pa2, pa3, ACT(even ? NT - 2 : NT - 1));
    if (even) { MASKT(pB0, pB1, NT - 1); partialSM(pB0, pB1, m_reg, mnB, alB); __syncthreads(); RESC(alB);
        finishSM(pB0, pB1, alB, l_reg, pa0, pa1, pa2, pa3); SBAR(); pv_tile<1, SK>(o, vb0, pa0, pa1, pa2, pa3, ACT(NT - 1)); }
    SBAR(); VMWN(8); SWRITE_HK(0, 0); SBAR();
    if (hi == 0) li_l[r32] = l_reg; asm volatile("s_waitcnt lgkmcnt(0)" ::: "memory");
    if (!FOX) { if (hi == 0) cur.LSE[(size_t)(wid * QBLK + r32) * cur.pl] = m_reg * SCALE + __logf(l_reg); }
    float rli[16];
#pragma unroll
    for (int r = 0; r < 16; ++r) rli[r] = __builtin_amdgcn_rcpf(li_l[crow(r, hi)]);
    bf16* Ow = cur.O + (size_t)(wid * QBLK) * cur.po;
#pragma unroll
    for (int r = 0; r < 16; ++r) { const int orow = crow(r, hi);
#pragma unroll
        for (int d0 = 0; d0 < 4; ++d0) { const float v = o[d0][r] * rli[r];
            const float vn = __shfl_xor(v, 1);
            if ((r32 & 1) == 0) *(unsigned*)(Ow + (size_t)orow * cur.po + d0 * 32 + r32) = cvtpk(v, vn); } }
    __syncthreads();
#undef RESC
#undef KBASE
#undef ACT
#undef MASKT
#undef HALF_STEP
}
#undef ROW
#undef VMW
#undef VMWN
#undef SLOAD_H
#undef SWRITE_HK
#undef SWRITE_HV
#undef SWRITE_H
}
#define LAS __attribute__((address_space(3)))
#define XB_TMO      128
#define XB_XCNT(j)  (256  + 64 * (j))
#define XB_XSUB(j)  (1280 + 64 * (j))
#define XB_XGEN(j)  (2304 + 64 * (j))
#define XB_TOP      3328
#define XB_TOPGEN   3392
#define XCD_BAR_WORDS 3456
#define XB_SPIN_CAP (1u << 18)

__device__ __forceinline__ unsigned xb_ld(unsigned* p)              { return __hip_atomic_load(p, __ATOMIC_RELAXED, __HIP_MEMORY_SCOPE_AGENT); }
__device__ __forceinline__ unsigned xb_add(unsigned* p, unsigned v) { return __hip_atomic_fetch_add(p, v, __ATOMIC_RELAXED, __HIP_MEMORY_SCOPE_AGENT); }
__device__ __forceinline__ unsigned xb_xcc_id() { return (unsigned)__builtin_amdgcn_s_getreg((3 << 11) | 20) & 0xFu; }
#define XB_SPIN(cond, bar) do { unsigned _sp = 0; while (cond) { __builtin_amdgcn_s_sleep(1); \
    if ((++_sp & 255u) == 0u) { if (xb_ld(&(bar)[XB_TMO])) break; if (_sp > XB_SPIN_CAP) { atomicAdd(&(bar)[XB_TMO], 1u); break; } } } } while (0)

struct XcdBarrier {
    unsigned* bar; unsigned x;
    volatile LAS unsigned* st;
};

__device__ __forceinline__ XcdBarrier xcd_barrier_post(unsigned* bar, volatile LAS unsigned* st) {
    XcdBarrier b; b.bar = bar; b.x = xb_xcc_id(); b.st = st;
    if (threadIdx.x == 0) (void)xb_add(&bar[XB_XCNT(b.x)], 1u);
    return b;
}
__device__ __forceinline__ void xcd_barrier_complete(unsigned* bar, unsigned x, unsigned& nloc, unsigned& nx) {
    const unsigned G = gridDim.x * gridDim.y * gridDim.z;
    unsigned sum, cnt, mine, sp = 0u;
    for (;;) {
        sum = 0u; cnt = 0u; mine = 0u;
#pragma unroll
        for (unsigned j = 0; j < 16; ++j) { const unsigned c = xb_ld(&bar[XB_XCNT(j)]); sum += c; cnt += (c > 0u) ? 1u : 0u; mine = (j == x) ? c : mine; }
        if (sum == G) break;
        __builtin_amdgcn_s_sleep(1);
        if ((++sp & 255u) == 0u) { if (xb_ld(&bar[XB_TMO])) break; if (sp > XB_SPIN_CAP) { atomicAdd(&bar[XB_TMO], 1u); break; } }
    }
    nloc = mine > 0u ? mine : 1u; nx = cnt > 0u ? cnt : 1u;
}

__device__ __forceinline__ void xcd_barrier(const XcdBarrier& b) {
    asm volatile("s_waitcnt vmcnt(0)" ::: "memory");
    __syncthreads();
    if (threadIdx.x == 0) {
        unsigned* bar = b.bar;
        __builtin_amdgcn_s_waitcnt(0);
        unsigned nloc = b.st[0], nx = b.st[1];
        if (nloc == 0u) { xcd_barrier_complete(bar, b.x, nloc, nx); b.st[0] = nloc; b.st[1] = nx; }
        const unsigned old = xb_add(&bar[XB_XSUB(b.x)], 1u);
        const unsigned gen = old / nloc;
        if (old + 1u == (gen + 1u) * nloc) {
            __builtin_amdgcn_fence(__ATOMIC_RELEASE, "agent");
            asm volatile("s_waitcnt vmcnt(0)" ::: "memory");
            const unsigned og = xb_add(&bar[XB_TOP], 1u);
            const unsigned tg = og / nx;
            if (og + 1u == (tg + 1u) * nx) xb_add(&bar[XB_TOPGEN], 1u);
            else XB_SPIN(xb_ld(&bar[XB_TOPGEN]) == tg, bar);
            __builtin_amdgcn_fence(__ATOMIC_ACQUIRE, "agent");
            xb_add(&bar[XB_XGEN(b.x)], 1u);
            asm volatile("s_waitcnt vmcnt(0)" ::: "memory");
        } else {
            XB_SPIN(xb_ld(&bar[XB_XGEN(b.x)]) == gen, bar);
            __builtin_amdgcn_fence(__ATOMIC_ACQUIRE, "agent");
            asm volatile("s_waitcnt vmcnt(0)" ::: "memory");
        }
    }
    __syncthreads();
}
constexpr int BATCH = 4, SEQ = 8192, DM = 2048, M = BATCH * SEQ, NH = 12, HD = 128, WA = 1536, DEPTH = 4;
constexpr int NIN = 16396, NPAD = 16640;
constexpr int C_QA = 0, C_KA = 1536, C_VA = 3072, C_ZA = 4608, C_QB = 6144, C_KB = 7680, C_VB = 9216, C_ZB = 10752, C_G = 12288, C_F = 16384;
constexpr float LN_EPS = 1e-5f, ALPHA = 1.6817928305074290f;
constexpr size_t MiB = 1u << 20;
constexpr size_t WS_XB = 0, WS_WIN = 128 * MiB, WS_WUA = 388 * MiB, WS_WUB = 412 * MiB, WS_WOUT = 436 * MiB, WS_H = 468 * MiB, WS_OA = 1508 * MiB,
                 WS_LSE = 1796 * MiB, WS_LOGF = 1802 * MiB, WS_CUM = 1804 * MiB, WS_COS = 1806 * MiB, WS_SIN = 1808 * MiB, WS_NRM = 1810 * MiB, WS_SC = 1811 * MiB, WS_BAR = 1812 * MiB, WS_PN2 = 1813 * MiB, WS_END = 1826 * MiB;
constexpr size_t SC_SX = 0, SC_SAA = 32768, SC_SAB = 65536, SC_SWIN = 98304, SC_SWUA = SC_SWIN + 4 * 16640, SC_SWUB = SC_SWUA + 4 * 2048, SC_CSIN = SC_SWUB + 4 * 2048, SC_SWOUT = SC_CSIN + 4 * 16640;
constexpr size_t WS_STATS = WS_BAR + 65536;
constexpr size_t WS_SM = WS_BAR + 393216;
constexpr size_t WS_MF = WS_OA + 96 * MiB;
constexpr size_t OA_STRIDE = (size_t)M * WA, LSE_STRIDE = (size_t)M * NH;
constexpr int LDS_BYTES = 147456, LDS_BARST_OFF = 139264;
constexpr int NPH = 2 + 7 * DEPTH;
typedef unsigned short bf16;
typedef float f32x4 __attribute__((ext_vector_type(4)));
typedef unsigned u32x4 __attribute__((ext_vector_type(4)));

__device__ __forceinline__ unsigned f2bf(float f) { unsigned u = __builtin_bit_cast(unsigned, f); return (u + 0x7fffu + ((u >> 16) & 1u)) >> 16; }
__device__ __forceinline__ unsigned pk2(float lo, float hi) { return f2bf(lo) | (f2bf(hi) << 16); }
__device__ __forceinline__ float bflo(unsigned w) { return __uint_as_float(w << 16); }
__device__ __forceinline__ float bfhi(unsigned w) { return __uint_as_float(w & 0xffff0000u); }
__device__ __forceinline__ float wave_sum(float v) {
#pragma unroll
    for (int o = 1; o < 64; o <<= 1) v += __shfl_xor(v, o);
    return v;
}
__device__ __forceinline__ int in_src_col(int n) {
    if (n < C_VA) { const int hb = n >> 7, p = n & 127; return hb * 128 + 4 * (p >> 3) + (p & 3) + 64 * ((p >> 2) & 1); }
    if (n < C_G) return n;
    if (n < C_F) return n + 12;
    if (n < C_F + 12) return n - C_F + 12288;
    return -1;
}
__device__ __forceinline__ unsigned q8(float v) { return (unsigned)__float2int_rn(v) & 0xffu; }
__device__ __forceinline__ unsigned pack4q(float a, float b, float c, float d) { return q8(a) | (q8(b) << 8) | (q8(c) << 16) | (q8(d) << 24); }
__device__ __forceinline__ float wave_max(float v) {
#pragma unroll
    for (int o = 1; o < 64; o <<= 1) v = fmaxf(v, __shfl_xor(v, o));
    return v;
}
__device__ __forceinline__ void quant_row(const f32x4 (&v)[8], unsigned char* qrow, float* scale, int lane) {
    float amax = 0.f;
#pragma unroll
    for (int j = 0; j < 8; ++j) amax = fmaxf(amax, fmaxf(fmaxf(fabsf(v[j][0]), fabsf(v[j][1])), fmaxf(fabsf(v[j][2]), fabsf(v[j][3]))));
    amax = wave_max(amax); const float inv = amax > 0.f ? 127.f / amax : 0.f;
#pragma unroll
    for (int j = 0; j < 8; ++j) *(unsigned*)(qrow + 4 * lane + 256 * j) = pack4q(v[j][0] * inv, v[j][1] * inv, v[j][2] * inv, v[j][3] * inv);
    if (lane == 0) *scale = amax > 0.f ? amax * (1.f / 127.f) : 1.f;
}

__device__ __forceinline__ float quant_row_q(const f32x4 (&v)[8], unsigned char* qrow, float* scale, int lane, unsigned (&q)[8]) {
    float amax = 0.f;
#pragma unroll
    for (int j = 0; j < 8; ++j) amax = fmaxf(amax, fmaxf(fmaxf(fabsf(v[j][0]), fabsf(v[j][1])), fmaxf(fabsf(v[j][2]), fabsf(v[j][3]))));
    amax = wave_max(amax); const float inv = amax > 0.f ? 127.f / amax : 0.f, sc = amax > 0.f ? amax * (1.f / 127.f) : 1.f;
#pragma unroll
    for (int j = 0; j < 8; ++j) { q[j] = pack4q(v[j][0] * inv, v[j][1] * inv, v[j][2] * inv, v[j][3] * inv); *(unsigned*)(qrow + 4 * lane + 256 * j) = q[j]; }
    if (lane == 0) *scale = sc;
    return sc;
}

template <bool MAP>
__device__ __forceinline__ void quant_tile(const float* W, int K, int N, const float* cs, unsigned char* WT, float* swout, unsigned* t, int item, int nblk, int lane) {
    const int kb = item / nblk, nb = item - kb * nblk, k0 = 64 * kb, nn = 64 * nb + lane, src = MAP ? in_src_col(nn) : nn;
    const float sc = src >= 0 ? cs[src] : 1.f, inv = src >= 0 ? 1.f / sc : 0.f;
    if (swout && kb == 0) swout[nn] = sc;
    const float* wp = W + (size_t)k0 * N + (src >= 0 ? src : 0);
#pragma unroll 4
    for (int s = 0; s < 16; ++s) { const float v0 = wp[(size_t)(4 * s) * N], v1 = wp[(size_t)(4 * s + 1) * N], v2 = wp[(size_t)(4 * s + 2) * N], v3 = wp[(size_t)(4 * s + 3) * N];
        t[lane * 17 + s] = pack4q(v0 * inv, v1 * inv, v2 * inv, v3 * inv); }
    asm volatile("s_waitcnt lgkmcnt(0)" ::: "memory");
#pragma unroll
    for (int j = 0; j < 4; ++j) { const int idx = lane + 64 * j, n = idx >> 2, c = idx & 3; const unsigned* s = t + n * 17 + 4 * c;
        u32x4 o; o.x = s[0]; o.y = s[1]; o.z = s[2]; o.w = s[3];
        *(u32x4*)(WT + (size_t)(64 * nb + n) * K + k0 + 16 * c) = o; }
    asm volatile("s_waitcnt lgkmcnt(0)" ::: "memory");
}

#define FGATE_ROW(q, sxr, m, LN_) do { float zsel = 0.f; \
        _Pragma("unroll") for (int h = 0; h < 12; ++h) { int a = 0; const unsigned char* wfh = WINQ + (size_t)(LN_) * NPAD * DM + (size_t)(C_F + h) * DM + 4 * lane; \
            _Pragma("unroll") for (int j = 0; j < 8; ++j) a = __builtin_amdgcn_sdot4((int)q[j], *(const int*)(wfh + 256 * j), a, false); \
            _Pragma("unroll") for (int o = 1; o < 64; o <<= 1) a += __shfl_xor(a, o); \
            if (lane == h) zsel = (float)a; } \
        if (lane < 12) { const float z_ = zsel * (sxr) * swf + bff; LOGF[((size_t)((m) >> 13) * NH + lane) * SEQ + ((m) & 8191)] = fminf(z_, 0.f) - __logf(1.f + __expf(-fabsf(z_))); } } while (0)

struct Args { const float* in[9]; float* out; unsigned char* ws; int ph_lo, ph_hi; };

__global__ void __launch_bounds__(512, 2) mega_fwd(Args args) {
    extern __shared__ __attribute__((aligned(16))) unsigned char lds[];
    cg::grid_group grid = cg::this_grid();
    const int G = gridDim.x, bx = blockIdx.x, NGW = G * 8;
    const int vcu = (G % 8 == 0) ? (bx % 8) * (G / 8) + bx / 8 : bx;
#define PH_IDS int tid = threadIdx.x; asm volatile("" : "+v"(tid)); const int lane = tid & 63, wave = __builtin_amdgcn_readfirstlane(tid >> 6), gw = bx * 8 + wave; (void)lane; (void)gw; PH_PTRS
#define PH_PTRS     unsigned long long wz_ = 0; asm volatile("" : "+s"(wz_)); unsigned char* ws = args.ws + wz_;     \
    const float* x_in = args.in[0]; const float* w_in = args.in[1]; const float* b_forget = args.in[2]; const float* b_gate = args.in[3]; \
    const float* w_up_a = args.in[4]; const float* w_up_b = args.in[5]; const float* w_out = args.in[6]; const float* ln_g = args.in[7]; const float* ln_b = args.in[8]; \
    float* out = args.out; \
    bf16* XB = (bf16*)(ws + WS_XB); bf16* WIN = (bf16*)(ws + WS_WIN); bf16* WUA = (bf16*)(ws + WS_WUA); bf16* WUB = (bf16*)(ws + WS_WUB); bf16* WOUT = (bf16*)(ws + WS_WOUT); \
    bf16* H = (bf16*)(ws + WS_H); bf16* OA = (bf16*)(ws + WS_OA); bf16* MF = (bf16*)(ws + WS_MF); \
    float* LSE = (float*)(ws + WS_LSE); float* LOGF = (float*)(ws + WS_LOGF); float* CUM = (float*)(ws + WS_CUM); float* COS = (float*)(ws + WS_COS); float* SIN = (float*)(ws + WS_SIN); float* NRM = (float*)(ws + WS_NRM); float* SC = (float*)(ws + WS_SC); \
    unsigned char* XQ = ws + WS_XB; unsigned char* WINQ = ws + WS_WIN; unsigned char* WUAQ = ws + WS_WUA; unsigned char* WUBQ = ws + WS_WUB; \
    (void)x_in; (void)w_in; (void)b_forget; (void)b_gate; (void)w_up_a; (void)w_up_b; (void)w_out; (void)ln_g; (void)ln_b; (void)out; (void)XB; (void)WIN; (void)WUA; (void)WUB; (void)WOUT; (void)H; (void)OA; (void)MF; (void)LSE; (void)LOGF; (void)CUM; (void)COS; (void)SIN; (void)NRM; (void)SC; (void)XQ; (void)WINQ; (void)WUAQ; (void)WUBQ
    const int lo = args.ph_lo, hi = args.ph_hi;
#define IN(k) (lo <= (k) && (k) < hi)
#ifndef XCDBAR
#define XCDBAR 1
#endif
    volatile LAS unsigned* bst = (volatile LAS unsigned*)((LAS unsigned char*)lds + LDS_BARST_OFF);
    if (threadIdx.x < 2) bst[threadIdx.x] = 0u;
    __syncthreads();
    XcdBarrier xbar = xcd_barrier_post((unsigned*)(args.ws + WS_BAR), bst);
#define SEAM(k) do { if ((k) + 1 < hi) { if (!XCDBAR || (k) == 0) grid.sync(); else xcd_barrier(xbar); } } while (0)

    if (IN(0)) { PH_IDS;
        {   float* red = (float*)lds; constexpr int CG_IN = (NIN + 255) / 256, CG_UP = DM / 256, CG_L = CG_IN + 3 * CG_UP;
            for (int it = bx; it < DEPTH * CG_L; it += G) {
                const int l = it / CG_L; int r = it - l * CG_L; const float* W; int K, N; float* cs;
                if (r < CG_IN) { W = w_in + (size_t)l * DM * NIN; K = DM; N = NIN; cs = SC + SC_CSIN + l * NPAD; }
                else if (r < CG_IN + CG_UP) { r -= CG_IN; W = w_up_a + (size_t)l * WA * DM; K = WA; N = DM; cs = SC + SC_SWUA + l * DM; }
                else if (r < CG_IN + 2 * CG_UP) { r -= CG_IN + CG_UP; W = w_up_b + (size_t)l * WA * DM; K = WA; N = DM; cs = SC + SC_SWUB + l * DM; }
                else { r -= CG_IN + 2 * CG_UP; W = w_out + (size_t)l * DM * DM; K = DM; N = DM; cs = SC + SC_SWOUT + l * DM; }
                const int col = 256 * r + 4 * lane; f32x4 mx = {0.f, 0.f, 0.f, 0.f};
                if (col < N) { const float* wp = W + col;
#pragma unroll 8
                    for (int k = wave; k < K; k += 8) { const f32x4 v = *(const f32x4*)(wp + (size_t)k * N);
                        mx[0] = fmaxf(mx[0], fabsf(v[0])); mx[1] = fmaxf(mx[1], fabsf(v[1])); mx[2] = fmaxf(mx[2], fabsf(v[2])); mx[3] = fmaxf(mx[3], fabsf(v[3])); } }
                *(f32x4*)(red + wave * 256 + 4 * lane) = mx;
                __syncthreads();
                if (tid < 256 && 256 * r + tid < N) { float m = 0.f; for (int w = 0; w < 8; ++w) m = fmaxf(m, red[w * 256 + tid]); cs[256 * r + tid] = m > 0.f ? m * (1.f / 127.f) : 1.f; }
                __syncthreads();
            }
        }
        for (int idx = bx * 512 + tid; idx < SEQ * 64; idx += G * 512) {
            const int pos = idx >> 6, i = idx & 63;
            const float inv_freq = exp2f(-(float)i * (1.f / 64.f) * 13.287712379549449f);
            const float ang = (float)pos * inv_freq;
            const double rev = (double)ang * 0.15915494309189535; const float fr = (float)(rev - floor(rev));
            COS[idx] = __builtin_amdgcn_cosf(fr); SIN[idx] = __builtin_amdgcn_sinf(fr);
        }
        for (int m = gw; m < M; m += NGW) { f32x4 v[8];
#pragma unroll
            for (int j = 0; j < 8; ++j) v[j] = *(const f32x4*)(x_in + (size_t)m * DM + 4 * lane + 256 * j);
            quant_row(v, XQ + (size_t)m * DM, SC + SC_SX + m, lane); }
        SEAM(0);
    }
    if (IN(1)) { PH_IDS;
        unsigned* t = (unsigned*)(lds + wave * 16384);
        constexpr int T_IN = (DM / 64) * (NPAD / 64), T_UP = (WA / 64) * (DM / 64), T_OUT = (DM / 64) * (DM / 64), T_L = T_IN + 2 * T_UP + T_OUT;
        for (int it = gw; it < DEPTH * T_L; it += NGW) {
            const int l = it / T_L; int r = it - l * T_L;
            if (r < T_IN) { quant_tile<true>(w_in + (size_t)l * DM * NIN, DM, NIN, SC + SC_CSIN + l * NPAD, WINQ + (size_t)l * NPAD * DM, SC + SC_SWIN + l * NPAD, t, r, NPAD / 64, lane); continue; } r -= T_IN;
            if (r < T_UP) { quant_tile<false>(w_up_a + (size_t)l * WA * DM, WA, DM, SC + SC_SWUA + l * DM, WUAQ + (size_t)l * DM * WA, nullptr, t, r, DM / 64, lane); continue; } r -= T_UP;
            if (r < T_UP) { quant_tile<false>(w_up_b + (size_t)l * WA * DM, WA, DM, SC + SC_SWUB + l * DM, WUBQ + (size_t)l * DM * WA, nullptr, t, r, DM / 64, lane); continue; } r -= T_UP;
            quant_tile<false>(w_out + (size_t)l * DM * DM, DM, DM, SC + SC_SWOUT + l * DM, ws + WS_WOUT + (size_t)l * DM * DM, nullptr, t, r, DM / 64, lane);
        }
        SEAM(1);
    }

    for (int l = 0; l < DEPTH; ++l) {
        const int pb = 2 + 7 * l;
        if (IN(pb + 0)) { PH_IDS;
            if (l == 0) {
                float swf = 1.f, bff = 0.f; if (lane < 12) { swf = SC[SC_SWIN + C_F + lane]; bff = b_forget[lane]; }
                for (int m = gw; m < M; m += NGW) { unsigned q[8];
#pragma unroll
                    for (int j = 0; j < 8; ++j) q[j] = *(const unsigned*)(XQ + (size_t)m * DM + 4 * lane + 256 * j);
                    const float sxr = SC[SC_SX + m]; FGATE_ROW(q, sxr, m, 0); } }
            if (bx == 0 && tid < 96) NRM[tid] = 0.f;
            const int NP1 = C_F;
            pg8::Gemm g{(const bf16*)XQ, (const bf16*)(WINQ + (size_t)l * NPAD * DM), M, NP1, DM / 2, DM / 2};   pg8::StaticOrder S; S.init(M, NP1, G, bx);
            pg8::EpiIn E{H, NPAD, COS, SIN, LOGF, b_forget + l * NH, SC + SC_SX, SC + SC_SWIN + l * NPAD, (float*)(ws + WS_PN2)};
            pg8::gemm_phase<pg8::EpiIn, pg8::StaticOrder, true, true, true>((PG8_LAS unsigned char*)lds, g, S, E);
            SEAM(pb + 0);
        }
        if (IN(pb + 1)) { PH_IDS;
            {
                float* red = (float*)lds;
                for (int b = 0; b < BATCH; ++b) {
                    float mx = 0.f;
                    for (int s = gw; s < SEQ; s += NGW) { if (lane < 24) { const f32x4 p = *(const f32x4*)((const float*)(ws + WS_PN2) + (((size_t)b * SEQ + s) * 24 + lane) * 4); mx = fmaxf(mx, (p[0] + p[1]) + (p[2] + p[3])); } }
                    if (lane < 24) red[wave * 24 + lane] = mx;
                    __syncthreads();
                    if (tid < 24) { float v = 0.f; for (int w = 0; w < 8; ++w) v = fmaxf(v, red[w * 24 + tid]); atomicMax((unsigned*)NRM + (tid < 12 ? 0 : 48) + b * NH + (tid % 12), __float_as_uint(v)); }
                    __syncthreads();
                }
            }
            if (bx < BATCH * NH) {
                const int b = bx / NH, h = bx - b * NH; float* red = (float*)lds;
                float v[16]; float run = 0.f;
#pragma unroll
                for (int j = 0; j < 16; j += 4) { const f32x4 lf = *(const f32x4*)(LOGF + (size_t)bx * SEQ + 16 * tid + j);
                    run += lf[0]; v[j] = run; run += lf[1]; v[j + 1] = run; run += lf[2]; v[j + 2] = run; run += lf[3]; v[j + 3] = run; }
                float inc = run;
#pragma unroll
                for (int o = 1; o < 64; o <<= 1) { const float t = __shfl_up(inc, o); if (lane >= o) inc += t; }
                if (lane == 63) red[wave] = inc;
                __syncthreads();
                float off = inc - run;
                for (int w = 0; w < wave; ++w) off += red[w];
                float* cp = CUM + (size_t)bx * SEQ + 16 * tid;
#pragma unroll
                for (int j = 0; j < 16; j += 4) *(f32x4*)(cp + j) = (f32x4){v[j] + off, v[j + 1] + off, v[j + 2] + off, v[j + 3] + off};
                __syncthreads();
            }
            constexpr int NIT = 3 * 1536;
            const int cnt = vcu < NIT ? (NIT - vcu + G - 1) / G : 0;
#define DIL_REF(R, n) do { const int L_ = vcu + (n) * G;   \
            const int bh_ = L_ / 96, rb_ = L_ - bh_ * 96, b_ = bh_ / NH, h_ = bh_ - b_ * NH, g_ = rb_ >> 5, r_ = rb_ & 31, dsh = 2 * g_, d_ = 1 << dsh; \
            const int qb = r_ & ((32 >> dsh) - 1), res = r_ >> (5 - dsh); \
            const size_t tok0 = (size_t)b_ * SEQ + res, rq = (size_t)qb * 256 * d_; \
            R.Q = H + (tok0 + rq) * NPAD + C_QA + h_ * HD; R.K = H + tok0 * NPAD + C_KA + h_ * HD; R.V = H + tok0 * NPAD + C_VA + h_ * HD; \
            R.O = OA + (size_t)g_ * OA_STRIDE + (tok0 + rq) * WA + h_ * HD; R.LSE = LSE + (size_t)g_ * LSE_STRIDE + (tok0 + rq) * NH + h_; R.CUM = nullptr; \
            R.P0 = qb * 256; R.pq = d_ * NPAD; R.po = d_ * WA; R.pl = d_ * NH; R.skv = SEQ >> dsh; R.thr = 0.f; } while (0)
            if (cnt > 0) {
                at::BlkRef cur, nxt; at::Seam S{};     DIL_REF(cur, 0);
                at::attn_prime<false>(cur, 129, (char*)lds, S);
                for (int n = 0; n < cnt; ++n) {
                    if (n + 1 < cnt) DIL_REF(nxt, n + 1); else nxt = cur;
                    at::attn_block<false, true, 129>(cur, nxt, (char*)lds, S);
                    cur = nxt;
                }
            }
#undef DIL_REF
            SEAM(pb + 1);
        }
        if (IN(pb + 2)) { PH_IDS;
            constexpr int NIT = BATCH * NH * 32;
            const int cnt = vcu < NIT ? (NIT - vcu + G - 1) / G : 0;
#define FOX_REF(R, n) do { const int L_ = vcu + (n) * G; const int bh = L_ >> 5, qb = (L_ + ((G & 31) == 0 ? 5 * (n) : 0)) & 31  , b_ = bh / NH, h_ = bh - b_ * NH; \
            R.Q = H + ((size_t)b_ * SEQ + (size_t)qb * 256) * NPAD + C_QB + h_ * HD; R.K = H + (size_t)b_ * SEQ * NPAD + C_KB + h_ * HD; R.V = H + (size_t)b_ * SEQ * NPAD + C_VB + h_ * HD; \
            R.O = (bf16*)R.Q; R.LSE = nullptr; R.CUM = CUM + (size_t)bh * SEQ; R.P0 = qb * 256; R.pq = NPAD; R.po = NPAD; R.pl = 0; R.skv = SEQ; R.thr = 30.f + 2.f * 1.02f * sqrtf(NRM[bh] * NRM[48 + bh]) * 0.08838834764831845f;     } while (0)
            if (cnt > 0) {
                at::BlkRef cur, nxt; at::Seam S{};     FOX_REF(cur, 0);
                at::attn_prime<true>(cur, SEQ, (char*)lds, S);
                for (int n = 0; n < cnt; ++n) {
                    if (n + 1 < cnt) FOX_REF(nxt, n + 1); else nxt = cur;
                    at::attn_block<true, false, SEQ>(cur, nxt, (char*)lds, S);
                    cur = nxt;
                }
            }
#undef FOX_REF
            SEAM(pb + 2);
        }

        if (IN(pb + 3)) { PH_IDS;
            for (int m = gw; m < M; m += NGW) {
                bf16* hr = H + (size_t)m * NPAD; float va[3][8], vb[3][8]; float ama = 0.f, amb = 0.f;
                u32x4 A0[3], A1[3], A2[3], ZA[3], OB[3], ZB[3]; float L0[3], L1[3], L2[3];
#pragma unroll
                for (int j = 0; j < 3; ++j) {
                    const int col = 8 * (lane + 64 * j), hh = col >> 7; const bf16* oa = OA + (size_t)m * WA + col;
                    A0[j] = *(const u32x4*)oa; A1[j] = *(const u32x4*)(oa + OA_STRIDE); A2[j] = *(const u32x4*)(oa + 2 * OA_STRIDE); ZA[j] = *(const u32x4*)(hr + C_ZA + col);
                    OB[j] = *(const u32x4*)(hr + C_QB + col); ZB[j] = *(const u32x4*)(hr + C_ZB + col);
                    L0[j] = LSE[(size_t)m * NH + hh]; L1[j] = LSE[LSE_STRIDE + (size_t)m * NH + hh]; L2[j] = LSE[2 * LSE_STRIDE + (size_t)m * NH + hh]; }
                asm volatile("" ::: "memory");
#pragma unroll
                for (int j = 0; j < 3; ++j) {
                    const float l0 = L0[j], l1 = L1[j], l2 = L2[j];
                    const float mx = fmaxf(l0, fmaxf(l1, l2)); float e0 = __expf(l0 - mx), e1 = __expf(l1 - mx), e2 = __expf(l2 - mx);
                    const float inv = __builtin_amdgcn_rcpf(e0 + e1 + e2); e0 *= inv; e1 *= inv; e2 *= inv;
                    const u32x4 a0 = A0[j], a1 = A1[j], a2 = A2[j], za = ZA[j], ob = OB[j], zb = ZB[j];
#pragma unroll
                    for (int k = 0; k < 4; ++k) { const float zl = bflo(za[k]), zh = bfhi(za[k]), yl = bflo(zb[k]), yh = bfhi(zb[k]);
                        va[j][2 * k] = (e0 * bflo(a0[k]) + e1 * bflo(a1[k]) + e2 * bflo(a2[k])) * zl * __builtin_amdgcn_rcpf(1.f + __expf(-zl));
                        va[j][2 * k + 1] = (e0 * bfhi(a0[k]) + e1 * bfhi(a1[k]) + e2 * bfhi(a2[k])) * zh * __builtin_amdgcn_rcpf(1.f + __expf(-zh));
                        vb[j][2 * k] = bflo(ob[k]) * yl * __builtin_amdgcn_rcpf(1.f + __expf(-yl)); vb[j][2 * k + 1] = bfhi(ob[k]) * yh * __builtin_amdgcn_rcpf(1.f + __expf(-yh));
                        ama = fmaxf(ama, fmaxf(fabsf(va[j][2 * k]), fabsf(va[j][2 * k + 1]))); amb = fmaxf(amb, fmaxf(fabsf(vb[j][2 * k]), fabsf(vb[j][2 * k + 1]))); }
                }
                ama = wave_max(ama); amb = wave_max(amb);
                const float ia = ama > 0.f ? 127.f / ama : 0.f, ib = amb > 0.f ? 127.f / amb : 0.f;
                unsigned char* qa = (unsigned char*)OA + (size_t)m * (2 * WA); unsigned char* qb = (unsigned char*)(hr + C_QB);
#pragma unroll
                for (int j = 0; j < 3; ++j) { const int col = 8 * (lane + 64 * j);
                    unsigned long long pa = (unsigned long long)pack4q(va[j][0] * ia, va[j][1] * ia, va[j][2] * ia, va[j][3] * ia) | ((unsigned long long)pack4q(va[j][4] * ia, va[j][5] * ia, va[j][6] * ia, va[j][7] * ia) << 32);
                    unsigned long long pb = (unsigned long long)pack4q(vb[j][0] * ib, vb[j][1] * ib, vb[j][2] * ib, vb[j][3] * ib) | ((unsigned long long)pack4q(vb[j][4] * ib, vb[j][5] * ib, vb[j][6] * ib, vb[j][7] * ib) << 32);
                    *(unsigned long long*)(qa + col) = pa; *(unsigned long long*)(qb + col) = pb; }
                if (lane == 0) { SC[SC_SAA + m] = ama > 0.f ? ama * (1.f / 127.f) : 1.f; SC[SC_SAB + m] = amb > 0.f ? amb * (1.f / 127.f) : 1.f; }
            }
            SEAM(pb + 3);
        }

        if (IN(pb + 4)) { PH_IDS;
            { pg8::Gemm g{OA, (const bf16*)(WUAQ + (size_t)l * DM * WA), M, DM, WA / 2, WA}; pg8::StaticOrder S; S.init(M, DM, G, bx);
              pg8::EpiGate<false> E{H + C_G, NPAD, b_gate + (size_t)l * 2 * DM, nullptr, MF, DM, SC + SC_SAA, SC + SC_SWUA + l * DM};
              pg8::gemm_phase<pg8::EpiGate<false>, pg8::StaticOrder, true, true, true>((PG8_LAS unsigned char*)lds, g, S, E); }
            { pg8::Gemm g{H + C_QB, (const bf16*)(WUBQ + (size_t)l * DM * WA), M, DM, WA / 2, NPAD}; pg8::StaticOrder S; S.init(M, DM, G, bx);
              pg8::EpiGate<true> E{H + C_G + DM, NPAD, b_gate + (size_t)l * 2 * DM + DM, MF, XB, DM, SC + SC_SAB, SC + SC_SWUB + l * DM};
              pg8::gemm_phase<pg8::EpiGate<true>, pg8::StaticOrder, true, true, true>((PG8_LAS unsigned char*)lds, g, S, E); }
            SEAM(pb + 4);
        }
        if (IN(pb + 5)) { PH_IDS;
            {
                unsigned char* MQ = ws + WS_MF; float* SM = (float*)(ws + WS_SM);
                for (int m = gw; m < M; m += NGW) { u32x4 r4[4]; float amax = 0.f;
#pragma unroll
                    for (int j = 0; j < 4; ++j) { r4[j] = *(const u32x4*)(XB + (size_t)m * DM + 8 * (lane + 64 * j));
#pragma unroll
                        for (int k = 0; k < 4; ++k) amax = fmaxf(amax, fmaxf(fabsf(bflo(r4[j][k])), fabsf(bfhi(r4[j][k])))); }
                    amax = wave_max(amax); const float inv = amax > 0.f ? 127.f / amax : 0.f;
#pragma unroll
                    for (int j = 0; j < 4; ++j) { const unsigned long long p = (unsigned long long)pack4q(bflo(r4[j][0]) * inv, bfhi(r4[j][0]) * inv, bflo(r4[j][1]) * inv, bfhi(r4[j][1]) * inv) |
                            ((unsigned long long)pack4q(bflo(r4[j][2]) * inv, bfhi(r4[j][2]) * inv, bflo(r4[j][3]) * inv, bfhi(r4[j][3]) * inv) << 32);
                        *(unsigned long long*)(MQ + (size_t)m * DM + 8 * (lane + 64 * j)) = p; }
                    if (lane == 0) SM[m] = amax > 0.f ? amax * (1.f / 127.f) : 1.f; }
                if (hi - lo > 1) xcd_barrier(xbar);
            }
            pg8::Gemm g{(const bf16*)(ws + WS_MF), (const bf16*)(ws + WS_WOUT + (size_t)l * DM * DM), M, DM, DM / 2, DM / 2}; pg8::StaticOrder S; S.init(M, DM, G, bx);
            pg8::EpiOut E{l == 0 ? x_in : out, out, DM, ALPHA, l == 0 ? nullptr : (const float*)(ws + WS_STATS), ln_g + (size_t)(l > 0 ? l - 1 : 0) * DM, ln_b + (size_t)(l > 0 ? l - 1 : 0) * DM, (const float*)(ws + WS_SM), SC + SC_SWOUT + l * DM};
            pg8::gemm_phase<pg8::EpiOut, pg8::StaticOrder, true, true, true>((PG8_LAS unsigned char*)lds, g, S, E);
            SEAM(pb + 5);
        }

        if (IN(pb + 6)) { PH_IDS;
            const float* gg = ln_g + (size_t)l * DM; const float* bb = ln_b + (size_t)l * DM;
            const int ln_ = l + 1 < DEPTH ? l + 1 : l; float swf = 1.f, bff = 0.f;
            { const unsigned char* wf = WINQ + (size_t)ln_ * NPAD * DM + (size_t)C_F * DM; (void)wf;
              if (lane < 12) { swf = SC[SC_SWIN + (size_t)ln_ * NPAD + C_F + lane]; bff = b_forget[ln_ * NH + lane]; } }
            for (int m = gw; m < M; m += NGW) {
                float* row = out + (size_t)m * DM; f32x4 v[8]; float s = 0.f;
#pragma unroll
                for (int j = 0; j < 8; ++j) { v[j] = *(const f32x4*)(row + 4 * lane + 256 * j); s += (v[j][0] + v[j][1]) + (v[j][2] + v[j][3]); }
                const float mean = wave_sum(s) * (1.f / DM); float s2 = 0.f;
#pragma unroll
                for (int j = 0; j < 8; ++j) { v[j] = v[j] - mean; s2 += (v[j][0] * v[j][0] + v[j][1] * v[j][1]) + (v[j][2] * v[j][2] + v[j][3] * v[j][3]); }
                const float rstd = 1.f / sqrtf(wave_sum(s2) * (1.f / DM) + LN_EPS);
                const bool lastl = l == DEPTH - 1;
#pragma unroll
                for (int j = 0; j < 8; ++j) { const int c = 4 * lane + 256 * j; const f32x4 gv = *(const f32x4*)(gg + c), bv = *(const f32x4*)(bb + c);
                    v[j] = v[j] * rstd * gv + bv; if (lastl) *(f32x4*)(row + c) = v[j]; }
                if (!lastl) { if (lane == 0) { float* st = (float*)(ws + WS_STATS) + 2 * (size_t)m; st[0] = mean; st[1] = rstd; }
                    unsigned q[8]; const float sxr = quant_row_q(v, XQ + (size_t)m * DM, SC + SC_SX + m, lane, q);
                    FGATE_ROW(q, sxr, m, ln_); }
            }
            SEAM(pb + 6);
        }
    }
#undef IN
#undef SEAM
}

extern "C" void kernel_launch(void* const* d_in, const int* in_sizes, int n_in, void* d_out, int out_size, void* d_ws, size_t ws_size, hipStream_t stream) {
    static int grid = 0;
    if (grid == 0) {
        if (n_in != 9 || in_sizes[0] != M * DM || out_size != M * DM || ws_size < WS_END) { fprintf(stderr, "kernel_launch: unexpected shapes / workspace (n_in %d, ws %zu)\n", n_in, ws_size); grid = -1; return; }
        int dev = 0, cus = 0, per_cu = 0;
        (void)hipGetDevice(&dev); (void)hipDeviceGetAttribute(&cus, hipDeviceAttributeMultiprocessorCount, dev);
        if (hipFuncSetAttribute((const void*)mega_fwd, hipFuncAttributeMaxDynamicSharedMemorySize, LDS_BYTES) != hipSuccess) { fprintf(stderr, "kernel_launch: hipFuncSetAttribute failed\n"); grid = -1; return; }
        if (hipOccupancyMaxActiveBlocksPerMultiprocessor(&per_cu, (const void*)mega_fwd, 512, LDS_BYTES) != hipSuccess || per_cu < 1) { fprintf(stderr, "kernel_launch: occupancy query says %d\n", per_cu); per_cu = 1; }
        (void)hipGetLastError();
        if (cus <= 0) cus = 256;
        grid = cus * per_cu;
    }
    if (grid < 0) return;
    if (hipMemsetAsync((char*)d_ws + WS_BAR, 0, XCD_BAR_WORDS * 4, stream) != hipSuccess) { fprintf(stderr, "kernel_launch: hipMemsetAsync of the barrier words failed\n"); return; }
    Args a{};
    for (int i = 0; i < 9; ++i) a.in[i] = (const float*)d_in[i];
    a.out = (float*)d_out; a.ws = (unsigned char*)d_ws;
    a.ph_lo = 0; a.ph_hi = NPH;
    void* kargs[] = {&a};
    hipError_t e = hipLaunchCooperativeKernel((const void*)mega_fwd, dim3(grid), dim3(512), kargs, LDS_BYTES, stream);
    if (e != hipSuccess) fprintf(stderr, "kernel_launch: cooperative launch failed: %s (grid %d)\n", hipGetErrorString(e), grid);
}
```
